# Optimizing an MI355X kernel written in HIP

```python
import math
import jax, jax.numpy as jnp
from jax import lax
import numpy as np

D_MODEL = 2048
BATCH = 4
SEQ = 2048
DEPTH = 2
DEC_BATCH = 8
DEC_SEQ = 1
PAST_LEN = 16384
PAGE_SIZE = 128

F32 = jnp.float32
N_EVEN = (DEPTH + 1) // 2
N_ODD = DEPTH // 2
SSD_HEADS = 32
SSD_HEAD_DIM = 64
SSD_INNER = SSD_HEADS * SSD_HEAD_DIM
SSD_GROUPS = 8
SSD_STATE = 128
SSD_CONV = 4
SSD_CHUNK = 128
CONV_DIM = SSD_INNER + 2 * SSD_GROUPS * SSD_STATE
ATT_HEAD_DIM = 128
WINDOWS = (128, 512, 2048)
DILATIONS = (1, 4, 16)
ATT_HPP = 8
ATT_HEADS = ATT_HPP * len(WINDOWS)
ATT_QKV = ATT_HEADS * ATT_HEAD_DIM
ATT_OUT = ATT_HPP * ATT_HEAD_DIM
REL_BUCKETS = 32
REL_MAX_DIST = 2048
IN_COLS = SSD_INNER + CONV_DIM + SSD_HEADS + 3 * ATT_QKV
IN_SPLITS = [SSD_INNER, SSD_INNER + CONV_DIM, SSD_INNER + CONV_DIM + SSD_HEADS,
             SSD_INNER + CONV_DIM + SSD_HEADS + ATT_QKV, SSD_INNER + CONV_DIM + SSD_HEADS + 2 * ATT_QKV]
MIX_OUT = SSD_INNER + ATT_OUT
POOL_WINDOWS = (2, 4, 8, 16)
POOL_GROUPS = 4
POOL_CH = D_MODEL // POOL_GROUPS
POOL_MAX = 16
D_FF = 4 * D_MODEL
EPS = 1e-6
NEG = -1e30

kernel_name = "hybrid_ssd_dilated_pool_decoder_step"


def rmsnorm(x, g):
    xf = x.astype(F32)
    y = xf * lax.rsqrt(jnp.mean(xf * xf, axis=-1, keepdims=True) + EPS)
    return (y * g.astype(F32)).astype(x.dtype)


def rel_bucket(dist):
    max_exact = REL_BUCKETS // 2
    n = jnp.maximum(dist, 1).astype(F32)
    large = max_exact + (jnp.log(n / max_exact) / math.log(REL_MAX_DIST / max_exact)
                         * (REL_BUCKETS - max_exact)).astype(jnp.int32)
    large = jnp.minimum(large, REL_BUCKETS - 1)
    return jnp.where(dist < max_exact, dist, large)


def causal_conv(xbc, prev, w, b):
    t = xbc.shape[1]
    ext = jnp.concatenate([prev.astype(xbc.dtype), xbc], axis=1)
    out = b + sum(w[k] * ext[:, k:k + t] for k in range(SSD_CONV))
    return jax.nn.silu(out), ext[:, -(SSD_CONV - 1):]


def ssd_chunked(xs, dt, A, Bm, Cm):
    b, L = xs.shape[:2]
    Q, G = SSD_CHUNK, SSD_GROUPS
    E = SSD_HEADS // G
    nc = L // Q
    x = xs.reshape(b, nc, Q, G, E, SSD_HEAD_DIM).astype(F32)
    dtc = dt.reshape(b, nc, Q, G, E).astype(F32)
    Bc = Bm.reshape(b, nc, Q, G, SSD_STATE).astype(F32)
    Cc = Cm.reshape(b, nc, Q, G, SSD_STATE).astype(F32)
    acum = jnp.cumsum(dtc * A.reshape(G, E), axis=2)
    seg = acum[:, :, :, None] - acum[:, :, None, :]
    causal = (jnp.arange(Q)[:, None] >= jnp.arange(Q)[None, :])[:, :, None, None]
    Lw = jnp.where(causal, jnp.exp(jnp.where(causal, seg, 0.0)), 0.0) * dtc[:, :, None]
    CB = jnp.einsum('bcign,bcjgn->bcgij', Cc, Bc)
    y_diag = jnp.einsum('bcgij,bcijge,bcjgep->bcigep', CB, Lw, x)
    decay_end = jnp.exp(acum[:, :, -1:] - acum) * dtc
    states = jnp.einsum('bcjgn,bcjge,bcjgep->bcgepn', Bc, decay_end, x)
    chunk_decay = jnp.exp(acum[:, :, -1])

    def step(h, inp):
        dec, st = inp
        return dec[..., None, None] * h + st, h

    h0 = jnp.zeros((b, G, E, SSD_HEAD_DIM, SSD_STATE), F32)
    h_fin, h_prev = lax.scan(step, h0, (jnp.moveaxis(chunk_decay, 1, 0), jnp.moveaxis(states, 1, 0)))
    h_prev = jnp.moveaxis(h_prev, 0, 1)
    y_off = jnp.einsum('bcign,bcige,bcgepn->bcigep', Cc, jnp.exp(acum), h_prev)
    y = (y_diag + y_off).reshape(b, L, SSD_HEADS, SSD_HEAD_DIM)
    return y, h_fin.reshape(b, SSD_HEADS, SSD_HEAD_DIM, SSD_STATE)


def ssd_recurrent(xs, dt, A, Bm, Cm, h0):
    E = SSD_HEADS // SSD_GROUPS

    def step(h, inp):
        x_t, dt_t, B_t, C_t = inp
        Bh = jnp.repeat(B_t, E, axis=1)
        Ch = jnp.repeat(C_t, E, axis=1)
        h = jnp.exp(dt_t * A)[..., None, None] * h + (dt_t[..., None] * x_t)[..., None] * Bh[:, :, None, :]
        return h, jnp.einsum('bhpn,bhn->bhp', h, Ch)

    inp = (jnp.moveaxis(xs.astype(F32), 1, 0), jnp.moveaxis(dt.astype(F32), 1, 0),
           jnp.moveaxis(Bm.astype(F32), 1, 0), jnp.moveaxis(Cm.astype(F32), 1, 0))
    h, ys = lax.scan(step, h0.astype(F32), inp)
    return jnp.moveaxis(ys, 0, 1), h


def dilated_attn_prompt(q, k, v, dil, window, bias_g):
    b, S, H, hd = q.shape
    blk = window // dil
    Ls = S // dil
    nb = -(-Ls // blk)
    pad = nb * blk - Ls

    def to_sub(t):
        t = t.reshape(b, Ls, dil, H, hd).transpose(0, 2, 1, 3, 4).reshape(b * dil, Ls, H, hd)
        return jnp.pad(t, ((0, 0), (0, pad), (0, 0), (0, 0)))

    def band(t):
        tb = jnp.pad(t, ((0, 0), (blk, 0), (0, 0), (0, 0))).reshape(b * dil, nb + 1, blk, H, hd)
        return jnp.concatenate([tb[:, :-1], tb[:, 1:]], axis=2)

    qb = to_sub(q).reshape(b * dil, nb, blk, H, hd)
    kb, vb = band(to_sub(k)), band(to_sub(v))
    j = blk + jnp.arange(blk)[:, None] - jnp.arange(2 * blk)[None, :]
    valid = ((j >= 0) & (j <= blk))[None] & ((jnp.arange(nb)[:, None, None] > 0)
                                           | (jnp.arange(2 * blk)[None, None, :] >= blk))
    bias = jnp.transpose(bias_g[rel_bucket(jnp.clip(j, 0, blk) * dil)], (2, 0, 1))
    logits = jnp.einsum('nbqhd,nbkhd->nbhqk', qb, kb, preferred_element_type=F32) / math.sqrt(hd)
    logits = jnp.where(valid[None, :, None], logits + bias.astype(F32)[None, None], NEG)
    m = jnp.max(logits, axis=-1, keepdims=True)
    p = jnp.exp(logits - m)
    s = jnp.sum(p, axis=-1, keepdims=True)
    out = jnp.einsum('nbhqk,nbkhd->nbqhd', p / s, vb.astype(F32))
    lse = jnp.transpose((m + jnp.log(s))[..., 0], (0, 1, 3, 2))

    def from_sub(t):
        t = t.reshape(b, dil, nb * blk, *t.shape[3:])[:, :, :Ls]
        return jnp.swapaxes(t, 1, 2).reshape(b, S, *t.shape[3:])

    return from_sub(out), from_sub(lse)


def dilated_attn_sample(q, kv_buf, k_new, v_new, dil, window, bias_g):
    b, T, H, hd = q.shape
    Lw = kv_buf.shape[1]
    kv_ext = jnp.concatenate([kv_buf.astype(k_new.dtype), jnp.stack([k_new, v_new], axis=2)], axis=1)
    nk = window // dil + 1
    jj = jnp.arange(nk)
    idx = Lw + jnp.arange(T)[:, None] - dil * jj[None, :]
    valid = idx >= 0
    g = jnp.take(kv_ext, jnp.clip(idx, 0, None), axis=1)
    bias = bias_g[rel_bucket(dil * jj)].T.astype(F32)
    logits = jnp.einsum('bthd,btjhd->bthj', q, g[:, :, :, 0], preferred_element_type=F32) / math.sqrt(hd)
    logits = jnp.where(valid[None, :, None, :], logits + bias[None, None], NEG)
    m = jnp.max(logits, axis=-1, keepdims=True)
    p = jnp.exp(logits - m)
    s = jnp.sum(p, axis=-1, keepdims=True)
    out = jnp.einsum('bthj,btjhd->bthd', p / s, g[:, :, :, 1].astype(F32))
    lse = (m + jnp.log(s))[..., 0]
    return out, lse, kv_ext[:, -min(window, Lw + T):]


def even_mixer(u, prm, e, conv_prev, ssm_h0, kv_bufs):
    b, t, _ = u.shape
    proj = u @ prm['in_proj_w'][e]
    z, xbc, dt_raw, q, k, v = jnp.split(proj, IN_SPLITS, axis=-1)
    xbc, conv_new = causal_conv(xbc, conv_prev, prm['conv_w'][e], prm['conv_b'][e])
    xs, Bm, Cm = jnp.split(xbc, [SSD_INNER, SSD_INNER + SSD_GROUPS * SSD_STATE], axis=-1)
    xs = xs.reshape(b, t, SSD_HEADS, SSD_HEAD_DIM)
    Bm = Bm.reshape(b, t, SSD_GROUPS, SSD_STATE)
    Cm = Cm.reshape(b, t, SSD_GROUPS, SSD_STATE)
    dt = jax.nn.softplus(dt_raw.astype(F32) + prm['dt_bias'][e].astype(F32))
    A = -jnp.exp(prm['a_log'][e].astype(F32))
    if ssm_h0 is None:
        y, h_new = ssd_chunked(xs, dt, A, Bm, Cm)
    else:
        y, h_new = ssd_recurrent(xs, dt, A, Bm, Cm, ssm_h0)
    y = (y + prm['d_skip'][e].astype(F32)[:, None] * xs.astype(F32)).reshape(b, t, SSD_INNER)
    y = rmsnorm(y * jax.nn.silu(z.astype(F32)), prm['ssd_norm_g'][e])
    q = rmsnorm(q.reshape(b, t, ATT_HEADS, ATT_HEAD_DIM), prm['q_norm_g'][e])
    k = rmsnorm(k.reshape(b, t, ATT_HEADS, ATT_HEAD_DIM), prm['k_norm_g'][e])
    v = v.reshape(b, t, ATT_HEADS, ATT_HEAD_DIM)
    outs, lses, new_bufs = [], [], []
    for gi in range(len(WINDOWS)):
        hs = slice(gi * ATT_HPP, (gi + 1) * ATT_HPP)
        bias_g = prm['rel_bias'][:, hs]
        if kv_bufs is None:
            o, l = dilated_attn_prompt(q[:, :, hs], k[:, :, hs], v[:, :, hs], DILATIONS[gi], WINDOWS[gi], bias_g)
            buf = jnp.stack([k[:, :, hs], v[:, :, hs]], axis=2)[:, -min(WINDOWS[gi], t):]
        else:
            o, l, buf = dilated_attn_sample(q[:, :, hs], kv_bufs[gi], k[:, :, hs], v[:, :, hs],
                                            DILATIONS[gi], WINDOWS[gi], bias_g)
        outs.append(o)
        lses.append(l)
        new_bufs.append(buf)
    wts = jax.nn.softmax(jnp.stack(lses, axis=0), axis=0)
    att = jnp.sum(wts[..., None] * jnp.stack(outs, axis=0), axis=0).reshape(b, t, ATT_OUT)
    mix = jnp.concatenate([y.astype(F32), att], axis=-1).astype(u.dtype) @ prm['out_proj_w'][e]
    return mix.astype(u.dtype), conv_new, h_new, new_bufs


def pool_mixer(u, prev, pos0, w_pool, scale):
    b, t, _ = u.shape
    ext = jnp.concatenate([prev.astype(u.dtype), u], axis=1)
    cs = jnp.pad(jnp.cumsum(ext.astype(F32), axis=1), ((0, 0), (1, 0), (0, 0)))
    pos = pos0 + jnp.arange(t)
    pooled = []
    for gi, w in enumerate(POOL_WINDOWS):
        ch = slice(gi * POOL_CH, (gi + 1) * POOL_CH)
        s = cs[:, POOL_MAX:POOL_MAX + t, ch] - cs[:, POOL_MAX - w:POOL_MAX - w + t, ch]
        cnt = jnp.minimum(w, pos + 1).astype(F32)[None, :, None]
        pooled.append(s / cnt - u[:, :, ch].astype(F32))
    pg = jnp.stack(pooled, axis=2)
    out = jnp.einsum('btgc,gcd->btgd', pg, w_pool.astype(F32)).reshape(b, t, D_MODEL) * scale.astype(F32)
    return out.astype(u.dtype), ext[:, -(POOL_MAX - 1):]


def trunk(x, c, prm, past):
    b, t, _ = x.shape
    ssm_l, conv_l, pool_l = [], [], []
    kv_l = [[] for _ in WINDOWS]
    for layer in range(DEPTH):
        mod = jax.nn.silu(c.astype(F32)) @ prm['ada_w'][layer].astype(F32) + prm['ada_b'][layer].astype(F32)
        sh1, sc1, g1, sh2, sc2, g2 = jnp.split(mod[:, None, :].astype(x.dtype), 6, axis=-1)
        u = rmsnorm(x, prm['norm_mix_g'][layer]) * (1 + sc1) + sh1
        if layer % 2 == 0:
            e = layer // 2
            if past is None:
                conv_prev = jnp.zeros((b, SSD_CONV - 1, CONV_DIM), x.dtype)
                h0, bufs = None, None
            else:
                conv_prev, h0, bufs = past[1][e], past[0][e], [cache[e] for cache in past[2]]
            mix, conv_new, h_new, bufs_new = even_mixer(u, prm, e, conv_prev, h0, bufs)
            ssm_l.append(h_new)
            conv_l.append(conv_new)
            for gi in range(len(WINDOWS)):
                kv_l[gi].append(bufs_new[gi])
        else:
            o = layer // 2
            if past is None:
                prev, pos0 = jnp.zeros((b, POOL_MAX - 1, D_MODEL), x.dtype), 0
            else:
                prev, pos0 = past[3][o], PAST_LEN
            mix, pool_new = pool_mixer(u, prev, pos0, prm['pool_w'][o], prm['pool_scale'][o])
            pool_l.append(pool_new)
        x = x + g1 * mix
        u = rmsnorm(x, prm['norm_mlp_g'][layer]) * (1 + sc2) + sh2
        hdn = jnp.square(jax.nn.relu(u @ prm['mlp_w1'][layer]))
        x = x + g2 * (hdn @ prm['mlp_w2'][layer])
    return (x, jnp.stack(ssm_l), jnp.stack(conv_l), jnp.stack(kv_l[0]), jnp.stack(kv_l[1]),
            jnp.stack(kv_l[2]), jnp.stack(pool_l))


def setup_inputs(seed: int = 0) -> dict:
    key = jax.random.key(seed)
    ks = jax.random.split(key, 32)

    def nrm(k, shape, s):
        return s * jax.random.normal(k, shape, F32)

    def kv_shape(w):
        return (N_EVEN, DEC_BATCH, min(w, PAST_LEN), 2, ATT_HPP, ATT_HEAD_DIM)

    dt0 = jnp.exp(jax.random.uniform(ks[20], (N_EVEN, SSD_HEADS), F32, math.log(1e-3), math.log(1e-1)))
    return {
        "x_prompt": nrm(ks[0], (BATCH, SEQ, D_MODEL), 1.0),
        "x_sample": nrm(ks[1], (DEC_BATCH, DEC_SEQ, D_MODEL), 1.0),
        "state_ssm": nrm(ks[2], (N_EVEN, DEC_BATCH, SSD_HEADS, SSD_HEAD_DIM, SSD_STATE), 0.5),
        "state_conv": nrm(ks[3], (N_EVEN, DEC_BATCH, SSD_CONV - 1, CONV_DIM), 1.0),
        "cache_kv_w128": nrm(ks[4], kv_shape(WINDOWS[0]), 1.0),
        "cache_kv_w512": nrm(ks[5], kv_shape(WINDOWS[1]), 1.0),
        "cache_kv_w2048": nrm(ks[6], kv_shape(WINDOWS[2]), 1.0),
        "state_pool": nrm(ks[7], (N_ODD, DEC_BATCH, POOL_MAX - 1, D_MODEL), 1.0),
        "c_prompt": nrm(ks[8], (BATCH, D_MODEL), 1.0),
        "c_sample": nrm(ks[9], (DEC_BATCH, D_MODEL), 1.0),
        "rel_bias": nrm(ks[10], (REL_BUCKETS, ATT_HEADS), 0.5),
        "ada_w": nrm(ks[11], (DEPTH, D_MODEL, 6 * D_MODEL), 0.5 * D_MODEL ** -0.5),
        "ada_b": nrm(ks[12], (DEPTH, 6 * D_MODEL), 0.02),
        "norm_mix_g": 1.0 + nrm(ks[13], (DEPTH, D_MODEL), 0.05),
        "norm_mlp_g": 1.0 + nrm(ks[14], (DEPTH, D_MODEL), 0.05),
        "in_proj_w": nrm(ks[15], (N_EVEN, D_MODEL, IN_COLS), D_MODEL ** -0.5),
        "conv_w": nrm(ks[16], (N_EVEN, SSD_CONV, CONV_DIM), SSD_CONV ** -0.5),
        "conv_b": nrm(ks[17], (N_EVEN, CONV_DIM), 0.02),
        "dt_bias": dt0 + jnp.log(-jnp.expm1(-dt0)),
        "a_log": jnp.log(jax.random.uniform(ks[18], (N_EVEN, SSD_HEADS), F32, 1.0, 16.0)),
        "d_skip": 1.0 + nrm(ks[19], (N_EVEN, SSD_HEADS), 0.1),
        "ssd_norm_g": 1.0 + nrm(ks[21], (N_EVEN, SSD_INNER), 0.05),
        "q_norm_g": 1.0 + nrm(ks[22], (N_EVEN, ATT_HEAD_DIM), 0.05),
        "k_norm_g": 1.0 + nrm(ks[23], (N_EVEN, ATT_HEAD_DIM), 0.05),
        "out_proj_w": nrm(ks[24], (N_EVEN, MIX_OUT, D_MODEL), MIX_OUT ** -0.5),
        "pool_w": nrm(ks[25], (N_ODD, POOL_GROUPS, POOL_CH, POOL_CH), POOL_CH ** -0.5),
        "pool_scale": 1.0 + nrm(ks[26], (N_ODD, D_MODEL), 0.1),
        "mlp_w1": nrm(ks[27], (DEPTH, D_MODEL, D_FF), D_MODEL ** -0.5),
        "mlp_w2": nrm(ks[28], (DEPTH, D_FF, D_MODEL), D_FF ** -0.5),
    }


def reference(x_prompt, x_sample, state_ssm, state_conv, cache_kv_w128, cache_kv_w512, cache_kv_w2048,
              state_pool, c_prompt, c_sample, rel_bias, ada_w, ada_b, norm_mix_g, norm_mlp_g, in_proj_w,
              conv_w, conv_b, dt_bias, a_log, d_skip, ssd_norm_g, q_norm_g, k_norm_g, out_proj_w,
              pool_w, pool_scale, mlp_w1, mlp_w2):
    prm = {
        "rel_bias": rel_bias, "ada_w": ada_w, "ada_b": ada_b, "norm_mix_g": norm_mix_g,
        "norm_mlp_g": norm_mlp_g, "in_proj_w": in_proj_w, "conv_w": conv_w, "conv_b": conv_b,
        "dt_bias": dt_bias, "a_log": a_log, "d_skip": d_skip, "ssd_norm_g": ssd_norm_g,
        "q_norm_g": q_norm_g, "k_norm_g": k_norm_g, "out_proj_w": out_proj_w, "pool_w": pool_w,
        "pool_scale": pool_scale, "mlp_w1": mlp_w1, "mlp_w2": mlp_w2,
    }
    y_prompt, p_ssm, p_conv, p_kv128, p_kv512, p_kv2048, p_pool = trunk(x_prompt, c_prompt, prm, None)
    past = (state_ssm, state_conv, [cache_kv_w128, cache_kv_w512, cache_kv_w2048], state_pool)
    y_sample, s_ssm, s_conv, s_kv128, s_kv512, s_kv2048, s_pool = trunk(x_sample, c_sample, prm, past)
    return (y_prompt, y_sample, p_ssm, p_conv, p_kv128, p_kv512, p_kv2048, p_pool,
            s_ssm, s_conv, s_kv128, s_kv512, s_kv2048, s_pool)
```

```cpp
#include <hip/hip_runtime.h>
#include <hip/hip_cooperative_groups.h>
#include <cstdio>
#include <cstdint>
namespace cg = cooperative_groups;

#ifndef MK_ONE_LAUNCH
#define MK_ONE_LAUNCH 1
#endif

#define LAS __attribute__((address_space(3)))
typedef unsigned short bf16;
typedef short bf16x8 __attribute__((ext_vector_type(8)));
typedef float f32x4 __attribute__((ext_vector_type(4)));
typedef float f32x2 __attribute__((ext_vector_type(2)));
typedef unsigned u32x4 __attribute__((ext_vector_type(4)));
typedef unsigned u32x2 __attribute__((ext_vector_type(2)));

constexpr int D = 2048, BATCH = 4, SEQ = 2048, MP = BATCH * SEQ, SB = 8;
constexpr int NH = 32, HP = 64, SN = 128, SG = 8, INNER = 2048, CONVD = 4096;
constexpr int AH = 24, HD = 128, HPP = 8, AQKV = 3072, AOUT = 1024;
constexpr int INC = 15392, INP = 15616;
constexpr int CZ = 0, CX = 2048, CQ = 6144, CK = 9216, CV = 12288, CDT = 15360;
constexpr int MIXK = 3072, DFF = 8192, MODW = 6 * D;
constexpr float EPS = 1e-6f;
constexpr int NWAVES = 8, NT = 512;

enum { I_XP = 0, I_XS, I_SSM, I_CONV, I_KV128, I_KV512, I_KV2048, I_POOL, I_CP, I_CS, I_RELB, I_ADAW, I_ADAB, I_NMIX, I_NMLP, I_INW, I_CONVW, I_CONVB,
       I_DTB, I_ALOG, I_DSKIP, I_SSDG, I_QG, I_KG, I_OUTW, I_POOLW, I_POOLS, I_W1, I_W2, N_IN };

constexpr size_t O_YP = 0;
constexpr size_t O_YS = O_YP + (size_t)MP * D;
constexpr size_t O_PSSM = O_YS + (size_t)SB * D;
constexpr size_t O_PCONV = O_PSSM + (size_t)BATCH * NH * HP * SN;
constexpr size_t O_PKV128 = O_PCONV + (size_t)BATCH * 3 * CONVD;
constexpr size_t O_PKV512 = O_PKV128 + (size_t)BATCH * 128 * 2048;
constexpr size_t O_PKV2048 = O_PKV512 + (size_t)BATCH * 512 * 2048;
constexpr size_t O_PPOOL = O_PKV2048 + (size_t)BATCH * 2048 * 2048;
constexpr size_t O_SSSM = O_PPOOL + (size_t)BATCH * 15 * D;
constexpr size_t O_SCONV = O_SSSM + (size_t)SB * NH * HP * SN;
constexpr size_t O_SKV128 = O_SCONV + (size_t)SB * 3 * CONVD;
constexpr size_t O_SKV512 = O_SKV128 + (size_t)SB * 128 * 2048;
constexpr size_t O_SKV2048 = O_SKV512 + (size_t)SB * 512 * 2048;
constexpr size_t O_SPOOL = O_SKV2048 + (size_t)SB * 2048 * 2048;
constexpr size_t O_END = O_SPOOL + (size_t)SB * 15 * D;

constexpr size_t MiB = 1u << 20;
constexpr size_t WS_CTL = 0;
constexpr size_t WS_MOD = 1 * MiB;
constexpr size_t WS_WIN = 4 * MiB;
constexpr size_t WS_WOUT = 66 * MiB;
constexpr size_t WS_W1 = 78 * MiB;
constexpr size_t WS_W2 = 142 * MiB;
constexpr size_t WS_WPOOL = 206 * MiB;
constexpr size_t WS_A0 = 208 * MiB;
constexpr size_t WS_SMP = 240 * MiB;
constexpr size_t WS_PROJ = 244 * MiB;
constexpr size_t WS_HDN = WS_PROJ;
constexpr size_t WS_U = WS_PROJ + 128 * MiB;
constexpr size_t WS_XC = 488 * MiB;
constexpr size_t WS_Y = 552 * MiB;
constexpr size_t WS_ATT = 616 * MiB;
constexpr size_t WS_LSE = 664 * MiB;
constexpr size_t WS_DT = 665 * MiB;
constexpr size_t WS_A1 = 668 * MiB;
constexpr size_t WS_END = 716 * MiB;
constexpr size_t SM_USBF = 0;
constexpr size_t SM_PROJ = 64 * 1024;
constexpr size_t SM_XC = 576 * 1024;
constexpr size_t SM_DT = 704 * 1024;
constexpr size_t SM_QK = 708 * 1024;
constexpr size_t SM_Y = 900 * 1024;
constexpr size_t SM_ATT = 964 * 1024;
constexpr size_t SM_LSE = 1060 * 1024;
constexpr size_t SM_A1BF = 1064 * 1024;
constexpr size_t SM_X1 = 1112 * 1024;
constexpr size_t SM_HBF = 1176 * 1024;
constexpr size_t SM_X2 = 1304 * 1024;
constexpr size_t SM_PGBF = 1368 * 1024;
constexpr size_t SM_X3 = 1400 * 1024;
constexpr size_t SM_H0 = 1500 * 1024;
constexpr size_t SM_H1 = 1756 * 1024;
constexpr size_t WS_RS = 667 * MiB;

constexpr int LDS_BYTES = 147456;

struct P { const float* in[N_IN]; float* out; unsigned char* ws; int ph_lo, ph_hi; };
static_assert(sizeof(P) == 8 * (N_IN + 2) + 8, "no padding in P");
typedef const __attribute__((address_space(4))) P CP;

__device__ __forceinline__ float bf2f(unsigned b) { return __uint_as_float(b << 16); }
__device__ __forceinline__ unsigned f2bf(float f) { unsigned u = __float_as_uint(f); return (u + 0x7fffu + ((u >> 16) & 1u)) >> 16; }
typedef float f32x2v_ __attribute__((ext_vector_type(2)));
typedef __bf16 bf16x2v_ __attribute__((ext_vector_type(2)));
__device__ __forceinline__ unsigned pk2(float lo, float hi) { const f32x2v_ v = {lo, hi}; return __builtin_bit_cast(unsigned, __builtin_convertvector(v, bf16x2v_)); }
__device__ __forceinline__ float wave_sum(float v) {
#pragma unroll
    for (int o = 1; o < 64; o <<= 1) v += __shfl_xor(v, o);
    return v;
}
__device__ __forceinline__ float wave_max(float v) {
#pragma unroll
    for (int o = 1; o < 64; o <<= 1) v = fmaxf(v, __shfl_xor(v, o));
    return v;
}
__device__ __forceinline__ float siluf(float x) { return x * __builtin_amdgcn_rcpf(1.f + __expf(-x)); }
__device__ __forceinline__ float softplusf(float x) { return log1pf(__expf(-fabsf(x))) + fmaxf(x, 0.f); }
#define LDS_WAIT() asm volatile("s_waitcnt lgkmcnt(0)" ::: "memory")

namespace pg8 {
constexpr int BM = 256, BK = 64, HALF = 128, HTB = HALF * BK * 2, STAGE_BYTES = 8 * HTB, NXCD = 8, WGM = 4;
__host__ __device__ __forceinline__ int lds_byte(int r, int c) { const int st = (r >> 4) * 2 + (c >> 5), rr = r & 15, cc = c & 31, ob = rr * 64 + cc * 2; return st * 1024 + (ob ^ (((ob >> 9) & 1) << 5)); }
__host__ __device__ __forceinline__ void stage_rc(int b, int& R, int& C) { const int st = b / 1024, sb = b % 1024, swz = sb ^ (((sb >> 9) & 1) << 5); R = (st >> 1) * 16 + swz / 64; C = (st & 1) * 32 + (swz % 64) / 2; }
__host__ __device__ __forceinline__ int perm32(int rho) { const int n = rho >> 4, i = rho & 15; return 8 * (i >> 2) + 4 * n + (i & 3); }
struct Unit { int pm, pn; };
struct Gemm { const bf16* A; const bf16* Bt; int M, N, K, lda, ldb, agrp; int akt = 0, bkt = 0; };
struct StaticOrder {
    int nM, nN, nwg, G, c;
    __device__ void init(int M, int N, int G_, int c_) { nM = M / BM; nN = N / BM; nwg = nM * nN; G = G_; c = c_; }
    __device__ bool next(int i, Unit& u) const {
        const long L = (long)i * G + c; if (L >= nwg) return false;
        int wgid = (int)L; { const int q = nwg / NXCD, r = nwg % NXCD, xcd = wgid % NXCD, off = wgid / NXCD; wgid = (xcd < r ? xcd * (q + 1) : r * (q + 1) + (xcd - r) * q) + off; }
        const int nig = WGM * nN, gid = wgid / nig, fm = gid * WGM, gsz = (nM - fm) < WGM ? (nM - fm) : WGM;
        u.pm = fm + ((wgid % nig) % gsz); u.pn = (wgid % nig) / gsz;
        { const int rot = gid * (nN / NXCD); u.pn = (u.pn + rot) % nN; }
        return true;
    }
};
__device__ __forceinline__ unsigned cvt_pk_bf16(float lo, float hi) { unsigned r; asm volatile("v_cvt_pk_bf16_f32 %0, %1, %2" : "=v"(r) : "v"(lo), "v"(hi)); return r; }

template <int ACT  > struct EpiBf16 {
    static constexpr bool PERM = true;
    bf16* O; int ldc; int okt;
    __device__ __forceinline__ void operator()(const f32x4 (&acc)[2][2][4][2], const Unit& u, int wr, int wc, int fr, int fq) const {
        const int row0 = u.pm * BM + wr * 64 + fr; const int col0 = u.pn * BM + wc * 32 + 8 * fq;
#pragma unroll
        for (int ai = 0; ai < 2; ++ai)
#pragma unroll
            for (int m = 0; m < 4; ++m) { const int rrow = row0 + ai * HALF + m * 16; bf16* rowp = okt ? O + ((size_t)(rrow >> 8) * okt + (col0 >> 6)) * 16384 + (rrow & 255) * 64 + (col0 & 63) : O + (size_t)rrow * ldc + col0;
#pragma unroll
                for (int bj = 0; bj < 2; ++bj) { f32x4 v0 = acc[ai][bj][m][0], v1 = acc[ai][bj][m][1];
                    if (ACT == 1) {
#pragma unroll
                        for (int j = 0; j < 4; ++j) { const float a = fmaxf(v0[j], 0.f), b = fmaxf(v1[j], 0.f); v0[j] = a * a; v1[j] = b * b; } }
                    u32x4 w; w.x = cvt_pk_bf16(v0[0], v0[1]); w.y = cvt_pk_bf16(v0[2], v0[3]); w.z = cvt_pk_bf16(v1[0], v1[1]); w.w = cvt_pk_bf16(v1[2], v1[3]);
                    *(u32x4*)(rowp + (okt ? bj * 2 * 16384 : bj * HALF)) = w; } }
    }
};
template <bool BIN  , bool BOUT  > struct EpiResid {
    static constexpr bool PERM = true;
    const void* base; void* out; int ldc; const float* gate; int gate_bstride; const float* cscale; float* rowss;
    __device__ __forceinline__ void operator()(const f32x4 (&acc)[2][2][4][2], const Unit& u, int wr, int wc, int fr, int fq) const {
        const int row0 = u.pm * BM + wr * 64 + fr, col0 = u.pn * BM + wc * 32 + 8 * fq;
        const float* gp = gate + (size_t)(u.pm / 8) * gate_bstride;
        f32x4 gv[2][2];
#pragma unroll
        for (int bj = 0; bj < 2; ++bj)
#pragma unroll
            for (int n = 0; n < 2; ++n) { gv[bj][n] = *(const f32x4*)(gp + col0 + bj * HALF + 4 * n); if (cscale) gv[bj][n] = gv[bj][n] * *(const f32x4*)(cscale + col0 + bj * HALF + 4 * n); }
#pragma unroll
        for (int ai = 0; ai < 2; ++ai)
#pragma unroll
            for (int m = 0; m < 4; ++m) { const size_t off = (size_t)(row0 + ai * HALF + m * 16) * ldc + col0; float ssq = 0.f;
#pragma unroll
                for (int bj = 0; bj < 2; ++bj) { f32x4 b0, b1;
                    if (BIN) { const u32x4 x = *(const u32x4*)((const bf16*)base + off + bj * HALF);
                        b0 = (f32x4){__uint_as_float(x.x << 16), __uint_as_float(x.x & 0xffff0000u), __uint_as_float(x.y << 16), __uint_as_float(x.y & 0xffff0000u)};
                        b1 = (f32x4){__uint_as_float(x.z << 16), __uint_as_float(x.z & 0xffff0000u), __uint_as_float(x.w << 16), __uint_as_float(x.w & 0xffff0000u)}; }
                    else { b0 = *(const f32x4*)((const float*)base + off + bj * HALF); b1 = *(const f32x4*)((const float*)base + off + bj * HALF + 4); }
                    const f32x4 o0 = b0 + gv[bj][0] * acc[ai][bj][m][0], o1 = b1 + gv[bj][1] * acc[ai][bj][m][1];
                    if (BOUT) { u32x4 w; w.x = cvt_pk_bf16(o0[0], o0[1]); w.y = cvt_pk_bf16(o0[2], o0[3]); w.z = cvt_pk_bf16(o1[0], o1[1]); w.w = cvt_pk_bf16(o1[2], o1[3]); *(u32x4*)((bf16*)out + off + bj * HALF) = w; }
                    else { *(f32x4*)((float*)out + off + bj * HALF) = o0; *(f32x4*)((float*)out + off + bj * HALF + 4) = o1; }
                    ssq += (o0.x * o0.x + o0.y * o0.y) + (o0.z * o0.z + o0.w * o0.w) + (o1.x * o1.x + o1.y * o1.y) + (o1.z * o1.z + o1.w * o1.w); }
                if (rowss) { ssq += __shfl_xor(ssq, 16); ssq += __shfl_xor(ssq, 32); if (fq == 0) atomicAdd(rowss + row0 + ai * HALF + m * 16, ssq); } }
    }
};


struct EpiProj {
    static constexpr bool PERM = true;
    bf16* O; float* dtout; float* out; const float* qg; const float* kg; const float* dtb; LAS float* xch;
    __device__ __forceinline__ void operator()(const f32x4 (&acc)[2][2][4][2], const Unit& u, int wr, int wc, int fr, int fq) const {
        const int rt0 = wr * 64 + fr;
        const int row0 = u.pm * BM + rt0, colt = u.pn * BM, cw8 = wc * 32 + 8 * fq;
        const int b = u.pm >> 3, tb = (u.pm & 7) * BM;
        if (u.pn == 60) {
            if (wc == 0) { const f32x4 b0 = *(const f32x4*)(dtb + 8 * fq), b1 = *(const f32x4*)(dtb + 8 * fq + 4);
#pragma unroll
                for (int ai = 0; ai < 2; ++ai)
#pragma unroll
                    for (int m = 0; m < 4; ++m) { float* d = dtout + (size_t)(row0 + ai * HALF + m * 16) * 32 + 8 * fq; const f32x4 v0 = acc[ai][0][m][0] + b0, v1 = acc[ai][0][m][1] + b1;
                        *(f32x4*)d = (f32x4){softplusf(v0.x), softplusf(v0.y), softplusf(v0.z), softplusf(v0.w)}; *(f32x4*)(d + 4) = (f32x4){softplusf(v1.x), softplusf(v1.y), softplusf(v1.z), softplusf(v1.w)}; } }
            return;
        }
        const bool isq = u.pn >= 24 && u.pn < 36, isk = u.pn >= 36 && u.pn < 48, isv = u.pn >= 48, isx = u.pn >= 8 && u.pn < 24;
        float scl[2][4][2];
        f32x4 g0 = (f32x4){1.f, 1.f, 1.f, 1.f}, g1 = g0;
        if (isq || isk) {
#pragma unroll
            for (int ai = 0; ai < 2; ++ai)
#pragma unroll
                for (int m = 0; m < 4; ++m)
#pragma unroll
                    for (int bj = 0; bj < 2; ++bj) { const f32x4 a = acc[ai][bj][m][0], c2 = acc[ai][bj][m][1];
                        float ssq = (a.x * a.x + a.y * a.y) + (a.z * a.z + a.w * a.w) + (c2.x * c2.x + c2.y * c2.y) + (c2.z * c2.z + c2.w * c2.w);
                        ssq += __shfl_xor(ssq, 16); ssq += __shfl_xor(ssq, 32);
                        if (fq == 0) xch[((ai * HALF + rt0 + m * 16) * 2 + bj) * 4 + wc] = ssq; }
            asm volatile("s_waitcnt lgkmcnt(0)" ::: "memory"); __builtin_amdgcn_s_barrier(); asm volatile("" ::: "memory");
#pragma unroll
            for (int ai = 0; ai < 2; ++ai)
#pragma unroll
                for (int m = 0; m < 4; ++m)
#pragma unroll
                    for (int bj = 0; bj < 2; ++bj) { const f32x4 pz = *(const LAS f32x4*)(xch + ((ai * HALF + rt0 + m * 16) * 2 + bj) * 4);
                        scl[ai][m][bj] = rsqrtf(((pz.x + pz.y) + (pz.z + pz.w)) * (1.f / 128.f) + 1e-6f); }
            const float* gp = (isq ? qg : kg) + cw8; g0 = *(const f32x4*)gp; g1 = *(const f32x4*)(gp + 4);
        } else {
#pragma unroll
            for (int ai = 0; ai < 2; ++ai)
#pragma unroll
                for (int m = 0; m < 4; ++m) { scl[ai][m][0] = 1.f; scl[ai][m][1] = 1.f; }
        }
#pragma unroll
        for (int ai = 0; ai < 2; ++ai)
#pragma unroll
            for (int m = 0; m < 4; ++m) { const int rr = ai * HALF + m * 16; bf16* rowp = O + (size_t)(row0 + rr) * ldo() + colt + cw8; const int t = tb + rt0 + rr;
#pragma unroll
                for (int bj = 0; bj < 2; ++bj) { const f32x4 v0 = acc[ai][bj][m][0] * scl[ai][m][bj] * g0, v1 = acc[ai][bj][m][1] * scl[ai][m][bj] * g1;
                    u32x4 w; w.x = cvt_pk_bf16(v0[0], v0[1]); w.y = cvt_pk_bf16(v0[2], v0[3]); w.z = cvt_pk_bf16(v1[0], v1[1]); w.w = cvt_pk_bf16(v1[2], v1[3]);
                    *(u32x4*)(rowp + bj * HALF) = w;
                    if (isk || isv) { const int hd = (u.pn - (isk ? 36 : 48)) * 2 + bj, gi = hd >> 3, slot = hd & 7, W = gi == 0 ? 128 : (gi == 1 ? 512 : 2048);
                        if (t >= 2048 - W) { float* o = out + (gi == 0 ? O_PKV128 : (gi == 1 ? O_PKV512 : O_PKV2048)) + (((size_t)b * W + (t - (2048 - W))) * 2 + (isv ? 1 : 0)) * 1024 + slot * 128 + cw8;
                            *(f32x4*)o = v0; *(f32x4*)(o + 4) = v1; } }
                    if (isx && t >= 2045) { float* o = out + O_PCONV + ((size_t)b * 3 + (t - 2045)) * 4096 + (colt - 2048) + bj * HALF + cw8; *(f32x4*)o = v0; *(f32x4*)(o + 4) = v1; } } }
    }
    __device__ __forceinline__ static constexpr int ldo() { return 15616; }
};

struct NoHook { static constexpr int T = -1; __device__ __forceinline__ void operator()(f32x4 (&)[2][2][4][2], const Unit&, int, int) const {} };
struct RowScaleHook { static constexpr int T = 32; const float* ss;
    __device__ __forceinline__ void operator()(f32x4 (&acc)[2][2][4][2], const Unit& u, int wr, int fr) const {
#pragma unroll
        for (int ai = 0; ai < 2; ++ai)
#pragma unroll
            for (int m = 0; m < 4; ++m) { const float rs = rsqrtf(ss[u.pm * BM + ai * HALF + wr * 64 + m * 16 + fr] * (1.f / 2048.f) + 1e-6f);
#pragma unroll
                for (int bj = 0; bj < 2; ++bj)
#pragma unroll
                    for (int n = 0; n < 2; ++n) acc[ai][bj][m][n] = acc[ai][bj][m][n] * rs; } } };
template <class Epi, bool ALIGN_EPI = true, class Hook = NoHook>
__device__ __forceinline__ void gemm_phase(LAS unsigned char* lds, const Gemm g, const StaticOrder& S, const Epi& E, const Hook& H = Hook()) {
    const int tid = threadIdx.x, wid = __builtin_amdgcn_readfirstlane(tid >> 6), lane = tid & 63, wr = wid >> 2, wc = wid & 3, fr = lane & 15, fq = lane >> 4;
    const int K = g.K, nt = K / BK;
    unsigned voffA[2], voffB[2];
#pragma unroll
    for (int i = 0; i < 2; ++i) { int R, C; stage_rc(tid * 16 + i * 8192, R, C); const int Rb = Epi::PERM ? ((R & ~31) + perm32(R & 31)) : R;
        voffA[i] = (unsigned)(R * (g.akt ? 64 : g.lda) + C) * 2u; voffB[i] = (unsigned)(Rb * (g.bkt ? 64 : g.ldb) + C) * 2u; }
    const size_t kstepA = g.akt ? (size_t)32768 : (size_t)(BK * 2), kstepB = g.bkt ? (size_t)32768 : (size_t)(BK * 2);
    const size_t hstepA = (size_t)HALF * (g.akt ? 64 : g.lda) * 2, hstepB = (size_t)HALF * (g.bkt ? 64 : g.ldb) * 2;
    const size_t tstepA = g.akt ? (size_t)g.akt * 32768 : 2 * hstepA, tstepB = g.bkt ? (size_t)g.bkt * 32768 : 2 * hstepB;
    const unsigned ldsw = (unsigned)wid * 1024u;
    const int aoff = lds_byte(wr * 64 + fr, fq * 8), boff = lds_byte(wc * 32 + fr, fq * 8);
#define PG8_SA(b, h) (((b) * 2 + (h)) * HTB)
#define PG8_SB(b, h) ((4 + (b) * 2 + (h)) * HTB)
#define PG8_STAGE(bufoff, gbase, voff) do { _Pragma("unroll") for (int _i = 0; _i < 2; ++_i) \
        __builtin_amdgcn_global_load_lds((const unsigned*)((const char*)(gbase) + (voff)[_i]), (LAS unsigned*)(lds + (bufoff) + ldsw + _i * 8192), 16, 0, 0); } while (0)
#define PG8_LDA(dst, b, h) do { _Pragma("unroll") for (int m = 0; m < 4; ++m) _Pragma("unroll") for (int k = 0; k < 2; ++k) dst[m][k] = *(const LAS bf16x8*)(lds + PG8_SA(b, h) + aoff + m * 2048 + k * 1024); } while (0)
#define PG8_LDB(dst, b, h) do { _Pragma("unroll") for (int n = 0; n < 2; ++n) _Pragma("unroll") for (int k = 0; k < 2; ++k) dst[n][k] = *(const LAS bf16x8*)(lds + PG8_SB(b, h) + boff + n * 2048 + k * 1024); } while (0)
#define PG8_MMA(ai, bj, At, Bt) do { __builtin_amdgcn_s_setprio(1); _Pragma("unroll") for (int m = 0; m < 4; ++m) _Pragma("unroll") for (int n = 0; n < 2; ++n) _Pragma("unroll") for (int k = 0; k < 2; ++k) \
        acc[ai][bj][m][n] = __builtin_amdgcn_mfma_f32_16x16x32_bf16(Bt[n][k], At[m][k], acc[ai][bj][m][n], 0, 0, 0); __builtin_amdgcn_s_setprio(0); } while (0)
#define PG8_WAIT_V(n) asm volatile("s_waitcnt vmcnt(" #n ")" ::: "memory")
#define PG8_WAIT_L(n) asm volatile("s_waitcnt lgkmcnt(" #n ")" ::: "memory")
#define PG8_BAR __builtin_amdgcn_s_barrier()
#define PG8_SCHED __builtin_amdgcn_sched_barrier(0)
    Unit cur, nxt; int ui = 0;
    if (!S.next(0, cur)) return;
    f32x4 acc[2][2][4][2];
#pragma unroll
    for (int a = 0; a < 2; ++a)
#pragma unroll
        for (int b = 0; b < 2; ++b)
#pragma unroll
            for (int m = 0; m < 4; ++m)
#pragma unroll
                for (int n = 0; n < 2; ++n) acc[a][b][m][n] = (f32x4){0.f, 0.f, 0.f, 0.f};
    bf16x8 At[4][2], B0[2][2], B1[2][2];
    const char* cA = (const char*)g.A + (size_t)cur.pm * tstepA + (size_t)(cur.pn / g.agrp) * (K / BK) * kstepA; const char* cB = (const char*)g.Bt + (size_t)cur.pn * tstepB;
    PG8_STAGE(PG8_SB(0, 0), cB, voffB); PG8_STAGE(PG8_SB(0, 1), cB + hstepB, voffB); PG8_STAGE(PG8_SA(0, 0), cA, voffA); PG8_STAGE(PG8_SA(0, 1), cA + hstepA, voffA);
    if (wr == 1) PG8_BAR;
    PG8_WAIT_V(2); PG8_BAR;
    PG8_STAGE(PG8_SB(1, 0), cB + kstepB, voffB); PG8_STAGE(PG8_SA(1, 0), cA + kstepA, voffA); PG8_STAGE(PG8_SB(1, 1), cB + hstepB + kstepB, voffB);
    PG8_WAIT_V(6); PG8_BAR;
    for (;;) {
        const bool has_next = S.next(ui + 1, nxt);
        const char* nA = has_next ? (const char*)g.A + (size_t)nxt.pm * tstepA + (size_t)(nxt.pn / g.agrp) * (K / BK) * kstepA : cA; const char* nB = has_next ? (const char*)g.Bt + (size_t)nxt.pn * tstepB : cB;
        for (int t = 0; t < nt; t += 2) {
            const bool last = (t == nt - 2);
            if constexpr (Hook::T >= 0) { if (t == Hook::T) H(acc, cur, wr, fr); }
            const char* a1 = cA + (size_t)(t + 1) * kstepA;
            const char* a2 = last ? nA : cA + (size_t)(t + 2) * kstepA; const char* b2 = last ? nB : cB + (size_t)(t + 2) * kstepB;
            const char* a3 = a2 + kstepA; const char* b3 = b2 + kstepB;
            PG8_LDB(B0, 0, 0); PG8_LDB(B1, 0, 1); PG8_SCHED; PG8_LDA(At, 0, 0); PG8_STAGE(PG8_SA(1, 1), a1 + hstepA, voffA);
            PG8_WAIT_V(8); PG8_WAIT_L(0); PG8_BAR; PG8_MMA(0, 0, At, B0); PG8_MMA(0, 1, At, B1); PG8_BAR; PG8_SCHED;
            PG8_LDA(At, 0, 1); PG8_STAGE(PG8_SB(0, 0), b2, voffB); PG8_STAGE(PG8_SB(0, 1), b2 + hstepB, voffB); PG8_STAGE(PG8_SA(0, 0), a2, voffA);
            PG8_WAIT_V(8); PG8_WAIT_L(0); PG8_BAR; PG8_MMA(1, 0, At, B0); PG8_MMA(1, 1, At, B1); PG8_BAR; PG8_SCHED;
            PG8_LDB(B0, 1, 0); PG8_LDB(B1, 1, 1); PG8_SCHED; PG8_LDA(At, 1, 0); PG8_STAGE(PG8_SA(0, 1), a2 + hstepA, voffA);
            PG8_WAIT_V(8); PG8_WAIT_L(0); PG8_BAR; PG8_MMA(0, 0, At, B0); PG8_MMA(0, 1, At, B1); PG8_BAR; PG8_SCHED;
            PG8_LDA(At, 1, 1); PG8_STAGE(PG8_SB(1, 0), b3, voffB); PG8_STAGE(PG8_SB(1, 1), b3 + hstepB, voffB); PG8_STAGE(PG8_SA(1, 0), a3, voffA);
            PG8_WAIT_V(8); PG8_WAIT_L(0); PG8_BAR; PG8_MMA(1, 0, At, B0); PG8_MMA(1, 1, At, B1); PG8_BAR; PG8_SCHED;
        }
        if constexpr (ALIGN_EPI) { if (wr == 0) PG8_BAR; }
        E(acc, cur, wr, wc, fr, fq);
        if (!has_next) break;
#pragma unroll
        for (int a = 0; a < 2; ++a)
#pragma unroll
            for (int b = 0; b < 2; ++b)
#pragma unroll
                for (int m = 0; m < 4; ++m)
#pragma unroll
                    for (int n = 0; n < 2; ++n) acc[a][b][m][n] = (f32x4){0.f, 0.f, 0.f, 0.f};
        cur = nxt; cA = nA; cB = nB; ++ui;
        if constexpr (ALIGN_EPI) { if (wr == 1) PG8_BAR; }
    }
    PG8_WAIT_V(0);
    if constexpr (!ALIGN_EPI) { if (wr == 0) PG8_BAR; }
    PG8_BAR;
#undef PG8_SA
#undef PG8_SB
#undef PG8_STAGE
#undef PG8_LDA
#undef PG8_LDB
#undef PG8_MMA
#undef PG8_WAIT_V
#undef PG8_WAIT_L
#undef PG8_BAR
#undef PG8_SCHED
}
}


#define XB_TMO      128
#define XB_XCNT(j)  (256  + 64 * (j))
#define XB_XSUB(j)  (1280 + 64 * (j))
#define XB_XGEN(j)  (2304 + 64 * (j))
#define XB_TOP      3328
#define XB_TOPGEN   3392
#define XCD_BAR_WORDS 3456
#define XB_SPIN_CAP (1u << 18)
__device__ __forceinline__ unsigned xb_ld(unsigned* p)              { return __hip_atomic_load(p, __ATOMIC_RELAXED, __HIP_MEMORY_SCOPE_AGENT); }
__device__ __forceinline__ unsigned xb_add(unsigned* p, unsigned v) { return __hip_atomic_fetch_add(p, v, __ATOMIC_RELAXED, __HIP_MEMORY_SCOPE_AGENT); }
__device__ __forceinline__ unsigned xb_xcc_id() { return (unsigned)__builtin_amdgcn_s_getreg((3 << 11) | 20) & 0xFu; }
#define XB_SPIN(cond, bar) do { unsigned _sp = 0; while (cond) { __builtin_amdgcn_s_sleep(1); \
    if ((++_sp & 255u) == 0u) { if (xb_ld(&(bar)[XB_TMO])) break; if (_sp > XB_SPIN_CAP) { atomicAdd(&(bar)[XB_TMO], 1u); break; } } } } while (0)
struct XcdBarrier { unsigned* bar; unsigned x; volatile LAS unsigned* st; };
__device__ __forceinline__ XcdBarrier xcd_barrier_post(unsigned* bar, volatile LAS unsigned* st) {
    XcdBarrier b; b.bar = bar; b.x = xb_xcc_id(); b.st = st;
    if (threadIdx.x == 0) (void)xb_add(&bar[XB_XCNT(b.x)], 1u);
    return b;
}
__device__ __forceinline__ void xcd_barrier_complete(unsigned* bar, unsigned x, unsigned& nloc, unsigned& nx) {
    const unsigned G = gridDim.x * gridDim.y * gridDim.z;
    unsigned sum, cnt, mine, sp = 0u;
    for (;;) {
        sum = 0u; cnt = 0u; mine = 0u;
#pragma unroll
        for (unsigned j = 0; j < 16; ++j) { const unsigned c = xb_ld(&bar[XB_XCNT(j)]); sum += c; cnt += (c > 0u) ? 1u : 0u; mine = (j == x) ? c : mine; }
        if (sum == G) break;
        __builtin_amdgcn_s_sleep(1);
        if ((++sp & 255u) == 0u) { if (xb_ld(&bar[XB_TMO])) break; if (sp > XB_SPIN_CAP) { atomicAdd(&bar[XB_TMO], 1u); break; } }
    }
    nloc = mine > 0u ? mine : 1u; nx = cnt > 0u ? cnt : 1u;
}
__device__ __forceinline__ void xcd_barrier(const XcdBarrier& b) {
    asm volatile("s_waitcnt vmcnt(0)" ::: "memory");
    __syncthreads();
    if (threadIdx.x == 0) {
        unsigned* bar = b.bar;
        __builtin_amdgcn_s_waitcnt(0);
        unsigned nloc = b.st[0], nx = b.st[1];
        if (nloc == 0u) { xcd_barrier_complete(bar, b.x, nloc, nx); b.st[0] = nloc; b.st[1] = nx; }
        const unsigned old = xb_add(&bar[XB_XSUB(b.x)], 1u);
        const unsigned gen = old / nloc;
        if (old + 1u == (gen + 1u) * nloc) {
            __builtin_amdgcn_fence(__ATOMIC_RELEASE, "agent");
            asm volatile("s_waitcnt vmcnt(0)" ::: "memory");
            const unsigned og = xb_add(&bar[XB_TOP], 1u);
            const unsigned tg = og / nx;
            if (og + 1u == (tg + 1u) * nx) xb_add(&bar[XB_TOPGEN], 1u);
            else XB_SPIN(xb_ld(&bar[XB_TOPGEN]) == tg, bar);
            __builtin_amdgcn_fence(__ATOMIC_ACQUIRE, "agent");
            xb_add(&bar[XB_XGEN(b.x)], 1u);
            asm volatile("s_waitcnt vmcnt(0)" ::: "memory");
        } else {
            XB_SPIN(xb_ld(&bar[XB_XGEN(b.x)]) == gen, bar);
            __builtin_amdgcn_fence(__ATOMIC_ACQUIRE, "agent");
            asm volatile("s_waitcnt vmcnt(0)" ::: "memory");
        }
    }
    __syncthreads();
}

struct Ctx { int tid, lane, wave, gw, ngw; LAS unsigned char* lds; unsigned char* ws; };

template <class LA, class F> __device__ __forceinline__ void skinny(const Ctx& c, LA&& aload, const bf16* WT, int ldb, int K, int N, int KS, F&& epi, int bkt = 0) {
    const int lane = c.lane, ncg = N / 16, kl = K / KS;
    for (int it = c.gw; it < ncg * KS; it += c.ngw) {
        const int cg = it % ncg, kb = (it / ncg) * kl;
        f32x4 acc = (f32x4){0.f, 0.f, 0.f, 0.f};
        const int nn = cg * 16 + (lane & 15);
        const bf16* bp = bkt ? WT + ((size_t)(nn >> 8) * bkt + (kb >> 6)) * 16384 + (nn & 255) * 64 + 8 * (lane >> 4) : WT + (size_t)nn * ldb + kb + 8 * (lane >> 4);
#pragma unroll 8
        for (int k0 = 0; k0 < kl; k0 += 32) { const bf16x8 av = aload(lane & 7, kb + k0 + 8 * (lane >> 4)), bv = *(const bf16x8*)(bp + (bkt ? (k0 >> 6) * 16384 + (k0 & 63) : k0)); acc = __builtin_amdgcn_mfma_f32_16x16x32_bf16(av, bv, acc, 0, 0, 0); }
        if ((lane >> 4) < 2) {
#pragma unroll
            for (int j = 0; j < 4; ++j) epi((lane >> 4) * 4 + j, cg * 16 + (lane & 15), acc[j]);
        }
    }
}
__device__ __forceinline__ bf16x8 relu2_bf16x8(const float* q) { const f32x4 a = *(const f32x4*)q, b = *(const f32x4*)(q + 4);
    u32x4 w; float t0, t1;
    t0 = fmaxf(a.x, 0.f); t1 = fmaxf(a.y, 0.f); w.x = pk2(t0 * t0, t1 * t1); t0 = fmaxf(a.z, 0.f); t1 = fmaxf(a.w, 0.f); w.y = pk2(t0 * t0, t1 * t1);
    t0 = fmaxf(b.x, 0.f); t1 = fmaxf(b.y, 0.f); w.z = pk2(t0 * t0, t1 * t1); t0 = fmaxf(b.z, 0.f); t1 = fmaxf(b.w, 0.f); w.w = pk2(t0 * t0, t1 * t1);
    return __builtin_bit_cast(bf16x8, w); }

__device__ __forceinline__ void load_row(const float* row, f32x4 (&v)[8], int lane) {
#pragma unroll
    for (int j = 0; j < 8; ++j) v[j] = ((const f32x4*)row)[lane + 64 * j];
}
__device__ __forceinline__ void load_row_bf16(const bf16* row, f32x4 (&v)[8], int lane) {
#pragma unroll
    for (int j = 0; j < 8; ++j) { const u32x2 x = ((const u32x2*)row)[lane + 64 * j]; v[j] = (f32x4){__uint_as_float(x.x << 16), __uint_as_float(x.x & 0xffff0000u), __uint_as_float(x.y << 16), __uint_as_float(x.y & 0xffff0000u)}; }
}
__device__ __forceinline__ float row_rs(const f32x4 (&v)[8]) {
    float s = 0.f;
#pragma unroll
    for (int j = 0; j < 8; ++j) s += (v[j].x * v[j].x + v[j].y * v[j].y) + (v[j].z * v[j].z + v[j].w * v[j].w);
    return rsqrtf(wave_sum(s) * (1.f / D) + EPS);
}
__device__ __forceinline__ void normmod(f32x4 (&v)[8], const float* g, const float* sc, const float* sh, int lane) {
    const float rs = row_rs(v);
#pragma unroll
    for (int j = 0; j < 8; ++j) { const int c = 4 * (lane + 64 * j); const f32x4 gg = *(const f32x4*)(g + c), s1 = *(const f32x4*)(sc + c), s0 = *(const f32x4*)(sh + c);
        v[j] = v[j] * rs * gg * (s1 + 1.f) + s0; }
}
__device__ __forceinline__ void store_row_bf16(bf16* row, const f32x4 (&v)[8], int lane) {
#pragma unroll
    for (int j = 0; j < 8; ++j) { u32x2 w; w.x = pk2(v[j].x, v[j].y); w.y = pk2(v[j].z, v[j].w); ((u32x2*)row)[lane + 64 * j] = w; }
}
__device__ __forceinline__ void store_row_bf16_tiled(bf16* base, int m, const f32x4 (&v)[8], int lane) {
#pragma unroll
    for (int j = 0; j < 8; ++j) { const int col = 4 * (lane + 64 * j); u32x2 w; w.x = pk2(v[j].x, v[j].y); w.y = pk2(v[j].z, v[j].w);
        *(u32x2*)(base + ((size_t)(m >> 8) * 32 + (col >> 6)) * 16384 + (m & 255) * 64 + (col & 63)) = w; }
}
__device__ __forceinline__ void store_row_f32(float* row, const f32x4 (&v)[8], int lane) {
#pragma unroll
    for (int j = 0; j < 8; ++j) ((f32x4*)row)[lane + 64 * j] = v[j];
}

__device__ __forceinline__ const float* modp(const unsigned char* ws, int layer, int r, int chunk) { return (const float*)(ws + WS_MOD) + ((size_t)(layer * 12 + r) * 6 + chunk) * D; }

struct TDesc { const float* W; bf16* WT; const float* ks; int N, ldt, row0, k0, n0, tkt; };
__device__ __forceinline__ TDesc tdecode(CP& p, const Ctx& c, int it) {
    constexpr int I_IN = (D / 64) * (INC / 32), I_OUT = (MIXK / 64) * (D / 32), I_1 = (D / 64) * (DFF / 32), I_2 = (DFF / 64) * (D / 32), I_P = (512 / 64) * (512 / 32);
    TDesc d; d.ks = nullptr; d.tkt = 0; d.row0 = 0; int r = it;
    if (r < I_IN) { const int nb = INC / 32, n0 = (r % nb) * 32; const int nd = n0 < 6144 ? n0 : (n0 < 6176 ? CDT + (n0 - 6144) : n0 - 32);
        d.W = p.in[I_INW]; d.N = INC; d.WT = (bf16*)(c.ws + WS_WIN); d.ldt = D; d.row0 = nd - n0; d.k0 = (r / nb) * 64; d.n0 = n0; d.tkt = D / 64; return d; } r -= I_IN;
    if (r < I_OUT) { const int nb = D / 32; d.W = p.in[I_OUTW]; d.N = D; d.WT = (bf16*)(c.ws + WS_WOUT); d.ldt = MIXK; d.k0 = (r / nb) * 64; d.n0 = (r % nb) * 32; if (d.k0 < INNER) d.ks = p.in[I_SSDG]; return d; } r -= I_OUT;
    if (r < 2 * I_1) { const int l = r / I_1, q = r % I_1, nb = DFF / 32; d.W = p.in[I_W1] + (size_t)l * D * DFF; d.N = DFF; d.WT = (bf16*)(c.ws + WS_W1) + (size_t)l * DFF * D; d.ldt = D; d.k0 = (q / nb) * 64; d.n0 = (q % nb) * 32; d.tkt = D / 64; return d; } r -= 2 * I_1;
    if (r < 2 * I_2) { const int l = r / I_2, q = r % I_2, nb = D / 32; d.W = p.in[I_W2] + (size_t)l * DFF * D; d.N = D; d.WT = (bf16*)(c.ws + WS_W2) + (size_t)l * D * DFF; d.ldt = DFF; d.k0 = (q / nb) * 64; d.n0 = (q % nb) * 32; d.tkt = DFF / 64; return d; } r -= 2 * I_2;
    { const int gq = r / I_P, q = r % I_P, nb = 512 / 32; d.W = p.in[I_POOLW] + (size_t)gq * 512 * 512; d.N = 512; d.WT = (bf16*)(c.ws + WS_WPOOL) + (size_t)gq * 512 * 512; d.ldt = 512; d.k0 = (q / nb) * 64; d.n0 = (q % nb) * 32; return d; }
}
__device__ __forceinline__ void tload(const TDesc& d, int lane, float (&v)[32]) {
    const float* wp = d.W + (size_t)(d.k0 + (lane >> 5)) * d.N + d.n0 + (lane & 31);
#pragma unroll
    for (int i = 0; i < 32; ++i) v[i] = __builtin_nontemporal_load(wp + (size_t)(2 * i) * d.N);
}
__device__ __forceinline__ void tstore(const TDesc& d, LAS float* scr, int lane, const float (&v)[32]) {
#pragma unroll
    for (int i = 0; i < 32; ++i) { const int kk = 2 * i + (lane >> 5); float wv = v[i]; if (d.ks) wv *= d.ks[d.k0 + kk]; scr[kk * 33 + (lane & 31)] = wv; }
    LDS_WAIT();
    const int cc = lane & 7;
#pragma unroll
    for (int j = 0; j < 4; ++j) { const int n = (lane >> 3) + 8 * j; const LAS float* s = scr + (8 * cc) * 33 + n;
        u32x4 o; o.x = pk2(s[0 * 33], s[1 * 33]); o.y = pk2(s[2 * 33], s[3 * 33]); o.z = pk2(s[4 * 33], s[5 * 33]); o.w = pk2(s[6 * 33], s[7 * 33]);
        const int nn = d.row0 + d.n0 + n;
        *(u32x4*)(d.tkt ? d.WT + ((size_t)(nn >> 8) * d.tkt + (d.k0 >> 6)) * 16384 + (nn & 255) * 64 + 8 * cc : d.WT + (size_t)nn * d.ldt + d.k0 + 8 * cc) = o; }
    LDS_WAIT();
}

__device__ __forceinline__ void ph_prologue(CP& p, const Ctx& c) {
    const int lane = c.lane, wave = c.wave, tid = c.tid;
    const float* const cpp_ = p.in[I_CP]; const float* const csp_ = p.in[I_CS];
    __syncthreads();
    for (int it = blockIdx.x; it < 768; it += gridDim.x) {
        const int kq = it & 7, cgp = (it >> 3) % 48, layer = it / 384, n0 = cgp * 256, kb = kq * 256 + wave * 32;
        LAS float* cs = (LAS float*)c.lds + wave * (12 * 32);
        for (int i = lane; i < 12 * 32; i += 64) { const int r = i >> 5, k = kb + (i & 31); const float cv = r < 4 ? cpp_[r * D + k] : csp_[(r - 4) * D + k]; cs[i] = siluf(cv); }
        LDS_WAIT();
        f32x4 acc[12];
#pragma unroll
        for (int r = 0; r < 12; ++r) acc[r] = (f32x4){0.f, 0.f, 0.f, 0.f};
        const float* W = p.in[I_ADAW] + (size_t)layer * D * MODW + (size_t)kb * MODW + n0 + lane * 4;
#pragma unroll
        for (int h = 0; h < 2; ++h) { f32x4 w[16];
#pragma unroll
            for (int kk = 0; kk < 16; ++kk) w[kk] = __builtin_nontemporal_load((const f32x4*)(W + (size_t)(16 * h + kk) * MODW));
#pragma unroll
            for (int kk = 0; kk < 16; ++kk)
#pragma unroll
                for (int r = 0; r < 12; ++r) acc[r] += w[kk] * cs[r * 32 + 16 * h + kk]; }
        __syncthreads();
        LAS f32x4* red = (LAS f32x4*)(c.lds + 16384);
#pragma unroll
        for (int r = 0; r < 12; ++r) red[(wave * 12 + r) * 64 + lane] = acc[r];
        __syncthreads();
        for (int o = tid; o < 12 * 256; o += NT) { const int r = o >> 8, cc = o & 255; float sacc = kq == 0 ? p.in[I_ADAB][layer * MODW + n0 + cc] : 0.f;
#pragma unroll
            for (int w = 0; w < 8; ++w) sacc += ((LAS float*)(c.lds + 16384))[(w * 12 + r) * 256 + cc];
            atomicAdd((float*)(c.ws + WS_MOD) + (size_t)(layer * 12 + r) * MODW + n0 + cc, sacc); }
        __syncthreads();
    }
    {
        LAS float* scr = (LAS float*)(c.lds + wave * 16384);
        constexpr int NITEMS = (D / 64) * (INC / 32) + (MIXK / 64) * (D / 32) + 2 * (D / 64) * (DFF / 32) + 2 * (DFF / 64) * (D / 32) + 4 * (512 / 64) * (512 / 32);
        int it = c.gw;
        if (it < NITEMS) {
            TDesc d = tdecode(p, c, it); float v[32]; tload(d, lane, v);
#pragma clang loop unroll(disable)
            for (;;) { const int itn = it + c.ngw; TDesc dn = d; float vn[32];
                if (itn < NITEMS) { dn = tdecode(p, c, itn); tload(dn, lane, vn); }
                tstore(d, scr, lane, v);
                if (itn >= NITEMS) break;
                d = dn; it = itn;
#pragma unroll
                for (int i = 0; i < 32; ++i) v[i] = vn[i]; }
        }
    }
    { const int gt = blockIdx.x * NT + tid, gn = gridDim.x * NT;
      f32x4* z0 = (f32x4*)(c.ws + WS_SMP + SM_PROJ); for (int i = gt; i < SB * INP / 4; i += gn) z0[i] = (f32x4){0.f, 0.f, 0.f, 0.f};
      f32x4* z1 = (f32x4*)(c.ws + WS_SMP + SM_H0); for (int i = gt; i < 2 * SB * DFF / 4; i += gn) z1[i] = (f32x4){0.f, 0.f, 0.f, 0.f};
      f32x4* z2 = (f32x4*)(c.ws + WS_RS); for (int i = gt; i < 4 * MP / 4; i += gn) z2[i] = (f32x4){0.f, 0.f, 0.f, 0.f}; }
    { bf16* wt = (bf16*)(c.ws + WS_WIN) + (size_t)60 * 32 * 16384;
      for (int i = blockIdx.x * NT + tid; i < 32 * 224 * 8; i += gridDim.x * NT) { const int kt = i / (224 * 8), rem = i % (224 * 8), row = 32 + rem / 8, cc = rem % 8; *(u32x4*)(wt + (size_t)kt * 16384 + row * 64 + cc * 8) = (u32x4){0u, 0u, 0u, 0u}; } }
}

template <bool XBF> __device__ __forceinline__ void ph_normmod(CP& p, const Ctx& c, const void* xp, const float* xs, const float* g, int layer, int csh, int csc, float* xs_copy) {
    for (int m = c.gw; m < MP + SB; m += c.ngw) {
        f32x4 v[8];
        if (m < MP) { if (XBF) load_row_bf16((const bf16*)xp + (size_t)m * D, v, c.lane); else load_row((const float*)xp + (size_t)m * D, v, c.lane); normmod(v, g, modp(c.ws, layer, m >> 11, csc), modp(c.ws, layer, m >> 11, csh), c.lane); store_row_bf16_tiled((bf16*)(c.ws + WS_A0), m, v, c.lane); }
        else { const int r = m - MP; load_row(xs + (size_t)r * D, v, c.lane); store_row_f32(xs_copy + (size_t)r * D, v, c.lane); normmod(v, g, modp(c.ws, layer, 4 + r, csc), modp(c.ws, layer, 4 + r, csh), c.lane); store_row_bf16((bf16*)(c.ws + WS_SMP + SM_USBF) + (size_t)r * D, v, c.lane); }
    }
}

__device__ __forceinline__ int kvlen(int gi) { return gi == 0 ? 128 : (gi == 1 ? 512 : 2048); }
__device__ __forceinline__ size_t pkv_off(int gi) { return gi == 0 ? O_PKV128 : (gi == 1 ? O_PKV512 : O_PKV2048); }
__device__ __forceinline__ size_t skv_off(int gi) { return gi == 0 ? O_SKV128 : (gi == 1 ? O_SKV512 : O_SKV2048); }

__device__ __forceinline__ void ph_sample_postproj(CP& p, const Ctx& c) {
    const int lane = c.lane;
    const float* cw = p.in[I_CONVW]; const float* cb = p.in[I_CONVB]; const float* const qgp = p.in[I_QG]; const float* const kgp = p.in[I_KG];
    const float* sproj = (const float*)(c.ws + WS_SMP + SM_PROJ);
    for (int it = c.gw; it < 64 + 384 + 192; it += c.ngw) {
        if (it < 64) { const int b = it >> 3, ch = (it & 7) * 512 + lane * 8; const float* prow = sproj + (size_t)b * INP;
            const float* st = p.in[I_CONV] + (size_t)b * 3 * CONVD + ch;
            f32x4 o0 = *(const f32x4*)(cb + ch), o1 = *(const f32x4*)(cb + ch + 4);
            const f32x4 s00 = *(const f32x4*)(st), s01 = *(const f32x4*)(st + 4), s10 = *(const f32x4*)(st + CONVD), s11 = *(const f32x4*)(st + CONVD + 4), s20 = *(const f32x4*)(st + 2 * CONVD), s21 = *(const f32x4*)(st + 2 * CONVD + 4);
            const f32x4 x0 = *(const f32x4*)(prow + CX + ch), x1 = *(const f32x4*)(prow + CX + ch + 4);
            o0 += *(const f32x4*)(cw + ch) * s00 + *(const f32x4*)(cw + CONVD + ch) * s10 + *(const f32x4*)(cw + 2 * CONVD + ch) * s20 + *(const f32x4*)(cw + 3 * CONVD + ch) * x0;
            o1 += *(const f32x4*)(cw + ch + 4) * s01 + *(const f32x4*)(cw + CONVD + ch + 4) * s11 + *(const f32x4*)(cw + 2 * CONVD + ch + 4) * s21 + *(const f32x4*)(cw + 3 * CONVD + ch + 4) * x1;
            float* xo = (float*)(c.ws + WS_SMP + SM_XC) + (size_t)b * CONVD + ch;
            *(f32x4*)xo = (f32x4){siluf(o0.x), siluf(o0.y), siluf(o0.z), siluf(o0.w)}; *(f32x4*)(xo + 4) = (f32x4){siluf(o1.x), siluf(o1.y), siluf(o1.z), siluf(o1.w)};
            float* sc = p.out + O_SCONV + (size_t)b * 3 * CONVD + ch;
            *(f32x4*)sc = s10; *(f32x4*)(sc + 4) = s11; *(f32x4*)(sc + CONVD) = s20; *(f32x4*)(sc + CONVD + 4) = s21; *(f32x4*)(sc + 2 * CONVD) = x0; *(f32x4*)(sc + 2 * CONVD + 4) = x1;
            if ((it & 7) == 0 && lane < NH) ((float*)(c.ws + WS_SMP + SM_DT))[b * NH + lane] = softplusf(prow[CDT + lane] + p.in[I_DTB][lane]);
        } else if (it < 64 + 384) { const int q = it - 64, b = q / 48, hh = q % 48; const float* prow = sproj + (size_t)b * INP;
            float* qk = (float*)(c.ws + WS_SMP + SM_QK) + (size_t)b * 6144;
            const float x0 = prow[CQ + hh * HD + lane], x1 = prow[CQ + hh * HD + 64 + lane];
            const float rs = rsqrtf(wave_sum(x0 * x0 + x1 * x1) * (1.f / HD) + EPS); const float* gg = hh < AH ? qgp : kgp;
            const float y0 = x0 * rs * gg[lane], y1 = x1 * rs * gg[64 + lane];
            qk[hh * HD + lane] = y0; qk[hh * HD + 64 + lane] = y1;
            if (hh >= AH) { const int kh = hh - AH, gi = kh >> 3, slot = kh & 7, W = kvlen(gi);
                float* o = p.out + skv_off(gi) + (((size_t)b * W + (W - 1)) * 2 + 0) * 1024 + slot * HD; o[lane] = y0; o[64 + lane] = y1; }
        } else { const int q = it - 448, b = q / AH, vh = q % AH, gi = vh >> 3, slot = vh & 7, W = kvlen(gi); const float* prow = sproj + (size_t)b * INP;
            float* o = p.out + skv_off(gi) + (((size_t)b * W + (W - 1)) * 2 + 1) * 1024 + slot * HD; o[lane] = prow[CV + vh * HD + lane]; o[64 + lane] = prow[CV + vh * HD + 64 + lane]; }
    }
}
__device__ __forceinline__ void ph_kvcopy(CP& p, const Ctx& c, int rp0, int rp1, int w0, int nw) {
    constexpr int R0 = 8 * 127, R1 = 8 * 511, R2 = 8 * 2047, TOTR = R0 + R1 + R2;
    const int lane = c.lane;
    const float* const kc0 = p.in[I_KV128]; const float* const kc1 = p.in[I_KV512]; const float* const kc2 = p.in[I_KV2048];
#pragma clang loop unroll(disable)
    for (int rp = rp0 + w0; rp < rp1; rp += nw) {
        const u32x4* src[2]; u32x4* dst[2];
#pragma unroll
        for (int h = 0; h < 2; ++h) { int q = 2 * rp + h; const float* cb; size_t ob; int W;
            if (q < R0) { cb = kc0; ob = O_SKV128; W = 128; } else if (q < R0 + R1) { q -= R0; cb = kc1; ob = O_SKV512; W = 512; } else { q -= R0 + R1; cb = kc2; ob = O_SKV2048; W = 2048; }
            const int b = q / (W - 1), r = q - b * (W - 1); const size_t base = ((size_t)b * W + r) * 512;
            src[h] = (const u32x4*)cb + base + 512 + lane; dst[h] = (u32x4*)(p.out + ob) + base + lane; }
        u32x4 v[2][8];
#pragma unroll
        for (int h = 0; h < 2; ++h)
#pragma unroll
            for (int j = 0; j < 8; ++j) v[h][j] = __builtin_nontemporal_load(src[h] + 64 * j);
#pragma unroll
        for (int h = 0; h < 2; ++h)
#pragma unroll
            for (int j = 0; j < 8; ++j) __builtin_nontemporal_store(v[h][j], dst[h] + 64 * j);
    }
}

__device__ __forceinline__ int rel_bucket(int dist) {
    if (dist < 16) return dist;
    int l = 16 + (int)(logf((float)dist * (1.f / 16.f)) / 4.852030263919617f * 16.f);
    return l < 31 ? l : 31;
}

typedef short s16x4 __attribute__((ext_vector_type(4)));
__device__ __forceinline__ s16x4 tr_read(const LAS unsigned char* p) { return __builtin_bit_cast(s16x4, __builtin_amdgcn_ds_read_tr16_b64_v4i16((LAS s16x4*)p)); }
__device__ __forceinline__ bf16x8 cat4(s16x4 a, s16x4 b) { return (bf16x8){a[0], a[1], a[2], a[3], b[0], b[1], b[2], b[3]}; }
__device__ __forceinline__ bf16x8 pack8(f32x4 a, f32x4 b) { u32x4 w; w.x = pk2(a[0], a[1]); w.y = pk2(a[2], a[3]); w.z = pk2(b[0], b[1]); w.w = pk2(b[2], b[3]); return __builtin_bit_cast(bf16x8, w); }
#define MFMA16(a, b, c) __builtin_amdgcn_mfma_f32_16x16x32_bf16((a), (b), (c), 0, 0, 0)


struct ConvW { f32x4 w[4][2]; f32x4 b[2]; };
__device__ __forceinline__ void conv_load_w(ConvW& cwv, const float* cw, const float* cb, int ch) {
#pragma unroll
    for (int k = 0; k < 4; ++k) { cwv.w[k][0] = *(const f32x4*)(cw + k * CONVD + ch); cwv.w[k][1] = *(const f32x4*)(cw + k * CONVD + ch + 4); }
    cwv.b[0] = *(const f32x4*)(cb + ch); cwv.b[1] = *(const f32x4*)(cb + ch + 4);
}
__device__ __forceinline__ void conv8(const bf16* prow, int t, int ch, const ConvW& cwv, f32x4& o0, f32x4& o1) {
    o0 = cwv.b[0]; o1 = cwv.b[1];
#pragma unroll
    for (int k = 0; k < 4; ++k) { if (t + k - 3 >= 0) { const u32x4 xv = *(const u32x4*)(prow + (ptrdiff_t)(k - 3) * INP + CX + ch);
            o0 += cwv.w[k][0] * (f32x4){bf2f(xv.x & 0xffffu), bf2f(xv.x >> 16), bf2f(xv.y & 0xffffu), bf2f(xv.y >> 16)};
            o1 += cwv.w[k][1] * (f32x4){bf2f(xv.z & 0xffffu), bf2f(xv.z >> 16), bf2f(xv.w & 0xffffu), bf2f(xv.w >> 16)}; } }
    o0 = (f32x4){siluf(o0.x), siluf(o0.y), siluf(o0.z), siluf(o0.w)}; o1 = (f32x4){siluf(o1.x), siluf(o1.y), siluf(o1.z), siluf(o1.w)};
}

template <int R> __device__ __forceinline__ void conv_rows(const bf16* prow0, int t0, int ch, const ConvW& cwv, f32x4 (&o0)[R], f32x4 (&o1)[R]) {
    u32x4 raw[R + 3];
#pragma unroll
    for (int i = 0; i < R + 3; ++i) raw[i] = (t0 - 3 + i >= 0) ? *(const u32x4*)(prow0 + (ptrdiff_t)(i - 3) * INP + CX + ch) : (u32x4){0u, 0u, 0u, 0u};
#pragma unroll
    for (int r = 0; r < R; ++r) { f32x4 a0 = cwv.b[0], a1 = cwv.b[1];
#pragma unroll
        for (int k = 0; k < 4; ++k) { const u32x4 xv = raw[r + k];
            a0 += cwv.w[k][0] * (f32x4){bf2f(xv.x & 0xffffu), bf2f(xv.x >> 16), bf2f(xv.y & 0xffffu), bf2f(xv.y >> 16)};
            a1 += cwv.w[k][1] * (f32x4){bf2f(xv.z & 0xffffu), bf2f(xv.z >> 16), bf2f(xv.w & 0xffffu), bf2f(xv.w >> 16)}; }
        o0[r] = (f32x4){siluf(a0.x), siluf(a0.y), siluf(a0.z), siluf(a0.w)}; o1[r] = (f32x4){siluf(a1.x), siluf(a1.y), siluf(a1.z), siluf(a1.w)}; }
}

constexpr size_t WS_ACUM = 666 * MiB;
constexpr size_t WS_STATES = WS_Y;
constexpr size_t WS_HPREV = WS_XC;
__device__ __forceinline__ void ssd_states_item(CP& p, const Ctx& c, int b, int ch, int g) {
    LAS unsigned char* Bm = c.lds;
    LAS unsigned char* Xw = c.lds + 36864;
    LAS float* wts = (LAS float*)(c.lds + 118784);
    const int lane = c.lane, wave = c.wave, tid = c.tid, fq = lane >> 4, fr = lane & 15;
    const int m0 = b * SEQ + ch * 128;
    const bf16* pr0 = (const bf16*)(c.ws + WS_PROJ) + (size_t)m0 * INP; const int tch = ch * 128;
    if (wave < 4) {
        const int h = 4 * g + wave; const float A = -__expf(p.in[I_ALOG][h]);
        const float* dtp = (const float*)(c.ws + WS_DT) + (size_t)m0 * NH + h;
        const float d0 = dtp[(size_t)(2 * lane) * NH], d1 = dtp[(size_t)(2 * lane + 1) * NH];
        const float a0 = d0 * A, a1 = d1 * A; float sc = a0 + a1;
#pragma unroll
        for (int o = 1; o < 64; o <<= 1) { const float t = __shfl_up(sc, o); if (lane >= o) sc += t; }
        const float aend = __shfl(sc, 63); const float ac1 = sc, ac0 = sc - a1;
        float* ag = (float*)(c.ws + WS_ACUM) + (size_t)m0 * NH + h; ag[(size_t)(2 * lane) * NH] = ac0; ag[(size_t)(2 * lane + 1) * NH] = ac1;
        wts[wave * 128 + 2 * lane] = d0 * __expf(aend - ac0); wts[wave * 128 + 2 * lane + 1] = d1 * __expf(aend - ac1);
    }
    f32x4 xo0[8], xo1[8];
    { const int cc = tid & 7, e = (tid >> 3) & 3, chn = (4 * g + e) * HP + cc * 8, r0 = 8 * (tid >> 5); ConvW cwv; conv_load_w(cwv, p.in[I_CONVW], p.in[I_CONVB], chn);
      conv_rows<8>(pr0 + (size_t)r0 * INP, tch + r0, chn, cwv, xo0, xo1); }
    { const int cc = tid & 15, chn = INNER + g * SN + cc * 8, r0 = 4 * (tid >> 4); ConvW cwv; conv_load_w(cwv, p.in[I_CONVW], p.in[I_CONVB], chn);
      f32x4 o0[4], o1[4]; conv_rows<4>(pr0 + (size_t)r0 * INP, tch + r0, chn, cwv, o0, o1);
#pragma unroll
      for (int r = 0; r < 4; ++r) *(LAS bf16x8*)(Bm + (r0 + r) * 288 + cc * 16) = pack8(o0[r], o1[r]); }
    __syncthreads();
    { const int cc = tid & 7, e = (tid >> 3) & 3, r0 = 8 * (tid >> 5);
#pragma unroll
      for (int r = 0; r < 8; ++r) { const float w = wts[e * 128 + r0 + r]; *(LAS bf16x8*)(Xw + e * 20480 + (r0 + r) * 160 + cc * 16) = pack8(xo0[r] * w, xo1[r] * w); } }
    __syncthreads();
    const int troff = (4 * fq + (fr >> 2));
    bf16x8 bfr[4];
#pragma unroll
    for (int ks = 0; ks < 4; ++ks) { const LAS unsigned char* a = Bm + (32 * ks + troff) * 288 + (16 * wave + 4 * (fr & 3)) * 2; bfr[ks] = cat4(tr_read(a), tr_read(a + 16 * 288)); }
    float* st = (float*)(c.ws + WS_STATES) + (((size_t)(b * 16 + ch) * NH + 4 * g) * HP) * SN;
#pragma unroll 1
    for (int e = 0; e < 4; ++e) {
#pragma unroll
        for (int pt = 0; pt < 4; ++pt) { f32x4 acc = (f32x4){0.f, 0.f, 0.f, 0.f};
#pragma unroll
            for (int ks = 0; ks < 4; ++ks) { const LAS unsigned char* a = Xw + e * 20480 + (32 * ks + troff) * 160 + (16 * pt + 4 * (fr & 3)) * 2; acc = MFMA16(cat4(tr_read(a), tr_read(a + 16 * 160)), bfr[ks], acc); }
#pragma unroll
            for (int r = 0; r < 4; ++r) st[((size_t)e * HP + 16 * pt + 4 * fq + r) * SN + 16 * wave + fr] = acc[r]; }
    }
    __syncthreads();
}

__device__ __forceinline__ void ph_ssd_scan(CP& p, const Ctx& c, int blk0) {
    if ((int)blockIdx.x < blk0) return;
    const size_t gt = (size_t)(blockIdx.x - blk0) * NT + c.tid, gn = (size_t)(gridDim.x - blk0) * NT;
    const float* st = (const float*)(c.ws + WS_STATES); bf16* hp = (bf16*)(c.ws + WS_HPREV); const float* ac = (const float*)(c.ws + WS_ACUM);
    for (size_t i = gt; i < (size_t)BATCH * NH * HP * (SN / 4); i += gn) { const int n4 = (int)(i & 31), pp = (int)(i >> 5) & 63, h = (int)(i >> 11) & 31, b = (int)(i >> 16);
        f32x4 hr = (f32x4){0.f, 0.f, 0.f, 0.f};
        f32x4 stv[16]; float dcv[16];
#pragma unroll
        for (int ch = 0; ch < 16; ++ch) { stv[ch] = __builtin_nontemporal_load((const f32x4*)(st + ((((size_t)(b * 16 + ch) * NH + h) * HP + pp) * SN) + 4 * n4)); dcv[ch] = ac[(size_t)(b * SEQ + ch * 128 + 127) * NH + h]; }
#pragma unroll
        for (int ch = 0; ch < 16; ++ch) { const size_t off = ((((size_t)(b * 16 + ch) * NH + h) * HP + pp) * SN) + 4 * n4;
            u32x2 w; w.x = pk2(hr.x, hr.y); w.y = pk2(hr.z, hr.w); *(u32x2*)(hp + off) = w;
            hr = hr * __expf(dcv[ch]) + stv[ch]; }
        *(f32x4*)(p.out + O_PSSM + (((size_t)b * NH + h) * HP + pp) * SN + 4 * n4) = hr; }
}

__device__ __forceinline__ void ssd_out_item(CP& p, const Ctx& c, int b, int ch, int g, bool do_atomic = true) {
    LAS unsigned char* Bm = c.lds;
    LAS unsigned char* Xs = c.lds + 34816;
    LAS float* acs = (LAS float*)(c.lds + 116736);
    LAS float* dts = (LAS float*)(c.lds + 118784);
    const int lane = c.lane, wave = c.wave, tid = c.tid, fq = lane >> 4, fr = lane & 15;
    const int m0 = b * SEQ + ch * 128;
    const bf16* pr0 = (const bf16*)(c.ws + WS_PROJ) + (size_t)m0 * INP; const int tch = ch * 128;
    { const int cc = tid & 7, e = (tid >> 3) & 3, chn = (4 * g + e) * HP + cc * 8, r0 = 8 * (tid >> 5); ConvW cwv; conv_load_w(cwv, p.in[I_CONVW], p.in[I_CONVB], chn);
      f32x4 o0[8], o1[8]; conv_rows<8>(pr0 + (size_t)r0 * INP, tch + r0, chn, cwv, o0, o1);
#pragma unroll
      for (int r = 0; r < 8; ++r) *(LAS bf16x8*)(Xs + e * 20480 + (r0 + r) * 160 + cc * 16) = pack8(o0[r], o1[r]); }
    { const int cc = tid & 15, chn = INNER + g * SN + cc * 8, r0 = 4 * (tid >> 4); ConvW cwv; conv_load_w(cwv, p.in[I_CONVW], p.in[I_CONVB], chn);
      f32x4 o0[4], o1[4]; conv_rows<4>(pr0 + (size_t)r0 * INP, tch + r0, chn, cwv, o0, o1);
#pragma unroll
      for (int r = 0; r < 4; ++r) *(LAS bf16x8*)(Bm + (r0 + r) * 272 + cc * 16) = pack8(o0[r], o1[r]); }
    { const int e = tid >> 7, j = tid & 127; acs[tid] = ((const float*)(c.ws + WS_ACUM))[(size_t)(m0 + j) * NH + 4 * g + e]; dts[tid] = ((const float*)(c.ws + WS_DT))[(size_t)(m0 + j) * NH + 4 * g + e]; }
    __syncthreads();
    const int i_tok = 16 * wave + fr;
    bf16x8 cf[4];
#pragma unroll
    for (int ks = 0; ks < 4; ++ks) { const int chn = INNER + SG * SN + g * SN + 32 * ks + 8 * fq; ConvW cwv; conv_load_w(cwv, p.in[I_CONVW], p.in[I_CONVB], chn);
        f32x4 o0, o1; conv8(pr0 + (size_t)i_tok * INP, tch + i_tok, chn, cwv, o0, o1); cf[ks] = pack8(o0, o1); }
    f32x4 cb[8];
#pragma unroll
    for (int jt = 0; jt < 8; ++jt) { cb[jt] = (f32x4){0.f, 0.f, 0.f, 0.f};
        if (jt <= wave) {
#pragma unroll
            for (int ks = 0; ks < 4; ++ks) cb[jt] = MFMA16(*(const LAS bf16x8*)(Bm + (16 * jt + fr) * 272 + (32 * ks + 8 * fq) * 2), cf[ks], cb[jt]); } }
    const int troff = 4 * fq + (fr >> 2);
    const bf16* hpv = (const bf16*)(c.ws + WS_HPREV) + (((size_t)(b * 16 + ch) * NH + 4 * g) * HP) * SN;
    bf16* a1row = (bf16*)(c.ws + WS_A1) + (size_t)(m0 + i_tok) * MIXK + 4 * g * HP; const bf16* zrow = pr0 + (size_t)i_tok * INP + CZ + 4 * g * HP; float ssq = 0.f;
    bf16x8 hp[16];
#pragma unroll
    for (int q = 0; q < 16; ++q) hp[q] = *(const bf16x8*)(hpv + ((size_t)(16 * (q >> 2) + fr)) * SN + 32 * (q & 3) + 8 * fq);
#pragma unroll 1
    for (int e = 0; e < 4; ++e) {
        const float ai = acs[e * 128 + i_tok];
        u32x2 zv4[4];
#pragma unroll
        for (int pt = 0; pt < 4; ++pt) zv4[pt] = *(const u32x2*)(zrow + e * HP + 16 * pt + 4 * fq);
        f32x4 acc[4];
#pragma unroll
        for (int pt = 0; pt < 4; ++pt) { acc[pt] = (f32x4){0.f, 0.f, 0.f, 0.f};
#pragma unroll
            for (int ks = 0; ks < 4; ++ks) acc[pt] = MFMA16(hp[pt * 4 + ks], cf[ks], acc[pt]); }
        if (e < 3) {
#pragma unroll
            for (int q = 0; q < 16; ++q) hp[q] = *(const bf16x8*)(hpv + ((size_t)(e + 1) * HP + 16 * (q >> 2) + fr) * SN + 32 * (q & 3) + 8 * fq); }
        const float ei = __expf(ai);
#pragma unroll
        for (int pt = 0; pt < 4; ++pt) acc[pt] = acc[pt] * ei;
#pragma unroll
        for (int s2 = 0; s2 < 4; ++s2) {
            if (2 * s2 <= wave) {
                f32x4 mv[2];
#pragma unroll
                for (int hf = 0; hf < 2; ++hf) { const int jt = 2 * s2 + hf; const int j0 = 16 * jt + 4 * fq;
                    const f32x4 aj = *(const LAS f32x4*)(acs + e * 128 + j0), dj = *(const LAS f32x4*)(dts + e * 128 + j0);
#pragma unroll
                    for (int r = 0; r < 4; ++r) mv[hf][r] = (j0 + r <= i_tok) ? cb[jt][r] * __expf(ai - aj[r]) * dj[r] : 0.f; }
                const bf16x8 mf = pack8(mv[0], mv[1]);
#pragma unroll
                for (int pt = 0; pt < 4; ++pt) { const LAS unsigned char* a = Xs + e * 20480 + (32 * s2 + troff) * 160 + (16 * pt + 4 * (fr & 3)) * 2; acc[pt] = MFMA16(cat4(tr_read(a), tr_read(a + 16 * 160)), mf, acc[pt]); }
            }
        }
        const float dsk = p.in[I_DSKIP][4 * g + e];
#pragma unroll
        for (int pt = 0; pt < 4; ++pt) { const int pc = e * HP + 16 * pt + 4 * fq;
            const u32x2 xv = *(const LAS u32x2*)(Xs + e * 20480 + i_tok * 160 + (16 * pt + 4 * fq) * 2), zv = zv4[pt];
            const float y0 = (acc[pt][0] + dsk * bf2f(xv.x & 0xffffu)) * siluf(bf2f(zv.x & 0xffffu)), y1 = (acc[pt][1] + dsk * bf2f(xv.x >> 16)) * siluf(bf2f(zv.x >> 16));
            const float y2 = (acc[pt][2] + dsk * bf2f(xv.y & 0xffffu)) * siluf(bf2f(zv.y & 0xffffu)), y3 = (acc[pt][3] + dsk * bf2f(xv.y >> 16)) * siluf(bf2f(zv.y >> 16));
            ssq += (y0 * y0 + y1 * y1) + (y2 * y2 + y3 * y3);
            u32x2 w; w.x = pk2(y0, y1); w.y = pk2(y2, y3); *(u32x2*)(a1row + pc) = w; }
    }
    ssq += __shfl_xor(ssq, 16); ssq += __shfl_xor(ssq, 32);
    if (fq == 0 && do_atomic) atomicAdd((float*)(c.ws + WS_RS) + m0 + i_tok, ssq);
    __syncthreads();
}

struct AttnPre { u32x4 k[8], v[8]; bf16x8 q[4]; float bias; };
struct AttnIt { int b, hd, r, n; };
__device__ __forceinline__ AttnIt attn_decode(int a) { const int gi = a / 512, q = a % 512; AttnIt t; t.b = q >> 7; const int slot = (q >> 4) & 7; t.hd = gi * 8 + slot;
    if (gi == 0) { t.r = 0; t.n = q & 15; } else if (gi == 1) { t.r = (q >> 2) & 3; t.n = q & 3; } else { t.r = q & 15; t.n = 0; } return t; }
__device__ __forceinline__ void attn_prefetch(CP& p, const Ctx& c, const AttnIt it, AttnPre& pre) {
    const int gi = it.hd >> 3, dil = gi == 0 ? 1 : (gi == 1 ? 4 : 16), Ls = SEQ / dil, tid = c.tid, lane = c.lane, wave = c.wave;
    const bf16* proj = (const bf16*)(c.ws + WS_PROJ);
    const int cc = tid & 15;
#pragma unroll
    for (int j = 0; j < 8; ++j) { const int row = (tid >> 4) + 32 * j; int sp = 128 * (it.n - 1) + row; sp = sp < 0 ? 0 : (sp > Ls - 1 ? Ls - 1 : sp);
        const bf16* pr = proj + (size_t)(it.b * SEQ + sp * dil + it.r) * INP + it.hd * HD + cc * 8; pre.k[j] = *(const u32x4*)(pr + CK); pre.v[j] = *(const u32x4*)(pr + CV); }
    const int tokq = it.b * SEQ + (128 * it.n + 16 * wave + (lane & 15)) * dil + it.r;
#pragma unroll
    for (int ks = 0; ks < 4; ++ks) pre.q[ks] = *(const bf16x8*)(proj + (size_t)tokq * INP + CQ + it.hd * HD + 32 * ks + 8 * (lane >> 4));
    { const int t = tid - 16; pre.bias = (tid < 176 && t >= 0 && t <= 128) ? p.in[I_RELB][rel_bucket((128 - t) * dil) * AH + it.hd] : -1e30f; }
}
__device__ __forceinline__ void attn_store_lds(const Ctx& c, const AttnPre& pre) {
    LAS unsigned char* Ks = c.lds; LAS unsigned char* Vs = c.lds + 69632; LAS float* rb = (LAS float*)(c.lds + 143360);
    const int tid = c.tid, cc = tid & 15;
#pragma unroll
    for (int j = 0; j < 8; ++j) { const int row = (tid >> 4) + 32 * j; *(LAS u32x4*)(Ks + row * 272 + cc * 16) = pre.k[j]; *(LAS u32x4*)(Vs + row * 288 + cc * 16) = pre.v[j]; }
    if (tid < 176) rb[tid] = pre.bias;
}
__device__ __forceinline__ void attn_compute(CP& p, const Ctx& c, const AttnIt it, const bf16x8 (&qf)[4]) {
    const int gi = it.hd >> 3, slot = it.hd & 7, dil = gi == 0 ? 1 : (gi == 1 ? 4 : 16), n = it.n;
    const LAS unsigned char* Ks = c.lds; const LAS unsigned char* Vs = c.lds + 69632; const LAS float* rb = (const LAS float*)(c.lds + 143360);
    const int lane = c.lane, wave = c.wave, fq = lane >> 4, fr = lane & 15;
    const int q0 = 16 * wave, qi = q0 + fr;
    const int tokq = it.b * SEQ + (128 * n + qi) * dil + it.r;
    f32x4 sa[10];
#pragma unroll
    for (int kt = 0; kt < 10; ++kt) { int kr = q0 + 16 * kt + fr; kr = kr > 255 ? 255 : kr;
        sa[kt] = (f32x4){0.f, 0.f, 0.f, 0.f};
#pragma unroll
        for (int ks = 0; ks < 4; ++ks) sa[kt] = MFMA16(*(const LAS bf16x8*)(Ks + kr * 272 + (32 * ks + 8 * fq) * 2), qf[ks], sa[kt]);
        if (kt & 1) __builtin_amdgcn_sched_barrier(0); }
    float mx = -1e30f;
#pragma unroll
    for (int kt = 0; kt < 10; ++kt)
#pragma unroll
        for (int rg = 0; rg < 4; ++rg) { const int t = 16 * kt + 4 * fq + rg - fr; float lg = sa[kt][rg] * 0.08838834764831845f + rb[t + 16];
            if (n == 0 && (q0 + 16 * kt + 4 * fq + rg) < 128) lg = -1e30f;
            sa[kt][rg] = lg; mx = fmaxf(mx, lg); }
    mx = fmaxf(mx, __shfl_xor(mx, 16)); mx = fmaxf(mx, __shfl_xor(mx, 32));
    float sum = 0.f;
#pragma unroll
    for (int kt = 0; kt < 10; ++kt)
#pragma unroll
        for (int rg = 0; rg < 4; ++rg) { const float e = __expf(sa[kt][rg] - mx); sa[kt][rg] = e; sum += e; }
    sum += __shfl_xor(sum, 16); sum += __shfl_xor(sum, 32);
    bf16x8 pf[5];
#pragma unroll
    for (int s2 = 0; s2 < 5; ++s2) pf[s2] = pack8(sa[2 * s2], sa[2 * s2 + 1]);
    const float inv = 1.f / sum;
    bf16* orow = (bf16*)(c.ws + WS_ATT) + ((size_t)gi * MP + tokq) * AOUT + slot * HD;
#pragma unroll
    for (int dt = 0; dt < 8; ++dt) { f32x4 o = (f32x4){0.f, 0.f, 0.f, 0.f};
#pragma unroll
        for (int s2 = 0; s2 < 5; ++s2) { int r0 = q0 + 32 * s2 + 4 * fq + (fr >> 2), r1 = r0 + 16; r0 = r0 > 255 ? 255 : r0; r1 = r1 > 255 ? 255 : r1;
            const int cb2 = (16 * dt + 4 * (fr & 3)) * 2; o = MFMA16(cat4(tr_read(Vs + r0 * 288 + cb2), tr_read(Vs + r1 * 288 + cb2)), pf[s2], o); }
        u32x2 w; w.x = pk2(o[0] * inv, o[1] * inv); w.y = pk2(o[2] * inv, o[3] * inv); *(u32x2*)(orow + 16 * dt + 4 * fq) = w;
        if (dt & 1) __builtin_amdgcn_sched_barrier(0); }
    if (fq == 0) ((float*)(c.ws + WS_LSE))[((size_t)gi * MP + tokq) * HPP + slot] = mx + __logf(sum);
}

__device__ __forceinline__ void ph_mixers(CP& p, const Ctx& c) {
    const int G = gridDim.x;
    int it = blockIdx.x;
    for (; it < 512; it += G) ssd_states_item(p, c, it >> 7, (it >> 3) & 15, it & 7);
    int a = it - 512;
    if (a < 1536) {
        AttnPre pre; attn_prefetch(p, c, attn_decode(a), pre);
#pragma clang loop unroll(disable)
        for (; a < 1536; a += G) {
            const AttnIt cur = attn_decode(a);
            attn_store_lds(c, pre);
            bf16x8 qf[4];
#pragma unroll
            for (int ks = 0; ks < 4; ++ks) qf[ks] = pre.q[ks];
            __syncthreads();
            if (a + G < 1536) attn_prefetch(p, c, attn_decode(a + G), pre);
            attn_compute(p, c, cur, qf);
            __syncthreads();
        }
    }
}
__device__ __forceinline__ void ph_sample_mix(CP& p, const Ctx& c) {
    const int lane = c.lane;
    for (int it = c.gw; it < SB * NH * HP; it += c.ngw) {
        const int b = it >> 11, h = (it >> 6) & 31, pp = it & 63, g = h >> 2;
        const float* xcs = (const float*)(c.ws + WS_SMP + SM_XC) + (size_t)b * CONVD;
        const float dtv = ((const float*)(c.ws + WS_SMP + SM_DT))[b * NH + h], a = __expf(-__expf(p.in[I_ALOG][h]) * dtv), xdt = dtv * xcs[h * HP + pp];
        const float* h0 = p.in[I_SSM] + (((size_t)b * NH + h) * HP + pp) * SN; float* ho = p.out + O_SSSM + (((size_t)b * NH + h) * HP + pp) * SN;
        const f32x2 hv = *(const f32x2*)(h0 + 2 * lane), bv = *(const f32x2*)(xcs + INNER + g * SN + 2 * lane), cv = *(const f32x2*)(xcs + INNER + SG * SN + g * SN + 2 * lane);
        const f32x2 hn = (f32x2){a * hv.x + xdt * bv.x, a * hv.y + xdt * bv.y};
        *(f32x2*)(ho + 2 * lane) = hn;
        const float y = wave_sum(hn.x * cv.x + hn.y * cv.y);
        if (lane == 0) ((float*)(c.ws + WS_SMP + SM_Y))[b * INNER + h * HP + pp] = y;
    }
}
__device__ __forceinline__ void ph_sample_attn(CP& p, const Ctx& c) {
    const int lane = c.lane;
    for (int it = c.gw; it < SB * AH; it += c.ngw) {
        const int b = it / AH, hd = it % AH, gi = hd >> 3, slot = hd & 7, dil = gi == 0 ? 1 : (gi == 1 ? 4 : 16), W = kvlen(gi);
        const float* qk = (const float*)(c.ws + WS_SMP + SM_QK) + (size_t)b * 6144; const float* q = qk + hd * HD; const float* knew = qk + (AH + hd) * HD;
        const float* vnew = (const float*)(c.ws + WS_SMP + SM_PROJ) + (size_t)b * INP + CV + hd * HD;
        const float* const kc0 = p.in[I_KV128]; const float* const kc1 = p.in[I_KV512]; const float* const kc2 = p.in[I_KV2048];
        const float* cache = (gi == 0 ? kc0 : (gi == 1 ? kc1 : kc2)) + (size_t)b * W * 2048;
        LAS float* ps = (LAS float*)c.lds + c.wave * 160;
        const int sub = lane & 3, kg = lane >> 2;
        f32x4 qv[8];
#pragma unroll
        for (int e = 0; e < 8; ++e) qv[e] = *(const f32x4*)(q + sub * 32 + 4 * e);
        float lg[9]; float mx = -1e30f;
#pragma unroll
        for (int ps9 = 0; ps9 < 9; ++ps9) { const int jj = ps9 * 16 + kg; const int jc = jj > 128 ? 128 : jj;
            const float* kr = (jc == 0 ? knew : cache + ((size_t)(W - dil * jc) * 2 + 0) * 1024 + slot * HD) + sub * 32; float sdot = 0.f;
#pragma unroll
            for (int e = 0; e < 8; ++e) { const f32x4 kv = *(const f32x4*)(kr + 4 * e); sdot += (kv.x * qv[e].x + kv.y * qv[e].y) + (kv.z * qv[e].z + kv.w * qv[e].w); }
            sdot += __shfl_xor(sdot, 1); sdot += __shfl_xor(sdot, 2);
            lg[ps9] = jj <= 128 ? sdot * 0.08838834764831845f + p.in[I_RELB][rel_bucket(jc * dil) * AH + hd] : -1e30f; mx = fmaxf(mx, lg[ps9]); }
        mx = wave_max(mx); float sum = 0.f;
#pragma unroll
        for (int ps9 = 0; ps9 < 9; ++ps9) { const int jj = ps9 * 16 + kg; const float e = jj <= 128 ? __expf(lg[ps9] - mx) : 0.f; if (sub == 0) { ps[jj] = e; sum += e; } }
        sum = wave_sum(sum);
        LDS_WAIT();
        const int ksl = lane >> 3, dc = lane & 7;
        f32x4 oa[4];
#pragma unroll
        for (int q4 = 0; q4 < 4; ++q4) oa[q4] = (f32x4){0.f, 0.f, 0.f, 0.f};
#pragma unroll 1
        for (int j0 = 0; j0 < 160; j0 += 32) { f32x4 vv[4][4]; float pj[4];
#pragma unroll
            for (int st = 0; st < 4; ++st) { const int jj = j0 + 8 * st + ksl; const int jc = jj > 128 ? 128 : jj; const float* vr = (jc == 0 ? vnew : cache + ((size_t)(W - dil * jc) * 2 + 1) * 1024 + slot * HD) + 16 * dc;
                pj[st] = jj <= 128 ? ps[jj] : 0.f;
#pragma unroll
                for (int q4 = 0; q4 < 4; ++q4) vv[st][q4] = *(const f32x4*)(vr + 4 * q4); }
#pragma unroll
            for (int st = 0; st < 4; ++st)
#pragma unroll
                for (int q4 = 0; q4 < 4; ++q4) oa[q4] += vv[st][q4] * pj[st]; }
#pragma unroll
        for (int q4 = 0; q4 < 4; ++q4)
#pragma unroll
            for (int e = 0; e < 4; ++e) { float t = oa[q4][e]; t += __shfl_xor(t, 8); t += __shfl_xor(t, 16); t += __shfl_xor(t, 32); oa[q4][e] = t; }
        const float inv = 1.f / sum;
        if (ksl == 0) { float* ao = (float*)(c.ws + WS_SMP + SM_ATT) + ((size_t)gi * SB + b) * AOUT + slot * HD + 16 * dc;
#pragma unroll
            for (int q4 = 0; q4 < 4; ++q4) *(f32x4*)(ao + 4 * q4) = oa[q4] * inv; }
        if (lane == 0) ((float*)(c.ws + WS_SMP + SM_LSE))[(gi * SB + b) * HPP + slot] = mx + __logf(sum);
        LDS_WAIT();
    }
}

__device__ __forceinline__ void ph_combine(CP& p, const Ctx& c, int blk0) {
    if ((int)blockIdx.x < blk0) return;
    const int lane = c.lane; const float* lse = (const float*)(c.ws + WS_LSE);
    for (int m = c.gw - blk0 * NWAVES; m < MP; m += c.ngw - blk0 * NWAVES) {
        bf16* arow = (bf16*)(c.ws + WS_A1) + (size_t)m * MIXK;
#pragma unroll
        for (int j = 0; j < 4; ++j) { const int ch = 4 * (lane + 64 * j), slot = ch >> 7;
            const float l0 = lse[((size_t)0 * MP + m) * HPP + slot], l1 = lse[((size_t)1 * MP + m) * HPP + slot], l2 = lse[((size_t)2 * MP + m) * HPP + slot];
            const float mx = fmaxf(l0, fmaxf(l1, l2)); float w0 = __expf(l0 - mx), w1 = __expf(l1 - mx), w2 = __expf(l2 - mx); const float inv = 1.f / (w0 + w1 + w2); w0 *= inv; w1 *= inv; w2 *= inv;
            const bf16* ab = (const bf16*)(c.ws + WS_ATT) + (size_t)m * AOUT + ch;
            const u32x2 a0 = *(const u32x2*)ab, a1 = *(const u32x2*)(ab + (size_t)MP * AOUT), a2 = *(const u32x2*)(ab + (size_t)2 * MP * AOUT);
            const float o0 = w0 * bf2f(a0.x & 0xffffu) + w1 * bf2f(a1.x & 0xffffu) + w2 * bf2f(a2.x & 0xffffu), o1 = w0 * bf2f(a0.x >> 16) + w1 * bf2f(a1.x >> 16) + w2 * bf2f(a2.x >> 16);
            const float o2 = w0 * bf2f(a0.y & 0xffffu) + w1 * bf2f(a1.y & 0xffffu) + w2 * bf2f(a2.y & 0xffffu), o3 = w0 * bf2f(a0.y >> 16) + w1 * bf2f(a1.y >> 16) + w2 * bf2f(a2.y >> 16);
            u32x2 w; w.x = pk2(o0, o1); w.y = pk2(o2, o3); *(u32x2*)(arow + INNER + ch) = w; }
    }
}
__device__ __forceinline__ void ph_sample_a1(CP& p, const Ctx& c) {
    const int lane = c.lane;
    for (int b = c.gw; b < SB; b += c.ngw) {
        f32x4 v[8]; load_row((const float*)(c.ws + WS_SMP + SM_Y) + (size_t)b * INNER, v, lane);
        const float* xcs = (const float*)(c.ws + WS_SMP + SM_XC) + (size_t)b * CONVD; const float* zs = (const float*)(c.ws + WS_SMP + SM_PROJ) + (size_t)b * INP + CZ;
        float ss = 0.f;
#pragma unroll
        for (int j = 0; j < 8; ++j) { const int ch = 4 * (lane + 64 * j); const float dsk = p.in[I_DSKIP][ch >> 6]; const f32x4 xv = *(const f32x4*)(xcs + ch), zv = *(const f32x4*)(zs + ch);
            v[j].x = (v[j].x + dsk * xv.x) * siluf(zv.x); v[j].y = (v[j].y + dsk * xv.y) * siluf(zv.y); v[j].z = (v[j].z + dsk * xv.z) * siluf(zv.z); v[j].w = (v[j].w + dsk * xv.w) * siluf(zv.w);
            ss += (v[j].x * v[j].x + v[j].y * v[j].y) + (v[j].z * v[j].z + v[j].w * v[j].w); }
        const float rs = rsqrtf(wave_sum(ss) * (1.f / INNER) + EPS);
        bf16* arow = (bf16*)(c.ws + WS_SMP + SM_A1BF) + (size_t)b * MIXK;
#pragma unroll
        for (int j = 0; j < 8; ++j) { const int ch = 4 * (lane + 64 * j); const f32x4 o = v[j] * rs; u32x2 w; w.x = pk2(o.x, o.y); w.y = pk2(o.z, o.w); *(u32x2*)(arow + ch) = w; }
        const float* lse = (const float*)(c.ws + WS_SMP + SM_LSE); const float* att = (const float*)(c.ws + WS_SMP + SM_ATT);
#pragma unroll
        for (int j = 0; j < 4; ++j) { const int ch = 4 * (lane + 64 * j), slot = ch >> 7;
            const float l0 = lse[(0 * SB + b) * HPP + slot], l1 = lse[(1 * SB + b) * HPP + slot], l2 = lse[(2 * SB + b) * HPP + slot];
            const float mx = fmaxf(l0, fmaxf(l1, l2)); float w0 = __expf(l0 - mx), w1 = __expf(l1 - mx), w2 = __expf(l2 - mx); const float inv = 1.f / (w0 + w1 + w2); w0 *= inv; w1 *= inv; w2 *= inv;
            const f32x4 a0 = *(const f32x4*)(att + ((size_t)0 * SB + b) * AOUT + ch), a1 = *(const f32x4*)(att + ((size_t)1 * SB + b) * AOUT + ch), a2 = *(const f32x4*)(att + ((size_t)2 * SB + b) * AOUT + ch);
            const f32x4 o = a0 * w0 + a1 * w1 + a2 * w2;
            u32x2 w; w.x = pk2(o.x, o.y); w.y = pk2(o.z, o.w); *(u32x2*)(arow + INNER + ch) = w; }
    }
}

__device__ __forceinline__ void ph_pool(CP& p, const Ctx& c) {
    const int lane = c.lane;
    const bf16* x2 = (const bf16*)(c.ws + WS_Y); const float* rss = (const float*)(c.ws + WS_RS) + MP;
    bf16* pg = (bf16*)(c.ws + WS_A1);
    const int gt = blockIdx.x * NT + c.tid, gn = gridDim.x * NT;
    for (int task = gt; task < BATCH * 128 * 512; task += gn) {
        const int cq = task & 511, seg = (task >> 9) & 127, b = task >> 16, ch = 4 * cq, gi = cq >> 7, t0 = seg * 16;
        const f32x4 gg = *(const f32x4*)(p.in[I_NMIX] + D + ch), s1 = *(const f32x4*)(modp(c.ws, 1, b, 1) + ch), sh = *(const f32x4*)(modp(c.ws, 1, b, 0) + ch);
        const f32x4 gm = gg * (s1 + 1.f);
        const bf16* xb = x2 + (size_t)b * SEQ * D + ch; const float* rb = rss + b * SEQ;
        f32x4 xh[31];
#pragma unroll
        for (int i = 0; i < 31; ++i) { const int t = t0 - 15 + i; if (t >= 0 && i >= 16 - (2 << gi)) { const u32x2 x = *(const u32x2*)(xb + (size_t)t * D); xh[i] = (f32x4){__uint_as_float(x.x << 16), __uint_as_float(x.x & 0xffff0000u), __uint_as_float(x.y << 16), __uint_as_float(x.y & 0xffff0000u)} * rsqrtf(rb[t] * (1.f / D) + EPS); } else xh[i] = (f32x4){0.f, 0.f, 0.f, 0.f}; }
        auto emit = [&](int i, const f32x4& S, int w) { const int t = t0 + i; const int cnt = t + 1 < w ? t + 1 : w; const f32x4 xn = xh[15 + i]; const f32x4 o = gm * (S * __builtin_amdgcn_rcpf((float)cnt) - xn);
            u32x2 wv; wv.x = pk2(o.x, o.y); wv.y = pk2(o.z, o.w); *(u32x2*)(pg + (size_t)(b * SEQ + t) * D + ch) = wv;
            if (t >= SEQ - 15) *(f32x4*)(p.out + O_PPOOL + ((size_t)b * 15 + (t - (SEQ - 15))) * D + ch) = xn * gm + sh; };
#define POOL_W(W_) { f32x4 S = (f32x4){0.f, 0.f, 0.f, 0.f}; _Pragma("unroll") for (int k = 0; k < W_; ++k) S += xh[15 - k]; \
            _Pragma("unroll") for (int i = 0; i < 16; ++i) { emit(i, S, W_); if (i < 15) S += xh[16 + i] - xh[16 + i - W_]; } }
        if (gi == 0) POOL_W(2) else if (gi == 1) POOL_W(4) else if (gi == 2) POOL_W(8) else POOL_W(16)
#undef POOL_W
    }
    for (int it = c.gw; it < 112 + 64; it += c.ngw) {
        if (it < 112) { const int b = it / 14, k = it % 14; f32x4 t4[8]; load_row(p.in[I_POOL] + ((size_t)b * 15 + k + 1) * D, t4, lane); store_row_f32(p.out + O_SPOOL + ((size_t)b * 15 + k) * D, t4, lane); continue; }
        const int b = (it - 112) >> 3, j = (it - 112) & 7;
        f32x4 v[8]; load_row((const float*)(c.ws + WS_SMP + SM_X2) + (size_t)b * D, v, lane);
        const float rs = row_rs(v);
        const int ch = 4 * (lane + 64 * j), gi = ch >> 9, w = 2 << gi;
        const f32x4 xr = v[0];
        (void)xr;
        f32x4 xo;
#pragma unroll
        for (int jj = 0; jj < 8; ++jj) if (jj == j) xo = v[jj];
        ((f32x4*)((float*)(c.ws + WS_SMP + SM_X3) + (size_t)b * D))[lane + 64 * j] = xo;
        const f32x4 gg = *(const f32x4*)(p.in[I_NMIX] + D + ch), s1 = *(const f32x4*)(modp(c.ws, 1, 4 + b, 1) + ch), s0 = *(const f32x4*)(modp(c.ws, 1, 4 + b, 0) + ch);
        const f32x4 u = xo * rs * gg * (s1 + 1.f) + s0;
        const float* sp = p.in[I_POOL] + (size_t)b * 15 * D;
        *(f32x4*)(p.out + O_SPOOL + ((size_t)b * 15 + 14) * D + ch) = u;
        f32x4 pr[15];
#pragma unroll
        for (int k = 1; k < 16; ++k) pr[k - 1] = *(const f32x4*)(sp + (size_t)(15 - k) * D + ch);
        f32x4 sacc = u;
#pragma unroll
        for (int k = 1; k < 16; ++k) if (k < w) sacc += pr[k - 1];
        const f32x4 o = sacc * (1.f / (float)w) - u; u32x2 wv; wv.x = pk2(o.x, o.y); wv.y = pk2(o.z, o.w); *(u32x2*)((bf16*)(c.ws + WS_SMP + SM_PGBF) + (size_t)b * D + ch) = wv;
    }
}

constexpr int NPHASE = 15;
constexpr int KV_SPLIT = 7000;
__device__ __forceinline__ unsigned char* launder(unsigned char* q) { const unsigned long long v = (unsigned long long)q; unsigned lo = (unsigned)__builtin_amdgcn_readfirstlane((int)(unsigned)v), hi = (unsigned)__builtin_amdgcn_readfirstlane((int)(unsigned)(v >> 32)); asm volatile("" : "+s"(lo), "+s"(hi)); return (unsigned char*)(((unsigned long long)hi << 32) | (unsigned long long)lo); }
__device__ __forceinline__ CP* kernarg_p() { unsigned long long v = (unsigned long long)__builtin_amdgcn_kernarg_segment_ptr(); unsigned lo = (unsigned)v, hi = (unsigned)(v >> 32); asm volatile("" : "+s"(lo), "+s"(hi)); return (CP*)(((unsigned long long)hi << 32) | (unsigned long long)lo); }
__global__ void __launch_bounds__(NT, 2) mk_fwd(P p_unused) {
    (void)p_unused;
    CP& p0 = *kernarg_p();
    extern __shared__ __attribute__((aligned(16))) unsigned char lds_raw[];
    Ctx c0; c0.lds = (LAS unsigned char*)lds_raw; c0.tid = threadIdx.x; c0.lane = c0.tid & 63; c0.wave = __builtin_amdgcn_readfirstlane(c0.tid >> 6);
    c0.gw = blockIdx.x * NWAVES + c0.wave; c0.ngw = gridDim.x * NWAVES; c0.ws = nullptr;
    volatile LAS unsigned* bst = (volatile LAS unsigned*)(c0.lds + LDS_BYTES - 16);
    if (c0.tid < 4) bst[c0.tid] = 0u;
    __syncthreads();
#define WS_UNIFORM() ((unsigned char*)((((unsigned long long)(unsigned)__builtin_amdgcn_readfirstlane((int)((unsigned long long)p0.ws >> 32))) << 32) | (unsigned long long)(unsigned)__builtin_amdgcn_readfirstlane((int)(unsigned)(unsigned long long)p0.ws)))
    (void)xcd_barrier_post((unsigned*)(WS_UNIFORM() + WS_CTL) + 1024, bst);
    const int lo = p0.ph_lo, hi = p0.ph_hi;
    const int G = gridDim.x;
#ifndef PHMASK
#define PHMASK 0xFFFFF
#endif
#define IN(k) (((PHMASK >> (k)) & 1) && lo <= (k) && (k) < hi)
#ifndef REPMASK
#define REPMASK 0
#endif
#define REPLOOP(k) _Pragma("clang loop unroll(disable)") for (int rep_ = 0; rep_ < 1 + ((REPMASK >> (k)) & 1); ++rep_)
#define SEAM(k) do { if (IN(k) && IN((k) + 1)) { XcdBarrier bb_; bb_.bar = (unsigned*)(WS_UNIFORM() + WS_CTL) + 1024; bb_.x = xb_xcc_id(); bb_.st = (volatile LAS unsigned*)(c0.lds + LDS_BYTES - 16); xcd_barrier(bb_); } } while (0)
    if (IN(0)) REPLOOP(0) { CP& p = *kernarg_p(); Ctx c = c0; c.ws = launder(p.ws); unsigned char* ws = c.ws; (void)ws; ph_prologue(p, c); }
    SEAM(0);
    if (IN(1)) REPLOOP(1) { CP& p = *kernarg_p(); Ctx c = c0; c.ws = launder(p.ws); unsigned char* ws = c.ws; (void)ws; ph_normmod<false>(p, c, p.in[I_XP], p.in[I_XS], p.in[I_NMIX], 0, 0, 1, (float*)(ws + WS_SMP + SM_X1)); }
    SEAM(1);
    if (IN(2)) REPLOOP(2) { CP& p = *kernarg_p(); Ctx c = c0; c.ws = launder(p.ws); unsigned char* ws = c.ws; (void)ws;
        pg8::Gemm g{(const bf16*)(ws + WS_A0), (const bf16*)(ws + WS_WIN), MP, INP, D, D, D, 1 << 20, D / 64, D / 64}; pg8::StaticOrder S; S.init(MP, INP, G, blockIdx.x);
        if (G == 256 && blockIdx.x >= 160) { ph_kvcopy(p, c, 0, KV_SPLIT, (blockIdx.x - 160) * NWAVES + c.wave, 96 * NWAVES); __syncthreads(); }
        pg8::EpiProj E{(bf16*)(ws + WS_PROJ), (float*)(ws + WS_DT), p.out, p.in[I_QG], p.in[I_KG], p.in[I_DTB], (LAS float*)(c.lds + 131072)};
        pg8::gemm_phase<pg8::EpiProj>(c.lds, g, S, E);
        float* sp = (float*)(ws + WS_SMP + SM_PROJ); const bf16* ua = (const bf16*)(ws + WS_SMP + SM_USBF);
        if (rep_ == 0) skinny(c, [&](int r, int k) { return *(const bf16x8*)(ua + (size_t)r * D + k); }, (const bf16*)(ws + WS_WIN), D, D, INP, 2, [&](int r, int n, float v) { atomicAdd(sp + (size_t)r * INP + n, v); }, D / 64);
    }
    SEAM(2);
    if (IN(3)) REPLOOP(3) { CP& p = *kernarg_p(); Ctx c = c0; c.ws = launder(p.ws); unsigned char* ws = c.ws; (void)ws; ph_mixers(p, c); ph_sample_postproj(p, c); ph_kvcopy(p, c, (G == 256 ? KV_SPLIT : 0), 10740, c.gw, c.ngw); }
    SEAM(3);
    if (IN(4)) REPLOOP(4) { CP& p = *kernarg_p(); Ctx c = c0; c.ws = launder(p.ws); unsigned char* ws = c.ws; (void)ws; const int sb0 = G >= 64 ? 24 : 0; ph_sample_attn(p, c); ph_ssd_scan(p, c, sb0); ph_combine(p, c, sb0); ph_sample_mix(p, c); }
    SEAM(4);
    if (IN(5)) REPLOOP(5) { CP& p = *kernarg_p(); Ctx c = c0; c.ws = launder(p.ws); unsigned char* ws = c.ws; (void)ws;
        for (int it = blockIdx.x; it < 512; it += gridDim.x) ssd_out_item(p, c, it >> 7, (it >> 3) & 15, it & 7, rep_ == 0);
        ph_sample_a1(p, c); }
    SEAM(5);
    if (IN(6)) REPLOOP(6) { CP& p = *kernarg_p(); Ctx c = c0; c.ws = launder(p.ws); unsigned char* ws = c.ws; (void)ws;
        pg8::Gemm g{(const bf16*)(ws + WS_A1), (const bf16*)(ws + WS_WOUT), MP, D, MIXK, MIXK, MIXK, 1 << 20}; pg8::StaticOrder S; S.init(MP, D, G, blockIdx.x);
        pg8::EpiResid<false, true> E{p.in[I_XP], (void*)(ws + WS_XC), D, modp(c.ws, 0, 0, 2), MODW, nullptr, nullptr};
        pg8::RowScaleHook H{(const float*)(ws + WS_RS)};
        pg8::gemm_phase<pg8::EpiResid<false, true>, true, pg8::RowScaleHook>(c.lds, g, S, E, H);
        float* x1s = (float*)(ws + WS_SMP + SM_X1); const bf16* aa = (const bf16*)(ws + WS_SMP + SM_A1BF);
        if (rep_ == 0) skinny(c, [&](int r, int k) { return *(const bf16x8*)(aa + (size_t)r * MIXK + k); }, (const bf16*)(ws + WS_WOUT), MIXK, MIXK, D, 12, [&](int r, int n, float v) { atomicAdd(x1s + r * D + n, modp(c.ws, 0, 4 + r, 2)[n] * v); });
    }
    SEAM(6);
    if (IN(7)) REPLOOP(7) { CP& p = *kernarg_p(); Ctx c = c0; c.ws = launder(p.ws); unsigned char* ws = c.ws; (void)ws; ph_normmod<true>(p, c, (const void*)(ws + WS_XC), (const float*)(ws + WS_SMP + SM_X1), p.in[I_NMLP], 0, 3, 4, (float*)(ws + WS_SMP + SM_X2)); }
    SEAM(7);
    if (IN(8)) REPLOOP(8) { CP& p = *kernarg_p(); Ctx c = c0; c.ws = launder(p.ws); unsigned char* ws = c.ws; (void)ws;
        pg8::Gemm g{(const bf16*)(ws + WS_A0), (const bf16*)(ws + WS_W1), MP, DFF, D, D, D, 1 << 20, D / 64, D / 64}; pg8::StaticOrder S; S.init(MP, DFF, G, blockIdx.x);
        pg8::EpiBf16<1> E{(bf16*)(ws + WS_HDN), DFF, DFF / 64};
        pg8::gemm_phase<pg8::EpiBf16<1>>(c.lds, g, S, E);
        float* hacc = (float*)(ws + WS_SMP + SM_H0); const bf16* ua = (const bf16*)(ws + WS_SMP + SM_USBF);
        if (rep_ == 0) skinny(c, [&](int r, int k) { return *(const bf16x8*)(ua + (size_t)r * D + k); }, (const bf16*)(ws + WS_W1), D, D, DFF, 4, [&](int r, int n, float v) { atomicAdd(hacc + (size_t)r * DFF + n, v); }, D / 64);
    }
    SEAM(8);
    if (IN(9)) REPLOOP(9) { CP& p = *kernarg_p(); Ctx c = c0; c.ws = launder(p.ws); unsigned char* ws = c.ws; (void)ws;
        pg8::Gemm g{(const bf16*)(ws + WS_HDN), (const bf16*)(ws + WS_W2), MP, D, DFF, DFF, DFF, 1 << 20, DFF / 64, DFF / 64}; pg8::StaticOrder S; S.init(MP, D, G, blockIdx.x);
        pg8::EpiResid<true, true> E{(const void*)(ws + WS_XC), (void*)(ws + WS_Y), D, modp(c.ws, 0, 0, 5), MODW, nullptr, rep_ == 0 ? (float*)(ws + WS_RS) + MP : nullptr};
        pg8::gemm_phase<pg8::EpiResid<true, true>>(c.lds, g, S, E);
        float* x2s = (float*)(ws + WS_SMP + SM_X2); const float* hacc = (const float*)(ws + WS_SMP + SM_H0);
        if (rep_ == 0) skinny(c, [&](int r, int k) { return relu2_bf16x8(hacc + (size_t)r * DFF + k); }, (const bf16*)(ws + WS_W2), DFF, DFF, D, 16, [&](int r, int n, float v) { atomicAdd(x2s + r * D + n, modp(c.ws, 0, 4 + r, 5)[n] * v); }, DFF / 64);
    }
    SEAM(9);
    if (IN(10)) REPLOOP(10) { CP& p = *kernarg_p(); Ctx c = c0; c.ws = launder(p.ws); unsigned char* ws = c.ws; (void)ws; ph_pool(p, c); }
    SEAM(10);
    if (IN(11)) REPLOOP(11) { CP& p = *kernarg_p(); Ctx c = c0; c.ws = launder(p.ws); unsigned char* ws = c.ws; (void)ws;
        pg8::Gemm g{(const bf16*)(ws + WS_A1), (const bf16*)(ws + WS_WPOOL), MP, D, 512, D, 512, 2}; pg8::StaticOrder S; S.init(MP, D, G, blockIdx.x);
        pg8::EpiResid<true, true> E{(const void*)(ws + WS_Y), (void*)(ws + WS_XC), D, modp(c.ws, 1, 0, 2), MODW, p.in[I_POOLS], nullptr};
        pg8::gemm_phase<pg8::EpiResid<true, true>>(c.lds, g, S, E);
        float* x3s = (float*)(ws + WS_SMP + SM_X3); const float* psc = p.in[I_POOLS]; const bf16* pa = (const bf16*)(ws + WS_SMP + SM_PGBF);
#pragma unroll 1
        for (int gq = 0; gq < 4; ++gq)
            if (rep_ == 0) skinny(c, [&](int r, int k) { return *(const bf16x8*)(pa + (size_t)r * D + gq * 512 + k); }, (const bf16*)(ws + WS_WPOOL) + (size_t)gq * 512 * 512, 512, 512, 512, 4,
                   [&](int r, int n, float v) { const int col = gq * 512 + n; atomicAdd(x3s + r * D + col, modp(c.ws, 1, 4 + r, 2)[col] * psc[col] * v); });
    }
    SEAM(11);
    if (IN(12)) REPLOOP(12) { CP& p = *kernarg_p(); Ctx c = c0; c.ws = launder(p.ws); unsigned char* ws = c.ws; (void)ws; ph_normmod<true>(p, c, (const void*)(ws + WS_XC), (const float*)(ws + WS_SMP + SM_X3), p.in[I_NMLP] + D, 1, 3, 4, p.out + O_YS); }
    SEAM(12);
    if (IN(13)) REPLOOP(13) { CP& p = *kernarg_p(); Ctx c = c0; c.ws = launder(p.ws); unsigned char* ws = c.ws; (void)ws;
        pg8::Gemm g{(const bf16*)(ws + WS_A0), (const bf16*)(ws + WS_W1) + (size_t)DFF * D, MP, DFF, D, D, D, 1 << 20, D / 64, D / 64}; pg8::StaticOrder S; S.init(MP, DFF, G, blockIdx.x);
        pg8::EpiBf16<1> E{(bf16*)(ws + WS_HDN), DFF, DFF / 64};
        pg8::gemm_phase<pg8::EpiBf16<1>>(c.lds, g, S, E);
        float* hacc = (float*)(ws + WS_SMP + SM_H1); const bf16* ua = (const bf16*)(ws + WS_SMP + SM_USBF);
        if (rep_ == 0) skinny(c, [&](int r, int k) { return *(const bf16x8*)(ua + (size_t)r * D + k); }, (const bf16*)(ws + WS_W1) + (size_t)DFF * D, D, D, DFF, 4, [&](int r, int n, float v) { atomicAdd(hacc + (size_t)r * DFF + n, v); }, D / 64);
    }
    SEAM(13);
    if (IN(14)) REPLOOP(14) { CP& p = *kernarg_p(); Ctx c = c0; c.ws = launder(p.ws); unsigned char* ws = c.ws; (void)ws;
        pg8::Gemm g{(const bf16*)(ws + WS_HDN), (const bf16*)(ws + WS_W2) + (size_t)D * DFF, MP, D, DFF, DFF, DFF, 1 << 20, DFF / 64, DFF / 64}; pg8::StaticOrder S; S.init(MP, D, G, blockIdx.x);
        pg8::EpiResid<true, false> E{(const void*)(ws + WS_XC), (void*)(p.out + O_YP), D, modp(c.ws, 1, 0, 5), MODW, nullptr, nullptr};
        pg8::gemm_phase<pg8::EpiResid<true, false>>(c.lds, g, S, E);
        float* ys = p.out + O_YS; const float* hacc = (const float*)(ws + WS_SMP + SM_H1);
        if (rep_ == 0) skinny(c, [&](int r, int k) { return relu2_bf16x8(hacc + (size_t)r * DFF + k); }, (const bf16*)(ws + WS_W2) + (size_t)D * DFF, DFF, DFF, D, 16, [&](int r, int n, float v) { atomicAdd(ys + r * D + n, modp(c.ws, 1, 4 + r, 5)[n] * v); }, DFF / 64);
    }
#undef IN
#undef SEAM
}

extern "C" void kernel_launch(void* const* d_in, const int* in_sizes, int n_in, void* d_out, int out_size, void* d_ws, size_t ws_size, hipStream_t stream) {
    static int grid = 0;
    if (grid == 0) {
        if (n_in != N_IN || (size_t)out_size != O_END || ws_size < WS_END) { fprintf(stderr, "kernel_launch: shape mismatch: n_in %d (want %d), out %d (want %zu), ws %zu (want >= %zu)\n", n_in, (int)N_IN, out_size, (size_t)O_END, ws_size, (size_t)WS_END); grid = -1; return; }
        int dev = 0, cus = 0, per_cu = 0;
        if (hipGetDevice(&dev) != hipSuccess || hipDeviceGetAttribute(&cus, hipDeviceAttributeMultiprocessorCount, dev) != hipSuccess) { grid = -1; return; }
        if (hipFuncSetAttribute((const void*)mk_fwd, hipFuncAttributeMaxDynamicSharedMemorySize, LDS_BYTES) != hipSuccess) { fprintf(stderr, "kernel_launch: hipFuncSetAttribute failed\n"); grid = -1; return; }
        if (hipOccupancyMaxActiveBlocksPerMultiprocessor(&per_cu, (const void*)mk_fwd, NT, LDS_BYTES) != hipSuccess || per_cu < 1) { fprintf(stderr, "kernel_launch: occupancy query says %d blocks per CU\n", per_cu); (void)hipGetLastError(); per_cu = 1; }
        grid = cus;
        fprintf(stderr, "kernel_launch: %d CUs, occupancy query %d per CU, grid %d\n", cus, per_cu, grid);
    }
    if (grid < 0) return;
    if (hipMemsetAsync((char*)d_ws + WS_CTL, 0, WS_MOD + (size_t)2 * 12 * MODW * 4, stream) != hipSuccess) { fprintf(stderr, "kernel_launch: memset failed\n"); return; }
    P a{};
    for (int i = 0; i < N_IN; ++i) a.in[i] = (const float*)d_in[i];
    a.out = (float*)d_out; a.ws = (unsigned char*)d_ws;
#if MK_ONE_LAUNCH
    a.ph_lo = 0; a.ph_hi = NPHASE;
    { void* args[] = {&a}; hipError_t e = hipLaunchCooperativeKernel((const void*)mk_fwd, dim3(grid), dim3(NT), args, LDS_BYTES, stream);
      if (e != hipSuccess) fprintf(stderr, "kernel_launch: cooperative launch failed: %s\n", hipGetErrorString(e)); }
#else
    for (int ph = 0; ph < NPHASE; ++ph) { a.ph_lo = ph; a.ph_hi = ph + 1; void* args[] = {&a};
        hipError_t e = hipLaunchCooperativeKernel((const void*)mk_fwd, dim3(grid), dim3(NT), args, LDS_BYTES, stream);
        if (e != hipSuccess) { fprintf(stderr, "kernel_launch: launch %d failed: %s\n", ph, hipGetErrorString(e)); break; } }
#endif
}
```

```cpp
#include <hip/hip_runtime.h>
#include <hip/hip_cooperative_groups.h>
#include <cstdio>
#include <cstdint>
namespace cg = cooperative_groups;

#ifndef MK_ONE_LAUNCH
#define MK_ONE_LAUNCH 1
#endif

#define LAS __attribute__((address_space(3)))
typedef unsigned short bf16;
typedef short bf16x8 __attribute__((ext_vector_type(8)));
typedef float f32x4 __attribute__((ext_vector_type(4)));
typedef float f32x2 __attribute__((ext_vector_type(2)));
typedef unsigned u32x4 __attribute__((ext_vector_type(4)));
typedef unsigned u32x2 __attribute__((ext_vector_type(2)));

constexpr int D = 2048, BATCH = 4, SEQ = 2048, MP = BATCH * SEQ, SB = 8;
constexpr int NH = 32, HP = 64, SN = 128, SG = 8, INNER = 2048, CONVD = 4096;
constexpr int AH = 24, HD = 128, HPP = 8, AQKV = 3072, AOUT = 1024;
constexpr int INC = 15392, INP = 15616;
constexpr int CZ = 0, CX = 2048, CQ = 6144, CK = 9216, CV = 12288, CDT = 15360;
constexpr int MIXK = 3072, DFF = 8192, MODW = 6 * D;
constexpr float EPS = 1e-6f;
constexpr int NWAVES = 8, NT = 512;

enum { I_XP = 0, I_XS, I_SSM, I_CONV, I_KV128, I_KV512, I_KV2048, I_POOL, I_CP, I_CS, I_RELB, I_ADAW, I_ADAB, I_NMIX, I_NMLP, I_INW, I_CONVW, I_CONVB,
       I_DTB, I_ALOG, I_DSKIP, I_SSDG, I_QG, I_KG, I_OUTW, I_POOLW, I_POOLS, I_W1, I_W2, N_IN };

constexpr size_t O_YP = 0;
constexpr size_t O_YS = O_YP + (size_t)MP * D;
constexpr size_t O_PSSM = O_YS + (size_t)SB * D;
constexpr size_t O_PCONV = O_PSSM + (size_t)BATCH * NH * HP * SN;
constexpr size_t O_PKV128 = O_PCONV + (size_t)BATCH * 3 * CONVD;
constexpr size_t O_PKV512 = O_PKV128 + (size_t)BATCH * 128 * 2048;
constexpr size_t O_PKV2048 = O_PKV512 + (size_t)BATCH * 512 * 2048;
constexpr size_t O_PPOOL = O_PKV2048 + (size_t)BATCH * 2048 * 2048;
constexpr size_t O_SSSM = O_PPOOL + (size_t)BATCH * 15 * D;
constexpr size_t O_SCONV = O_SSSM + (size_t)SB * NH * HP * SN;
constexpr size_t O_SKV128 = O_SCONV + (size_t)SB * 3 * CONVD;
constexpr size_t O_SKV512 = O_SKV128 + (size_t)SB * 128 * 2048;
constexpr size_t O_SKV2048 = O_SKV512 + (size_t)SB * 512 * 2048;
constexpr size_t O_SPOOL = O_SKV2048 + (size_t)SB * 2048 * 2048;
constexpr size_t O_END = O_SPOOL + (size_t)SB * 15 * D;

constexpr size_t MiB = 1u << 20;
constexpr size_t WS_CTL = 0;
constexpr size_t WS_MOD = 1 * MiB;
constexpr size_t WS_WIN = 4 * MiB;
constexpr size_t WS_WOUT = 66 * MiB;
constexpr size_t WS_W1 = 78 * MiB;
constexpr size_t WS_W2 = 142 * MiB;
constexpr size_t WS_WPOOL = 206 * MiB;
constexpr size_t WS_A0 = 208 * MiB;
constexpr size_t WS_SMP = 240 * MiB;
constexpr size_t WS_PROJ = 244 * MiB;
constexpr size_t WS_HDN = WS_PROJ;
constexpr size_t WS_U = WS_PROJ + 128 * MiB;
constexpr size_t WS_XC = 488 * MiB;
constexpr size_t WS_Y = 552 * MiB;
constexpr size_t WS_ATT = 616 * MiB;
constexpr size_t WS_LSE = 664 * MiB;
constexpr size_t WS_DT = 665 * MiB;
constexpr size_t WS_A1 = 668 * MiB;
constexpr size_t WS_END = 716 * MiB;
constexpr size_t SM_USBF = 0;
constexpr size_t SM_PROJ = 64 * 1024;
constexpr size_t SM_XC = 576 * 1024;
constexpr size_t SM_DT = 704 * 1024;
constexpr size_t SM_QK = 708 * 1024;
constexpr size_t SM_Y = 900 * 1024;
constexpr size_t SM_ATT = 964 * 1024;
constexpr size_t SM_LSE = 1060 * 1024;
constexpr size_t SM_A1BF = 1064 * 1024;
constexpr size_t SM_X1 = 1112 * 1024;
constexpr size_t SM_HBF = 1176 * 1024;
constexpr size_t SM_X2 = 1304 * 1024;
constexpr size_t SM_PGBF = 1368 * 1024;
constexpr size_t SM_X3 = 1400 * 1024;
constexpr size_t SM_H0 = 1500 * 1024;
constexpr size_t SM_H1 = 1756 * 1024;
constexpr size_t WS_RS = 667 * MiB;

constexpr int LDS_BYTES = 147456;

struct P { const float* in[N_IN]; float* out; unsigned char* ws; int ph_lo, ph_hi; };
static_assert(sizeof(P) == 8 * (N_IN + 2) + 8, "no padding in P");
typedef const __attribute__((address_space(4))) P CP;

__device__ __forceinline__ float bf2f(unsigned b) { return __uint_as_float(b << 16); }
__device__ __forceinline__ unsigned f2bf(float f) { unsigned u = __float_as_uint(f); return (u + 0x7fffu + ((u >> 16) & 1u)) >> 16; }
typedef float f32x2v_ __attribute__((ext_vector_type(2)));
typedef __bf16 bf16x2v_ __attribute__((ext_vector_type(2)));
__device__ __forceinline__ unsigned pk2(float lo, float hi) { const f32x2v_ v = {lo, hi}; return __builtin_bit_cast(unsigned, __builtin_convertvector(v, bf16x2v_)); }
__device__ __forceinline__ float wave_sum(float v) {
#pragma unroll
    for (int o = 1; o < 64; o <<= 1) v += __shfl_xor(v, o);
    return v;
}
__device__ __forceinline__ float wave_max(float v) {
#pragma unroll
    for (int o = 1; o < 64; o <<= 1) v = fmaxf(v, __shfl_xor(v, o));
    return v;
}
__device__ __forceinline__ float siluf(float x) { return x * __builtin_amdgcn_rcpf(1.f + __expf(-x)); }
__device__ __forceinline__ float softplusf(float x) { return log1pf(__expf(-fabsf(x))) + fmaxf(x, 0.f); }
#define LDS_WAIT() asm volatile("s_waitcnt lgkmcnt(0)" ::: "memory")

namespace pg8 {
constexpr int BM = 256, BK = 64, HALF = 128, HTB = HALF * BK * 2, STAGE_BYTES = 8 * HTB, NXCD = 8, WGM = 4;
__host__ __device__ __forceinline__ int lds_byte(int r, int c) { const int st = (r >> 4) * 2 + (c >> 5), rr = r & 15, cc = c & 31, ob = rr * 64 + cc * 2; return st * 1024 + (ob ^ (((ob >> 9) & 1) << 5)); }
__host__ __device__ __forceinline__ void stage_rc(int b, int& R, int& C) { const int st = b / 1024, sb = b % 1024, swz = sb ^ (((sb >> 9) & 1) << 5); R = (st >> 1) * 16 + swz / 64; C = (st & 1) * 32 + (swz % 64) / 2; }
__host__ __device__ __forceinline__ int perm32(int rho) { const int n = rho >> 4, i = rho & 15; return 8 * (i >> 2) + 4 * n + (i & 3); }
struct Unit { int pm, pn; };
struct Gemm { const bf16* A; const bf16* Bt; int M, N, K, lda, ldb, agrp; int akt = 0, bkt = 0; };
struct StaticOrder {
    int nM, nN, nwg, G, c;
    __device__ void init(int M, int N, int G_, int c_) { nM = M / BM; nN = N / BM; nwg = nM * nN; G = G_; c = c_; }
    __device__ bool next(int i, Unit& u) const {
        const long L = (long)i * G + c; if (L >= nwg) return false;
        int wgid = (int)L; { const int q = nwg / NXCD, r = nwg % NXCD, xcd = wgid % NXCD, off = wgid / NXCD; wgid = (xcd < r ? xcd * (q + 1) : r * (q + 1) + (xcd - r) * q) + off; }
        const int nig = WGM * nN, gid = wgid / nig, fm = gid * WGM, gsz = (nM - fm) < WGM ? (nM - fm) : WGM;
        u.pm = fm + ((wgid % nig) % gsz); u.pn = (wgid % nig) / gsz;
        { const int rot = gid * (nN / NXCD); u.pn = (u.pn + rot) % nN; }
        return true;
    }
};
__device__ __forceinline__ unsigned cvt_pk_bf16(float lo, float hi) { unsigned r; asm volatile("v_cvt_pk_bf16_f32 %0, %1, %2" : "=v"(r) : "v"(lo), "v"(hi)); return r; }

template <int ACT  > struct EpiBf16 {
    static constexpr bool PERM = true;
    bf16* O; int ldc; int okt;
    __device__ __forceinline__ void operator()(const f32x4 (&acc)[2][2][4][2], const Unit& u, int wr, int wc, int fr, int fq) const {
        const int row0 = u.pm * BM + wr * 64 + fr; const int col0 = u.pn * BM + wc * 32 + 8 * fq;
#pragma unroll
        for (int ai = 0; ai < 2; ++ai)
#pragma unroll
            for (int m = 0; m < 4; ++m) { const int rrow = row0 + ai * HALF + m * 16; bf16* rowp = okt ? O + ((size_t)(rrow >> 8) * okt + (col0 >> 6)) * 16384 + (rrow & 255) * 64 + (col0 & 63) : O + (size_t)rrow * ldc + col0;
#pragma unroll
                for (int bj = 0; bj < 2; ++bj) { f32x4 v0 = acc[ai][bj][m][0], v1 = acc[ai][bj][m][1];
                    if (ACT == 1) {
#pragma unroll
                        for (int j = 0; j < 4; ++j) { const float a = fmaxf(v0[j], 0.f), b = fmaxf(v1[j], 0.f); v0[j] = a * a; v1[j] = b * b; } }
                    u32x4 w; w.x = cvt_pk_bf16(v0[0], v0[1]); w.y = cvt_pk_bf16(v0[2], v0[3]); w.z = cvt_pk_bf16(v1[0], v1[1]); w.w = cvt_pk_bf16(v1[2], v1[3]);
                    *(u32x4*)(rowp + (okt ? bj * 2 * 16384 : bj * HALF)) = w; } }
    }
};
template <bool BIN  , bool BOUT  > struct EpiResid {
    static constexpr bool PERM = true;
    const void* base; void* out; int ldc; const float* gate; int gate_bstride; const float* cscale; float* rowss;
    __device__ __forceinline__ void operator()(const f32x4 (&acc)[2][2][4][2], const Unit& u, int wr, int wc, int fr, int fq) const {
        const int row0 = u.pm * BM + wr * 64 + fr, col0 = u.pn * BM + wc * 32 + 8 * fq;
        const float* gp = gate + (size_t)(u.pm / 8) * gate_bstride;
        f32x4 gv[2][2];
#pragma unroll
        for (int bj = 0; bj < 2; ++bj)
#pragma unroll
            for (int n = 0; n < 2; ++n) { gv[bj][n] = *(const f32x4*)(gp + col0 + bj * HALF + 4 * n); if (cscale) gv[bj][n] = gv[bj][n] * *(const f32x4*)(cscale + col0 + bj * HALF + 4 * n); }
#pragma unroll
        for (int ai = 0; ai < 2; ++ai)
#pragma unroll
            for (int m = 0; m < 4; ++m) { const size_t off = (size_t)(row0 + ai * HALF + m * 16) * ldc + col0; float ssq = 0.f;
#pragma unroll
                for (int bj = 0; bj < 2; ++bj) { f32x4 b0, b1;
                    if (BIN) { const u32x4 x = *(const u32x4*)((const bf16*)base + off + bj * HALF);
                        b0 = (f32x4){__uint_as_float(x.x << 16), __uint_as_float(x.x & 0xffff0000u), __uint_as_float(x.y << 16), __uint_as_float(x.y & 0xffff0000u)};
                        b1 = (f32x4){__uint_as_float(x.z << 16), __uint_as_float(x.z & 0xffff0000u), __uint_as_float(x.w << 16), __uint_as_float(x.w & 0xffff0000u)}; }
                    else { b0 = *(const f32x4*)((const float*)base + off + bj * HALF); b1 = *(const f32x4*)((const float*)base + off + bj * HALF + 4); }
                    const f32x4 o0 = b0 + gv[bj][0] * acc[ai][bj][m][0], o1 = b1 + gv[bj][1] * acc[ai][bj][m][1];
                    if (BOUT) { u32x4 w; w.x = cvt_pk_bf16(o0[0], o0[1]); w.y = cvt_pk_bf16(o0[2], o0[3]); w.z = cvt_pk_bf16(o1[0], o1[1]); w.w = cvt_pk_bf16(o1[2], o1[3]); *(u32x4*)((bf16*)out + off + bj * HALF) = w; }
                    else { *(f32x4*)((float*)out + off + bj * HALF) = o0; *(f32x4*)((float*)out + off + bj * HALF + 4) = o1; }
                    ssq += (o0.x * o0.x + o0.y * o0.y) + (o0.z * o0.z + o0.w * o0.w) + (o1.x * o1.x + o1.y * o1.y) + (o1.z * o1.z + o1.w * o1.w); }
                if (rowss) { ssq += __shfl_xor(ssq, 16); ssq += __shfl_xor(ssq, 32); if (fq == 0) atomicAdd(rowss + row0 + ai * HALF + m * 16, ssq); } }
    }
};


struct EpiProj {
    static constexpr bool PERM = true;
    bf16* O; float* dtout; float* out; const float* qg; const float* kg; const float* dtb; LAS float* xch;
    __device__ __forceinline__ void operator()(const f32x4 (&acc)[2][2][4][2], const Unit& u, int wr, int wc, int fr, int fq) const {
        const int rt0 = wr * 64 + fr;
        const int row0 = u.pm * BM + rt0, colt = u.pn * BM, cw8 = wc * 32 + 8 * fq;
        const int b = u.pm >> 3, tb = (u.pm & 7) * BM;
        if (u.pn == 60) {
            if (wc == 0) { const f32x4 b0 = *(const f32x4*)(dtb + 8 * fq), b1 = *(const f32x4*)(dtb + 8 * fq + 4);
#pragma unroll
                for (int ai = 0; ai < 2; ++ai)
#pragma unroll
                    for (int m = 0; m < 4; ++m) { float* d = dtout + (size_t)(row0 + ai * HALF + m * 16) * 32 + 8 * fq; const f32x4 v0 = acc[ai][0][m][0] + b0, v1 = acc[ai][0][m][1] + b1;
                        *(f32x4*)d = (f32x4){softplusf(v0.x), softplusf(v0.y), softplusf(v0.z), softplusf(v0.w)}; *(f32x4*)(d + 4) = (f32x4){softplusf(v1.x), softplusf(v1.y), softplusf(v1.z), softplusf(v1.w)}; } }
            return;
        }
        const bool isq = u.pn >= 24 && u.pn < 36, isk = u.pn >= 36 && u.pn < 48, isv = u.pn >= 48, isx = u.pn >= 8 && u.pn < 24;
        float scl[2][4][2];
        f32x4 g0 = (f32x4){1.f, 1.f, 1.f, 1.f}, g1 = g0;
        if (isq || isk) {
#pragma unroll
            for (int ai = 0; ai < 2; ++ai)
#pragma unroll
                for (int m = 0; m < 4; ++m)
#pragma unroll
                    for (int bj = 0; bj < 2; ++bj) { const f32x4 a = acc[ai][bj][m][0], c2 = acc[ai][bj][m][1];
                        float ssq = (a.x * a.x + a.y * a.y) + (a.z * a.z + a.w * a.w) + (c2.x * c2.x + c2.y * c2.y) + (c2.z * c2.z + c2.w * c2.w);
                        ssq += __shfl_xor(ssq, 16); ssq += __shfl_xor(ssq, 32);
                        if (fq == 0) xch[((ai * HALF + rt0 + m * 16) * 2 + bj) * 4 + wc] = ssq; }
            asm volatile("s_waitcnt lgkmcnt(0)" ::: "memory"); __builtin_amdgcn_s_barrier(); asm volatile("" ::: "memory");
#pragma unroll
            for (int ai = 0; ai < 2; ++ai)
#pragma unroll
                for (int m = 0; m < 4; ++m)
#pragma unroll
                    for (int bj = 0; bj < 2; ++bj) { const f32x4 pz = *(const LAS f32x4*)(xch + ((ai * HALF + rt0 + m * 16) * 2 + bj) * 4);
                        scl[ai][m][bj] = rsqrtf(((pz.x + pz.y) + (pz.z + pz.w)) * (1.f / 128.f) + 1e-6f); }
            const float* gp = (isq ? qg : kg) + cw8; g0 = *(const f32x4*)gp; g1 = *(const f32x4*)(gp + 4);
        } else {
#pragma unroll
            for (int ai = 0; ai < 2; ++ai)
#pragma unroll
                for (int m = 0; m < 4; ++m) { scl[ai][m][0] = 1.f; scl[ai][m][1] = 1.f; }
        }
#pragma unroll
        for (int ai = 0; ai < 2; ++ai)
#pragma unroll
            for (int m = 0; m < 4; ++m) { const int rr = ai * HALF + m * 16; bf16* rowp = O + (size_t)(row0 + rr) * ldo() + colt + cw8; const int t = tb + rt0 + rr;
#pragma unroll
                for (int bj = 0; bj < 2; ++bj) { const f32x4 v0 = acc[ai][bj][m][0] * scl[ai][m][bj] * g0, v1 = acc[ai][bj][m][1] * scl[ai][m][bj] * g1;
                    u32x4 w; w.x = cvt_pk_bf16(v0[0], v0[1]); w.y = cvt_pk_bf16(v0[2], v0[3]); w.z = cvt_pk_bf16(v1[0], v1[1]); w.w = cvt_pk_bf16(v1[2], v1[3]);
                    *(u32x4*)(rowp + bj * HALF) = w;
                    if (isk || isv) { const int hd = (u.pn - (isk ? 36 : 48)) * 2 + bj, gi = hd >> 3, slot = hd & 7, W = gi == 0 ? 128 : (gi == 1 ? 512 : 2048);
                        if (t >= 2048 - W) { float* o = out + (gi == 0 ? O_PKV128 : (gi == 1 ? O_PKV512 : O_PKV2048)) + (((size_t)b * W + (t - (2048 - W))) * 2 + (isv ? 1 : 0)) * 1024 + slot * 128 + cw8;
                            *(f32x4*)o = v0; *(f32x4*)(o + 4) = v1; } }
                    if (isx && t >= 2045) { float* o = out + O_PCONV + ((size_t)b * 3 + (t - 2045)) * 4096 + (colt - 2048) + bj * HALF + cw8; *(f32x4*)o = v0; *(f32x4*)(o + 4) = v1; } } }
    }
    __device__ __forceinline__ static constexpr int ldo() { return 15616; }
};

struct NoHook { static constexpr int T = -1; __device__ __forceinline__ void operator()(f32x4 (&)[2][2][4][2], const Unit&, int, int) const {} };
struct RowScaleHook { static constexpr int T = 32; const float* ss;
    __device__ __forceinline__ void operator()(f32x4 (&acc)[2][2][4][2], const Unit& u, int wr, int fr) const {
#pragma unroll
        for (int ai = 0; ai < 2; ++ai)
#pragma unroll
            for (int m = 0; m < 4; ++m) { const float rs = rsqrtf(ss[u.pm * BM + ai * HALF + wr * 64 + m * 16 + fr] * (1.f / 2048.f) + 1e-6f);
#pragma unroll
                for (int bj = 0; bj < 2; ++bj)
#pragma unroll
                    for (int n = 0; n < 2; ++n) acc[ai][bj][m][n] = acc[ai][bj][m][n] * rs; } } };
template <class Epi, bool ALIGN_EPI = true, class Hook = NoHook>
__device__ __forceinline__ void gemm_phase(LAS unsigned char* lds, const Gemm g, const StaticOrder& S, const Epi& E, const Hook& H = Hook()) {
    const int tid = threadIdx.x, wid = __builtin_amdgcn_readfirstlane(tid >> 6), lane = tid & 63, wr = wid >> 2, wc = wid & 3, fr = lane & 15, fq = lane >> 4;
    const int K = g.K, nt = K / BK;
    unsigned voffA[2], voffB[2];
#pragma unroll
    for (int i = 0; i < 2; ++i) { int R, C; stage_rc(tid * 16 + i * 8192, R, C); const int Rb = Epi::PERM ? ((R & ~31) + perm32(R & 31)) : R;
        voffA[i] = (unsigned)(R * (g.akt ? 64 : g.lda) + C) * 2u; voffB[i] = (unsigned)(Rb * (g.bkt ? 64 : g.ldb) + C) * 2u; }
    const size_t kstepA = g.akt ? (size_t)32768 : (size_t)(BK * 2), kstepB = g.bkt ? (size_t)32768 : (size_t)(BK * 2);
    const size_t hstepA = (size_t)HALF * (g.akt ? 64 : g.lda) * 2, hstepB = (size_t)HALF * (g.bkt ? 64 : g.ldb) * 2;
    const size_t tstepA = g.akt ? (size_t)g.akt * 32768 : 2 * hstepA, tstepB = g.bkt ? (size_t)g.bkt * 32768 : 2 * hstepB;
    const unsigned ldsw = (unsigned)wid * 1024u;
    const int aoff = lds_byte(wr * 64 + fr, fq * 8), boff = lds_byte(wc * 32 + fr, fq * 8);
#define PG8_SA(b, h) (((b) * 2 + (h)) * HTB)
#define PG8_SB(b, h) ((4 + (b) * 2 + (h)) * HTB)
#define PG8_STAGE(bufoff, gbase, voff) do { _Pragma("unroll") for (int _i = 0; _i < 2; ++_i) \
        __builtin_amdgcn_global_load_lds((const unsigned*)((const char*)(gbase) + (voff)[_i]), (LAS unsigned*)(lds + (bufoff) + ldsw + _i * 8192), 16, 0, 0); } while (0)
#define PG8_LDA(dst, b, h) do { _Pragma("unroll") for (int m = 0; m < 4; ++m) _Pragma("unroll") for (int k = 0; k < 2; ++k) dst[m][k] = *(const LAS bf16x8*)(lds + PG8_SA(b, h) + aoff + m * 2048 + k * 1024); } while (0)
#define PG8_LDB(dst, b, h) do { _Pragma("unroll") for (int n = 0; n < 2; ++n) _Pragma("unroll") for (int k = 0; k < 2; ++k) dst[n][k] = *(const LAS bf16x8*)(lds + PG8_SB(b, h) + boff + n * 2048 + k * 1024); } while (0)
#define PG8_MMA(ai, bj, At, Bt) do { __builtin_amdgcn_s_setprio(1); _Pragma("unroll") for (int m = 0; m < 4; ++m) _Pragma("unroll") for (int n = 0; n < 2; ++n) _Pragma("unroll") for (int k = 0; k < 2; ++k) \
        acc[ai][bj][m][n] = __builtin_amdgcn_mfma_f32_16x16x32_bf16(Bt[n][k], At[m][k], acc[ai][bj][m][n], 0, 0, 0); __builtin_amdgcn_s_setprio(0); } while (0)
#define PG8_WAIT_V(n) asm volatile("s_waitcnt vmcnt(" #n ")" ::: "memory")
#define PG8_WAIT_L(n) asm volatile("s_waitcnt lgkmcnt(" #n ")" ::: "memory")
#define PG8_BAR __builtin_amdgcn_s_barrier()
#define PG8_SCHED __builtin_amdgcn_sched_barrier(0)
    Unit cur, nxt; int ui = 0;
    if (!S.next(0, cur)) return;
    f32x4 acc[2][2][4][2];
#pragma unroll
    for (int a = 0; a < 2; ++a)
#pragma unroll
        for (int b = 0; b < 2; ++b)
#pragma unroll
            for (int m = 0; m < 4; ++m)
#pragma unroll
                for (int n = 0; n < 2; ++n) acc[a][b][m][n] = (f32x4){0.f, 0.f, 0.f, 0.f};
    bf16x8 At[4][2], B0[2][2], B1[2][2];
    const char* cA = (const char*)g.A + (size_t)cur.pm * tstepA + (size_t)(cur.pn / g.agrp) * (K / BK) * kstepA; const char* cB = (const char*)g.Bt + (size_t)cur.pn * tstepB;
    PG8_STAGE(PG8_SB(0, 0), cB, voffB); PG8_STAGE(PG8_SB(0, 1), cB + hstepB, voffB); PG8_STAGE(PG8_SA(0, 0), cA, voffA); PG8_STAGE(PG8_SA(0, 1), cA + hstepA, voffA);
    if (wr == 1) PG8_BAR;
    PG8_WAIT_V(2); PG8_BAR;
    PG8_STAGE(PG8_SB(1, 0), cB + kstepB, voffB); PG8_STAGE(PG8_SA(1, 0), cA + kstepA, voffA); PG8_STAGE(PG8_SB(1, 1), cB + hstepB + kstepB, voffB);
    PG8_WAIT_V(6); PG8_BAR;
    for (;;) {
        const bool has_next = S.next(ui + 1, nxt);
        const char* nA = has_next ? (const char*)g.A + (size_t)nxt.pm * tstepA + (size_t)(nxt.pn / g.agrp) * (K / BK) * kstepA : cA; const char* nB = has_next ? (const char*)g.Bt + (size_t)nxt.pn * tstepB : cB;
        for (int t = 0; t < nt; t += 2) {
            const bool last = (t == nt - 2);
            if constexpr (Hook::T >= 0) { if (t == Hook::T) H(acc, cur, wr, fr); }
            const char* a1 = cA + (size_t)(t + 1) * kstepA;
            const char* a2 = last ? nA : cA + (size_t)(t + 2) * kstepA; const char* b2 = last ? nB : cB + (size_t)(t + 2) * kstepB;
            const char* a3 = a2 + kstepA; const char* b3 = b2 + kstepB;
            PG8_LDB(B0, 0, 0); PG8_LDB(B1, 0, 1); PG8_SCHED; PG8_LDA(At, 0, 0); PG8_STAGE(PG8_SA(1, 1), a1 + hstepA, voffA);
            PG8_WAIT_V(8); PG8_WAIT_L(0); PG8_BAR; PG8_MMA(0, 0, At, B0); PG8_MMA(0, 1, At, B1); PG8_BAR; PG8_SCHED;
            PG8_LDA(At, 0, 1); PG8_STAGE(PG8_SB(0, 0), b2, voffB); PG8_STAGE(PG8_SB(0, 1), b2 + hstepB, voffB); PG8_STAGE(PG8_SA(0, 0), a2, voffA);
            PG8_WAIT_V(8); PG8_WAIT_L(0); PG8_BAR; PG8_MMA(1, 0, At, B0); PG8_MMA(1, 1, At, B1); PG8_BAR; PG8_SCHED;
            PG8_LDB(B0, 1, 0); PG8_LDB(B1, 1, 1); PG8_SCHED; PG8_LDA(At, 1, 0); PG8_STAGE(PG8_SA(0, 1), a2 + hstepA, voffA);
            PG8_WAIT_V(8); PG8_WAIT_L(0); PG8_BAR; PG8_MMA(0, 0, At, B0); PG8_MMA(0, 1, At, B1); PG8_BAR; PG8_SCHED;
            PG8_LDA(At, 1, 1); PG8_STAGE(PG8_SB(1, 0), b3, voffB); PG8_STAGE(PG8_SB(1, 1), b3 + hstepB, voffB); PG8_STAGE(PG8_SA(1, 0), a3, voffA);
            PG8_WAIT_V(8); PG8_WAIT_L(0); PG8_BAR; PG8_MMA(1, 0, At, B0); PG8_MMA(1, 1, At, B1); PG8_BAR; PG8_SCHED;
        }
        if constexpr (ALIGN_EPI) { if (wr == 0) PG8_BAR; }
        E(acc, cur, wr, wc, fr, fq);
        if (!has_next) break;
#pragma unroll
        for (int a = 0; a < 2; ++a)
#pragma unroll
            for (int b = 0; b < 2; ++b)
#pragma unroll
                for (int m = 0; m < 4; ++m)
#pragma unroll
                    for (int n = 0; n < 2; ++n) acc[a][b][m][n] = (f32x4){0.f, 0.f, 0.f, 0.f};
        cur = nxt; cA = nA; cB = nB; ++ui;
        if constexpr (ALIGN_EPI) { if (wr == 1) PG8_BAR; }
    }
    PG8_WAIT_V(0);
    if constexpr (!ALIGN_EPI) { if (wr == 0) PG8_BAR; }
    PG8_BAR;
#undef PG8_SA
#undef PG8_SB
#undef PG8_STAGE
#undef PG8_LDA
#undef PG8_LDB
#undef PG8_MMA
#undef PG8_WAIT_V
#undef PG8_WAIT_L
#undef PG8_BAR
#undef PG8_SCHED
}
}


#define XB_TMO      128
#define XB_XCNT(j)  (256  + 64 * (j))
#define XB_XSUB(j)  (1280 + 64 * (j))
#define XB_XGEN(j)  (2304 + 64 * (j))
#define XB_TOP      3328
#define XB_TOPGEN   3392
#define XCD_BAR_WORDS 3456
#define XB_SPIN_CAP (1u << 18)
__device__ __forceinline__ unsigned xb_ld(unsigned* p)              { return __hip_atomic_load(p, __ATOMIC_RELAXED, __HIP_MEMORY_SCOPE_AGENT); }
__device__ __forceinline__ unsigned xb_add(unsigned* p, unsigned v) { return __hip_atomic_fetch_add(p, v, __ATOMIC_RELAXED, __HIP_MEMORY_SCOPE_AGENT); }
__device__ __forceinline__ unsigned xb_xcc_id() { return (unsigned)__builtin_amdgcn_s_getreg((3 << 11) | 20) & 0xFu; }
#define XB_SPIN(cond, bar) do { unsigned _sp = 0; while (cond) { __builtin_amdgcn_s_sleep(1); \
    if ((++_sp & 255u) == 0u) { if (xb_ld(&(bar)[XB_TMO])) break; if (_sp > XB_SPIN_CAP) { atomicAdd(&(bar)[XB_TMO], 1u); break; } } } } while (0)
struct XcdBarrier { unsigned* bar; unsigned x; volatile LAS unsigned* st; };
__device__ __forceinline__ XcdBarrier xcd_barrier_post(unsigned* bar, volatile LAS unsigned* st) {
    XcdBarrier b; b.bar = bar; b.x = xb_xcc_id(); b.st = st;
    if (threadIdx.x == 0) (void)xb_add(&bar[XB_XCNT(b.x)], 1u);
    return b;
}
__device__ __forceinline__ void xcd_barrier_complete(unsigned* bar, unsigned x, unsigned& nloc, unsigned& nx) {
    const unsigned G = gridDim.x * gridDim.y * gridDim.z;
    unsigned sum, cnt, mine, sp = 0u;
    for (;;) {
        sum = 0u; cnt = 0u; mine = 0u;
#pragma unroll
        for (unsigned j = 0; j < 16; ++j) { const unsigned c = xb_ld(&bar[XB_XCNT(j)]); sum += c; cnt += (c > 0u) ? 1u : 0u; mine = (j == x) ? c : mine; }
        if (sum == G) break;
        __builtin_amdgcn_s_sleep(1);
        if ((++sp & 255u) == 0u) { if (xb_ld(&bar[XB_TMO])) break; if (sp > XB_SPIN_CAP) { atomicAdd(&bar[XB_TMO], 1u); break; } }
    }
    nloc = mine > 0u ? mine : 1u; nx = cnt > 0u ? cnt : 1u;
}
__device__ __forceinline__ void xcd_barrier(const XcdBarrier& b) {
    asm volatile("s_waitcnt vmcnt(0)" ::: "memory");
    __syncthreads();
    if (threadIdx.x == 0) {
        unsigned* bar = b.bar;
        __builtin_amdgcn_s_waitcnt(0);
        unsigned nloc = b.st[0], nx = b.st[1];
        if (nloc == 0u) { xcd_barrier_complete(bar, b.x, nloc, nx); b.st[0] = nloc; b.st[1] = nx; }
        const unsigned old = xb_add(&bar[XB_XSUB(b.x)], 1u);
        const unsigned gen = old / nloc;
        if (old + 1u == (gen + 1u) * nloc) {
            __builtin_amdgcn_fence(__ATOMIC_RELEASE, "agent");
            asm volatile("s_waitcnt vmcnt(0)" ::: "memory");
            const unsigned og = xb_add(&bar[XB_TOP], 1u);
            const unsigned tg = og / nx;
            if (og + 1u == (tg + 1u) * nx) xb_add(&bar[XB_TOPGEN], 1u);
            else XB_SPIN(xb_ld(&bar[XB_TOPGEN]) == tg, bar);
            __builtin_amdgcn_fence(__ATOMIC_ACQUIRE, "agent");
            xb_add(&bar[XB_XGEN(b.x)], 1u);
            asm volatile("s_waitcnt vmcnt(0)" ::: "memory");
        } else {
            XB_SPIN(xb_ld(&bar[XB_XGEN(b.x)]) == gen, bar);
            __builtin_amdgcn_fence(__ATOMIC_ACQUIRE, "agent");
            asm volatile("s_waitcnt vmcnt(0)" ::: "memory");
        }
    }
    __syncthreads();
}

struct Ctx { int tid, lane, wave, gw, ngw; LAS unsigned char* lds; unsigned char* ws; };

template <class LA, class F> __device__ __forceinline__ void skinny(const Ctx& c, LA&& aload, const bf16* WT, int ldb, int K, int N, int KS, F&& epi, int bkt = 0) {
    const int lane = c.lane, ncg = N / 16, kl = K / KS;
    for (int it = c.gw; it < ncg * KS; it += c.ngw) {
        const int cg = it % ncg, kb = (it / ncg) * kl;
        f32x4 acc = (f32x4){0.f, 0.f, 0.f, 0.f};
        const int nn = cg * 16 + (lane & 15);
        const bf16* bp = bkt ? WT + ((size_t)(nn >> 8) * bkt + (kb >> 6)) * 16384 + (nn & 255) * 64 + 8 * (lane >> 4) : WT + (size_t)nn * ldb + kb + 8 * (lane >> 4);
#pragma unroll 8
        for (int k0 = 0; k0 < kl; k0 += 32) { const bf16x8 av = aload(lane & 7, kb + k0 + 8 * (lane >> 4)), bv = *(const bf16x8*)(bp + (bkt ? (k0 >> 6) * 16384 + (k0 & 63) : k0)); acc = __builtin_amdgcn_mfma_f32_16x16x32_bf16(av, bv, acc, 0, 0, 0); }
        if ((lane >> 4) < 2) {
#pragma unroll
            for (int j = 0; j < 4; ++j) epi((lane >> 4) * 4 + j, cg * 16 + (lane & 15), acc[j]);
        }
    }
}
__device__ __forceinline__ bf16x8 relu2_bf16x8(const float* q) { const f32x4 a = *(const f32x4*)q, b = *(const f32x4*)(q + 4);
    u32x4 w; float t0, t1;
    t0 = fmaxf(a.x, 0.f); t1 = fmaxf(a.y, 0.f); w.x = pk2(t0 * t0, t1 * t1); t0 = fmaxf(a.z, 0.f); t1 = fmaxf(a.w, 0.f); w.y = pk2(t0 * t0, t1 * t1);
    t0 = fmaxf(b.x, 0.f); t1 = fmaxf(b.y, 0.f); w.z = pk2(t0 * t0, t1 * t1); t0 = fmaxf(b.z, 0.f); t1 = fmaxf(b.w, 0.f); w.w = pk2(t0 * t0, t1 * t1);
    return __builtin_bit_cast(bf16x8, w); }

__device__ __forceinline__ void load_row(const float* row, f32x4 (&v)[8], int lane) {
#pragma unroll
    for (int j = 0; j < 8; ++j) v[j] = ((const f32x4*)row)[lane + 64 * j];
}
__device__ __forceinline__ void load_row_bf16(const bf16* row, f32x4 (&v)[8], int lane) {
#pragma unroll
    for (int j = 0; j < 8; ++j) { const u32x2 x = ((const u32x2*)row)[lane + 64 * j]; v[j] = (f32x4){__uint_as_float(x.x << 16), __uint_as_float(x.x & 0xffff0000u), __uint_as_float(x.y << 16), __uint_as_float(x.y & 0xffff0000u)}; }
}
__device__ __forceinline__ float row_rs(const f32x4 (&v)[8]) {
    float s = 0.f;
#pragma unroll
    for (int j = 0; j < 8; ++j) s += (v[j].x * v[j].x + v[j].y * v[j].y) + (v[j].z * v[j].z + v[j].w * v[j].w);
    return rsqrtf(wave_sum(s) * (1.f / D) + EPS);
}
__device__ __forceinline__ void normmod(f32x4 (&v)[8], const float* g, const float* sc, const float* sh, int lane) {
    const float rs = row_rs(v);
#pragma unroll
    for (int j = 0; j < 8; ++j) { const int c = 4 * (lane + 64 * j); const f32x4 gg = *(const f32x4*)(g + c), s1 = *(const f32x4*)(sc + c), s0 = *(const f32x4*)(sh + c);
        v[j] = v[j] * rs * gg * (s1 + 1.f) + s0; }
}
__device__ __forceinline__ void store_row_bf16(bf16* row, const f32x4 (&v)[8], int lane) {
#pragma unroll
    for (int j = 0; j < 8; ++j) { u32x2 w; w.x = pk2(v[j].x, v[j].y); w.y = pk2(v[j].z, v[j].w); ((u32x2*)row)[lane + 64 * j] = w; }
}
__device__ __forceinline__ void store_row_bf16_tiled(bf16* base, int m, const f32x4 (&v)[8], int lane) {
#pragma unroll
    for (int j = 0; j < 8; ++j) { const int col = 4 * (lane + 64 * j); u32x2 w; w.x = pk2(v[j].x, v[j].y); w.y = pk2(v[j].z, v[j].w);
        *(u32x2*)(base + ((size_t)(m >> 8) * 32 + (col >> 6)) * 16384 + (m & 255) * 64 + (col & 63)) = w; }
}
__device__ __forceinline__ void store_row_f32(float* row, const f32x4 (&v)[8], int lane) {
#pragma unroll
    for (int j = 0; j < 8; ++j) ((f32x4*)row)[lane + 64 * j] = v[j];
}

__device__ __forceinline__ const float* modp(const unsigned char* ws, int layer, int r, int chunk) { return (const float*)(ws + WS_MOD) + ((size_t)(layer * 12 + r) * 6 + chunk) * D; }

struct TDesc { const float* W; bf16* WT; const float* ks; int N, ldt, row0, k0, n0, tkt; };
__device__ __forceinline__ TDesc tdecode(CP& p, const Ctx& c, int it) {
    constexpr int I_IN = (D / 64) * (INC / 32), I_OUT = (MIXK / 64) * (D / 32), I_1 = (D / 64) * (DFF / 32), I_2 = (DFF / 64) * (D / 32), I_P = (512 / 64) * (512 / 32);
    TDesc d; d.ks = nullptr; d.tkt = 0; d.row0 = 0; int r = it;
    if (r < I_IN) { const int nb = INC / 32, n0 = (r % nb) * 32; const int nd = n0 < 6144 ? n0 : (n0 < 6176 ? CDT + (n0 - 6144) : n0 - 32);
        d.W = p.in[I_INW]; d.N = INC; d.WT = (bf16*)(c.ws + WS_WIN); d.ldt = D; d.row0 = nd - n0; d.k0 = (r / nb) * 64; d.n0 = n0; d.tkt = D / 64; return d; } r -= I_IN;
    if (r < I_OUT) { const int nb = D / 32; d.W = p.in[I_OUTW]; d.N = D; d.WT = (bf16*)(c.ws + WS_WOUT); d.ldt = MIXK; d.k0 = (r / nb) * 64; d.n0 = (r % nb) * 32; if (d.k0 < INNER) d.ks = p.in[I_SSDG]; return d; } r -= I_OUT;
    if (r < 2 * I_1) { const int l = r / I_1, q = r % I_1, nb = DFF / 32; d.W = p.in[I_W1] + (size_t)l * D * DFF; d.N = DFF; d.WT = (bf16*)(c.ws + WS_W1) + (size_t)l * DFF * D; d.ldt = D; d.k0 = (q / nb) * 64; d.n0 = (q % nb) * 32; d.tkt = D / 64; return d; } r -= 2 * I_1;
    if (r < 2 * I_2) { const int l = r / I_2, q = r % I_2, nb = D / 32; d.W = p.in[I_W2] + (size_t)l * DFF * D; d.N = D; d.WT = (bf16*)(c.ws + WS_W2) + (size_t)l * D * DFF; d.ldt = DFF; d.k0 = (q / nb) * 64; d.n0 = (q % nb) * 32; d.tkt = DFF / 64; return d; } r -= 2 * I_2;
    { const int gq = r / I_P, q = r % I_P, nb = 512 / 32; d.W = p.in[I_POOLW] + (size_t)gq * 512 * 512; d.N = 512; d.WT = (bf16*)(c.ws + WS_WPOOL) + (size_t)gq * 512 * 512; d.ldt = 512; d.k0 = (q / nb) * 64; d.n0 = (q % nb) * 32; return d; }
}
__device__ __forceinline__ void tload(const TDesc& d, int lane, float (&v)[32]) {
    const float* wp = d.W + (size_t)(d.k0 + (lane >> 5)) * d.N + d.n0 + (lane & 31);
#pragma unroll
    for (int i = 0; i < 32; ++i) v[i] = __builtin_nontemporal_load(wp + (size_t)(2 * i) * d.N);
}
__device__ __forceinline__ void tstore(const TDesc& d, LAS float* scr, int lane, const float (&v)[32]) {
#pragma unroll
    for (int i = 0; i < 32; ++i) { const int kk = 2 * i + (lane >> 5); float wv = v[i]; if (d.ks) wv *= d.ks[d.k0 + kk]; scr[kk * 33 + (lane & 31)] = wv; }
    LDS_WAIT();
    const int cc = lane & 7;
#pragma unroll
    for (int j = 0; j < 4; ++j) { const int n = (lane >> 3) + 8 * j; const LAS float* s = scr + (8 * cc) * 33 + n;
        u32x4 o; o.x = pk2(s[0 * 33], s[1 * 33]); o.y = pk2(s[2 * 33], s[3 * 33]); o.z = pk2(s[4 * 33], s[5 * 33]); o.w = pk2(s[6 * 33], s[7 * 33]);
        const int nn = d.row0 + d.n0 + n;
        *(u32x4*)(d.tkt ? d.WT + ((size_t)(nn >> 8) * d.tkt + (d.k0 >> 6)) * 16384 + (nn & 255) * 64 + 8 * cc : d.WT + (size_t)nn * d.ldt + d.k0 + 8 * cc) = o; }
    LDS_WAIT();
}

__device__ __forceinline__ void ph_prologue(CP& p, const Ctx& c) {
    const int lane = c.lane, wave = c.wave, tid = c.tid;
    const float* const cpp_ = p.in[I_CP]; const float* const csp_ = p.in[I_CS];
    __syncthreads();
    for (int it = blockIdx.x; it < 768; it += gridDim.x) {
        const int kq = it & 7, cgp = (it >> 3) % 48, layer = it / 384, n0 = cgp * 256, kb = kq * 256 + wave * 32;
        LAS float* cs = (LAS float*)c.lds + wave * (12 * 32);
        for (int i = lane; i < 12 * 32; i += 64) { const int r = i >> 5, k = kb + (i & 31); const float cv = r < 4 ? cpp_[r * D + k] : csp_[(r - 4) * D + k]; cs[i] = siluf(cv); }
        LDS_WAIT();
        f32x4 acc[12];
#pragma unroll
        for (int r = 0; r < 12; ++r) acc[r] = (f32x4){0.f, 0.f, 0.f, 0.f};
        const float* W = p.in[I_ADAW] + (size_t)layer * D * MODW + (size_t)kb * MODW + n0 + lane * 4;
#pragma unroll
        for (int h = 0; h < 2; ++h) { f32x4 w[16];
#pragma unroll
            for (int kk = 0; kk < 16; ++kk) w[kk] = __builtin_nontemporal_load((const f32x4*)(W + (size_t)(16 * h + kk) * MODW));
#pragma unroll
            for (int kk = 0; kk < 16; ++kk)
#pragma unroll
                for (int r = 0; r < 12; ++r) acc[r] += w[kk] * cs[r * 32 + 16 * h + kk]; }
        __syncthreads();
        LAS f32x4* red = (LAS f32x4*)(c.lds + 16384);
#pragma unroll
        for (int r = 0; r < 12; ++r) red[(wave * 12 + r) * 64 + lane] = acc[r];
        __syncthreads();
        for (int o = tid; o < 12 * 256; o += NT) { const int r = o >> 8, cc = o & 255; float sacc = kq == 0 ? p.in[I_ADAB][layer * MODW + n0 + cc] : 0.f;
#pragma unroll
            for (int w = 0; w < 8; ++w) sacc += ((LAS float*)(c.lds + 16384))[(w * 12 + r) * 256 + cc];
            atomicAdd((float*)(c.ws + WS_MOD) + (size_t)(layer * 12 + r) * MODW + n0 + cc, sacc); }
        __syncthreads();
    }
    {
        LAS float* scr = (LAS float*)(c.lds + wave * 16384);
        constexpr int NITEMS = (D / 64) * (INC / 32) + (MIXK / 64) * (D / 32) + 2 * (D / 64) * (DFF / 32) + 2 * (DFF / 64) * (D / 32) + 4 * (512 / 64) * (512 / 32);
        int it = c.gw;
        if (it < NITEMS) {
            TDesc d = tdecode(p, c, it); float v[32]; tload(d, lane, v);
#pragma clang loop unroll(disable)
            for (;;) { const int itn = it + c.ngw; TDesc dn = d; float vn[32];
                if (itn < NITEMS) { dn = tdecode(p, c, itn); tload(dn, lane, vn); }
                tstore(d, scr, lane, v);
                if (itn >= NITEMS) break;
                d = dn; it = itn;
#pragma unroll
                for (int i = 0; i < 32; ++i) v[i] = vn[i]; }
        }
    }
    { const int gt = blockIdx.x * NT + tid, gn = gridDim.x * NT;
      f32x4* z0 = (f32x4*)(c.ws + WS_SMP + SM_PROJ); for (int i = gt; i < SB * INP / 4; i += gn) z0[i] = (f32x4){0.f, 0.f, 0.f, 0.f};
      f32x4* z1 = (f32x4*)(c.ws + WS_SMP + SM_H0); for (int i = gt; i < 2 * SB * DFF / 4; i += gn) z1[i] = (f32x4){0.f, 0.f, 0.f, 0.f};
      f32x4* z2 = (f32x4*)(c.ws + WS_RS); for (int i = gt; i < 4 * MP / 4; i += gn) z2[i] = (f32x4){0.f, 0.f, 0.f, 0.f}; }
    { bf16* wt = (bf16*)(c.ws + WS_WIN) + (size_t)60 * 32 * 16384;
      for (int i = blockIdx.x * NT + tid; i < 32 * 224 * 8; i += gridDim.x * NT) { const int kt = i / (224 * 8), rem = i % (224 * 8), row = 32 + rem / 8, cc = rem % 8; *(u32x4*)(wt + (size_t)kt * 16384 + row * 64 + cc * 8) = (u32x4){0u, 0u, 0u, 0u}; } }
}

template <bool XBF> __device__ __forceinline__ void ph_normmod(CP& p, const Ctx& c, const void* xp, const float* xs, const float* g, int layer, int csh, int csc, float* xs_copy) {
    for (int m = c.gw; m < MP + SB; m += c.ngw) {
        f32x4 v[8];
        if (m < MP) { if (XBF) load_row_bf16((const bf16*)xp + (size_t)m * D, v, c.lane); else load_row((const float*)xp + (size_t)m * D, v, c.lane); normmod(v, g, modp(c.ws, layer, m >> 11, csc), modp(c.ws, layer, m >> 11, csh), c.lane); store_row_bf16_tiled((bf16*)(c.ws + WS_A0), m, v, c.lane); }
        else { const int r = m - MP; load_row(xs + (size_t)r * D, v, c.lane); store_row_f32(xs_copy + (size_t)r * D, v, c.lane); normmod(v, g, modp(c.ws, layer, 4 + r, csc), modp(c.ws, layer, 4 + r, csh), c.lane); store_row_bf16((bf16*)(c.ws + WS_SMP + SM_USBF) + (size_t)r * D, v, c.lane); }
    }
}

__device__ __forceinline__ int kvlen(int gi) { return gi == 0 ? 128 : (gi == 1 ? 512 : 2048); }
__device__ __forceinline__ size_t pkv_off(int gi) { return gi == 0 ? O_PKV128 : (gi == 1 ? O_PKV512 : O_PKV2048); }
__device__ __forceinline__ size_t skv_off(int gi) { return gi == 0 ? O_SKV128 : (gi == 1 ? O_SKV512 : O_SKV2048); }

__device__ __forceinline__ void ph_sample_postproj(CP& p, const Ctx& c) {
    const int lane = c.lane;
    const float* cw = p.in[I_CONVW]; const float* cb = p.in[I_CONVB]; const float* const qgp = p.in[I_QG]; const float* const kgp = p.in[I_KG];
    const float* sproj = (const float*)(c.ws + WS_SMP + SM_PROJ);
    for (int it = c.gw; it < 64 + 384 + 192; it += c.ngw) {
        if (it < 64) { const int b = it >> 3, ch = (it & 7) * 512 + lane * 8; const float* prow = sproj + (size_t)b * INP;
            const float* st = p.in[I_CONV] + (size_t)b * 3 * CONVD + ch;
            f32x4 o0 = *(const f32x4*)(cb + ch), o1 = *(const f32x4*)(cb + ch + 4);
            const f32x4 s00 = *(const f32x4*)(st), s01 = *(const f32x4*)(st + 4), s10 = *(const f32x4*)(st + CONVD), s11 = *(const f32x4*)(st + CONVD + 4), s20 = *(const f32x4*)(st + 2 * CONVD), s21 = *(const f32x4*)(st + 2 * CONVD + 4);
            const f32x4 x0 = *(const f32x4*)(prow + CX + ch), x1 = *(const f32x4*)(prow + CX + ch + 4);
            o0 += *(const f32x4*)(cw + ch) * s00 + *(const f32x4*)(cw + CONVD + ch) * s10 + *(const f32x4*)(cw + 2 * CONVD + ch) * s20 + *(const f32x4*)(cw + 3 * CONVD + ch) * x0;
            o1 += *(const f32x4*)(cw + ch + 4) * s01 + *(const f32x4*)(cw + CONVD + ch + 4) * s11 + *(const f32x4*)(cw + 2 * CONVD + ch + 4) * s21 + *(const f32x4*)(cw + 3 * CONVD + ch + 4) * x1;
            float* xo = (float*)(c.ws + WS_SMP + SM_XC) + (size_t)b * CONVD + ch;
            *(f32x4*)xo = (f32x4){siluf(o0.x), siluf(o0.y), siluf(o0.z), siluf(o0.w)}; *(f32x4*)(xo + 4) = (f32x4){siluf(o1.x), siluf(o1.y), siluf(o1.z), siluf(o1.w)};
            float* sc = p.out + O_SCONV + (size_t)b * 3 * CONVD + ch;
            *(f32x4*)sc = s10; *(f32x4*)(sc + 4) = s11; *(f32x4*)(sc + CONVD) = s20; *(f32x4*)(sc + CONVD + 4) = s21; *(f32x4*)(sc + 2 * CONVD) = x0; *(f32x4*)(sc + 2 * CONVD + 4) = x1;
            if ((it & 7) == 0 && lane < NH) ((float*)(c.ws + WS_SMP + SM_DT))[b * NH + lane] = softplusf(prow[CDT + lane] + p.in[I_DTB][lane]);
        } else if (it < 64 + 384) { const int q = it - 64, b = q / 48, hh = q % 48; const float* prow = sproj + (size_t)b * INP;
            float* qk = (float*)(c.ws + WS_SMP + SM_QK) + (size_t)b * 6144;
            const float x0 = prow[CQ + hh * HD + lane], x1 = prow[CQ + hh * HD + 64 + lane];
            const float rs = rsqrtf(wave_sum(x0 * x0 + x1 * x1) * (1.f / HD) + EPS); const float* gg = hh < AH ? qgp : kgp;
            const float y0 = x0 * rs * gg[lane], y1 = x1 * rs * gg[64 + lane];
            qk[hh * HD + lane] = y0; qk[hh * HD + 64 + lane] = y1;
            if (hh >= AH) { const int kh = hh - AH, gi = kh >> 3, slot = kh & 7, W = kvlen(gi);
                float* o = p.out + skv_off(gi) + (((size_t)b * W + (W - 1)) * 2 + 0) * 1024 + slot * HD; o[lane] = y0; o[64 + lane] = y1; }
        } else { const int q = it - 448, b = q / AH, vh = q % AH, gi = vh >> 3, slot = vh & 7, W = kvlen(gi); const float* prow = sproj + (size_t)b * INP;
            float* o = p.out + skv_off(gi) + (((size_t)b * W + (W - 1)) * 2 + 1) * 1024 + slot * HD; o[lane] = prow[CV + vh * HD + lane]; o[64 + lane] = prow[CV + vh * HD + 64 + lane]; }
    }
}
__device__ __forceinline__ void ph_kvcopy(CP& p, const Ctx& c, int rp0, int rp1, int w0, int nw) {
    constexpr int R0 = 8 * 127, R1 = 8 * 511, R2 = 8 * 2047, TOTR = R0 + R1 + R2;
    const int lane = c.lane;
    const float* const kc0 = p.in[I_KV128]; const float* const kc1 = p.in[I_KV512]; const float* const kc2 = p.in[I_KV2048];
#pragma clang loop unroll(disable)
    for (int rp = rp0 + w0; rp < rp1; rp += nw) {
        const u32x4* src[2]; u32x4* dst[2];
#pragma unroll
        for (int h = 0; h < 2; ++h) { int q = 2 * rp + h; const float* cb; size_t ob; int W;
            if (q < R0) { cb = kc0; ob = O_SKV128; W = 128; } else if (q < R0 + R1) { q -= R0; cb = kc1; ob = O_SKV512; W = 512; } else { q -= R0 + R1; cb = kc2; ob = O_SKV2048; W = 2048; }
            const int b = q / (W - 1), r = q - b * (W - 1); const size_t base = ((size_t)b * W + r) * 512;
            src[h] = (const u32x4*)cb + base + 512 + lane; dst[h] = (u32x4*)(p.out + ob) + base + lane; }
        u32x4 v[2][8];
#pragma unroll
        for (int h = 0; h < 2; ++h)
#pragma unroll
            for (int j = 0; j < 8; ++j) v[h][j] = __builtin_nontemporal_load(src[h] + 64 * j);
#pragma unroll
        for (int h = 0; h < 2; ++h)
#pragma unroll
            for (int j = 0; j < 8; ++j) __builtin_nontemporal_store(v[h][j], dst[h] + 64 * j);
    }
}

__device__ __forceinline__ int rel_bucket(int dist) {
    if (dist < 16) return dist;
    int l = 16 + (int)(logf((float)dist * (1.f / 16.f)) / 4.852030263919617f * 16.f);
    return l < 31 ? l : 31;
}

typedef short s16x4 __attribute__((ext_vector_type(4)));
__device__ __forceinline__ s16x4 tr_read(const LAS unsigned char* p) { return __builtin_bit_cast(s16x4, __builtin_amdgcn_ds_read_tr16_b64_v4i16((LAS s16x4*)p)); }
__device__ __forceinline__ bf16x8 cat4(s16x4 a, s16x4 b) { return (bf16x8){a[0], a[1], a[2], a[3], b[0], b[1], b[2], b[3]}; }
__device__ __forceinline__ bf16x8 pack8(f32x4 a, f32x4 b) { u32x4 w; w.x = pk2(a[0], a[1]); w.y = pk2(a[2], a[3]); w.z = pk2(b[0], b[1]); w.w = pk2(b[2], b[3]); return __builtin_bit_cast(bf16x8, w); }
#define MFMA16(a, b, c) __builtin_amdgcn_mfma_f32_16x16x32_bf16((a), (b), (c), 0, 0, 0)


struct ConvW { f32x4 w[4][2]; f32x4 b[2]; };
__device__ __forceinline__ void conv_load_w(ConvW& cwv, const float* cw, const float* cb, int ch) {
#pragma unroll
    for (int k = 0; k < 4; ++k) { cwv.w[k][0] = *(const f32x4*)(cw + k * CONVD + ch); cwv.w[k][1] = *(const f32x4*)(cw + k * CONVD + ch + 4); }
    cwv.b[0] = *(const f32x4*)(cb + ch); cwv.b[1] = *(const f32x4*)(cb + ch + 4);
}
__device__ __forceinline__ void conv8(const bf16* prow, int t, int ch, const ConvW& cwv, f32x4& o0, f32x4& o1) {
    o0 = cwv.b[0]; o1 = cwv.b[1];
#pragma unroll
    for (int k = 0; k < 4; ++k) { if (t + k - 3 >= 0) { const u32x4 xv = *(const u32x4*)(prow + (ptrdiff_t)(k - 3) * INP + CX + ch);
            o0 += cwv.w[k][0] * (f32x4){bf2f(xv.x & 0xffffu), bf2f(xv.x >> 16), bf2f(xv.y & 0xffffu), bf2f(xv.y >> 16)};
            o1 += cwv.w[k][1] * (f32x4){bf2f(xv.z & 0xffffu), bf2f(xv.z >> 16), bf2f(xv.w & 0xffffu), bf2f(xv.w >> 16)}; } }
    o0 = (f32x4){siluf(o0.x), siluf(o0.y), siluf(o0.z), siluf(o0.w)}; o1 = (f32x4){siluf(o1.x), siluf(o1.y), siluf(o1.z), siluf(o1.w)};
}

template <int R> __device__ __forceinline__ void conv_rows(const bf16* prow0, int t0, int ch, const ConvW& cwv, f32x4 (&o0)[R], f32x4 (&o1)[R]) {
    u32x4 raw[R + 3];
#pragma unroll
    for (int i = 0; i < R + 3; ++i) raw[i] = (t0 - 3 + i >= 0) ? *(const u32x4*)(prow0 + (ptrdiff_t)(i - 3) * INP + CX + ch) : (u32x4){0u, 0u, 0u, 0u};
#pragma unroll
    for (int r = 0; r < R; ++r) { f32x4 a0 = cwv.b[0], a1 = cwv.b[1];
#pragma unroll
        for (int k = 0; k < 4; ++k) { const u32x4 xv = raw[r + k];
            a0 += cwv.w[k][0] * (f32x4){bf2f(xv.x & 0xffffu), bf2f(xv.x >> 16), bf2f(xv.y & 0xffffu), bf2f(xv.y >> 16)};
            a1 += cwv.w[k][1] * (f32x4){bf2f(xv.z & 0xffffu), bf2f(xv.z >> 16), bf2f(xv.w & 0xffffu), bf2f(xv.w >> 16)}; }
        o0[r] = (f32x4){siluf(a0.x), siluf(a0.y), siluf(a0.z), siluf(a0.w)}; o1[r] = (f32x4){siluf(a1.x), siluf(a1.y), siluf(a1.z), siluf(a1.w)}; }
}

constexpr size_t WS_ACUM = 666 * MiB;
constexpr size_t WS_STATES = WS_Y;
constexpr size_t WS_HPREV = WS_XC;
__device__ __forceinline__ void ssd_states_item(CP& p, const Ctx& c, int b, int ch, int g) {
    LAS unsigned char* Bm = c.lds;
    LAS unsigned char* Xw = c.lds + 36864;
    LAS float* wts = (LAS float*)(c.lds + 118784);
    const int lane = c.lane, wave = c.wave, tid = c.tid, fq = lane >> 4, fr = lane & 15;
    const int m0 = b * SEQ + ch * 128;
    const bf16* pr0 = (const bf16*)(c.ws + WS_PROJ) + (size_t)m0 * INP; const int tch = ch * 128;
    if (wave < 4) {
        const int h = 4 * g + wave; const float A = -__expf(p.in[I_ALOG][h]);
        const float* dtp = (const float*)(c.ws + WS_DT) + (size_t)m0 * NH + h;
        const float d0 = dtp[(size_t)(2 * lane) * NH], d1 = dtp[(size_t)(2 * lane + 1) * NH];
        const float a0 = d0 * A, a1 = d1 * A; float sc = a0 + a1;
#pragma unroll
        for (int o = 1; o < 64; o <<= 1) { const float t = __shfl_up(sc, o); if (lane >= o) sc += t; }
        const float aend = __shfl(sc, 63); const float ac1 = sc, ac0 = sc - a1;
        float* ag = (float*)(c.ws + WS_ACUM) + (size_t)m0 * NH + h; ag[(size_t)(2 * lane) * NH] = ac0; ag[(size_t)(2 * lane + 1) * NH] = ac1;
        wts[wave * 128 + 2 * lane] = d0 * __expf(aend - ac0); wts[wave * 128 + 2 * lane + 1] = d1 * __expf(aend - ac1);
    }
    f32x4 xo0[8], xo1[8];
    { const int cc = tid & 7, e = (tid >> 3) & 3, chn = (4 * g + e) * HP + cc * 8, r0 = 8 * (tid >> 5); ConvW cwv; conv_load_w(cwv, p.in[I_CONVW], p.in[I_CONVB], chn);
      conv_rows<8>(pr0 + (size_t)r0 * INP, tch + r0, chn, cwv, xo0, xo1); }
    { const int cc = tid & 15, chn = INNER + g * SN + cc * 8, r0 = 4 * (tid >> 4); ConvW cwv; conv_load_w(cwv, p.in[I_CONVW], p.in[I_CONVB], chn);
      f32x4 o0[4], o1[4]; conv_rows<4>(pr0 + (size_t)r0 * INP, tch + r0, chn, cwv, o0, o1);
#pragma unroll
      for (int r = 0; r < 4; ++r) *(LAS bf16x8*)(Bm + (r0 + r) * 288 + cc * 16) = pack8(o0[r], o1[r]); }
    __syncthreads();
    { const int cc = tid & 7, e = (tid >> 3) & 3, r0 = 8 * (tid >> 5);
#pragma unroll
      for (int r = 0; r < 8; ++r) { const float w = wts[e * 128 + r0 + r]; *(LAS bf16x8*)(Xw + e * 20480 + (r0 + r) * 160 + cc * 16) = pack8(xo0[r] * w, xo1[r] * w); } }
    __syncthreads();
    const int troff = (4 * fq + (fr >> 2));
    bf16x8 bfr[4];
#pragma unroll
    for (int ks = 0; ks < 4; ++ks) { const LAS unsigned char* a = Bm + (32 * ks + troff) * 288 + (16 * wave + 4 * (fr & 3)) * 2; bfr[ks] = cat4(tr_read(a), tr_read(a + 16 * 288)); }
    float* st = (float*)(c.ws + WS_STATES) + (((size_t)(b * 16 + ch) * NH + 4 * g) * HP) * SN;
#pragma unroll 1
    for (int e = 0; e < 4; ++e) {
#pragma unroll
        for (int pt = 0; pt < 4; ++pt) { f32x4 acc = (f32x4){0.f, 0.f, 0.f, 0.f};
#pragma unroll
            for (int ks = 0; ks < 4; ++ks) { const LAS unsigned char* a = Xw + e * 20480 + (32 * ks + troff) * 160 + (16 * pt + 4 * (fr & 3)) * 2; acc = MFMA16(cat4(tr_read(a), tr_read(a + 16 * 160)), bfr[ks], acc); }
#pragma unroll
            for (int r = 0; r < 4; ++r) st[((size_t)e * HP + 16 * pt + 4 * fq + r) * SN + 16 * wave + fr] = acc[r]; }
    }
    __syncthreads();
}

__device__ __forceinline__ void ph_ssd_scan(CP& p, const Ctx& c, int blk0) {
    if ((int)blockIdx.x < blk0) return;
    const size_t gt = (size_t)(blockIdx.x - blk0) * NT + c.tid, gn = (size_t)(gridDim.x - blk0) * NT;
    const float* st = (const float*)(c.ws + WS_STATES); bf16* hp = (bf16*)(c.ws + WS_HPREV); const float* ac = (const float*)(c.ws + WS_ACUM);
    for (size_t i = gt; i < (size_t)BATCH * NH * HP * (SN / 4); i += gn) { const int n4 = (int)(i & 31), pp = (int)(i >> 5) & 63, h = (int)(i >> 11) & 31, b = (int)(i >> 16);
        f32x4 hr = (f32x4){0.f, 0.f, 0.f, 0.f};
        f32x4 stv[16]; float dcv[16];
#pragma unroll
        for (int ch = 0; ch < 16; ++ch) { stv[ch] = __builtin_nontemporal_load((const f32x4*)(st + ((((size_t)(b * 16 + ch) * NH + h) * HP + pp) * SN) + 4 * n4)); dcv[ch] = ac[(size_t)(b * SEQ + ch * 128 + 127) * NH + h]; }
#pragma unroll
        for (int ch = 0; ch < 16; ++ch) { const size_t off = ((((size_t)(b * 16 + ch) * NH + h) * HP + pp) * SN) + 4 * n4;
            u32x2 w; w.x = pk2(hr.x, hr.y); w.y = pk2(hr.z, hr.w); *(u32x2*)(hp + off) = w;
            hr = hr * __expf(dcv[ch]) + stv[ch]; }
        *(f32x4*)(p.out + O_PSSM + (((size_t)b * NH + h) * HP + pp) * SN + 4 * n4) = hr; }
}

__device__ __forceinline__ void ssd_out_item(CP& p, const Ctx& c, int b, int ch, int g, bool do_atomic = true) {
    LAS unsigned char* Bm = c.lds;
    LAS unsigned char* Xs = c.lds + 34816;
    LAS float* acs = (LAS float*)(c.lds + 116736);
    LAS float* dts = (LAS float*)(c.lds + 118784);
    const int lane = c.lane, wave = c.wave, tid = c.tid, fq = lane >> 4, fr = lane & 15;
    const int m0 = b * SEQ + ch * 128;
    const bf16* pr0 = (const bf16*)(c.ws + WS_PROJ) + (size_t)m0 * INP; const int tch = ch * 128;
    { const int cc = tid & 7, e = (tid >> 3) & 3, chn = (4 * g + e) * HP + cc * 8, r0 = 8 * (tid >> 5); ConvW cwv; conv_load_w(cwv, p.in[I_CONVW], p.in[I_CONVB], chn);
      f32x4 o0[8], o1[8]; conv_rows<8>(pr0 + (size_t)r0 * INP, tch + r0, chn, cwv, o0, o1);
#pragma unroll
      for (int r = 0; r < 8; ++r) *(LAS bf16x8*)(Xs + e * 20480 + (r0 + r) * 160 + cc * 16) = pack8(o0[r], o1[r]); }
    { const int cc = tid & 15, chn = INNER + g * SN + cc * 8, r0 = 4 * (tid >> 4); ConvW cwv; conv_load_w(cwv, p.in[I_CONVW], p.in[I_CONVB], chn);
      f32x4 o0[4], o1[4]; conv_rows<4>(pr0 + (size_t)r0 * INP, tch + r0, chn, cwv, o0, o1);
#pragma unroll
      for (int r = 0; r < 4; ++r) *(LAS bf16x8*)(Bm + (r0 + r) * 272 + cc * 16) = pack8(o0[r], o1[r]); }
    { const int e = tid >> 7, j = tid & 127; acs[tid] = ((const float*)(c.ws + WS_ACUM))[(size_t)(m0 + j) * NH + 4 * g + e]; dts[tid] = ((const float*)(c.ws + WS_DT))[(size_t)(m0 + j) * NH + 4 * g + e]; }
    __syncthreads();
    const int i_tok = 16 * wave + fr;
    bf16x8 cf[4];
#pragma unroll
    for (int ks = 0; ks < 4; ++ks) { const int chn = INNER + SG * SN + g * SN + 32 * ks + 8 * fq; ConvW cwv; conv_load_w(cwv, p.in[I_CONVW], p.in[I_CONVB], chn);
        f32x4 o0, o1; conv8(pr0 + (size_t)i_tok * INP, tch + i_tok, chn, cwv, o0, o1); cf[ks] = pack8(o0, o1); }
    f32x4 cb[8];
#pragma unroll
    for (int jt = 0; jt < 8; ++jt) { cb[jt] = (f32x4){0.f, 0.f, 0.f, 0.f};
        if (jt <= wave) {
#pragma unroll
            for (int ks = 0; ks < 4; ++ks) cb[jt] = MFMA16(*(const LAS bf16x8*)(Bm + (16 * jt + fr) * 272 + (32 * ks + 8 * fq) * 2), cf[ks], cb[jt]); } }
    const int troff = 4 * fq + (fr >> 2);
    const bf16* hpv = (const bf16*)(c.ws + WS_HPREV) + (((size_t)(b * 16 + ch) * NH + 4 * g) * HP) * SN;
    bf16* a1row = (bf16*)(c.ws + WS_A1) + (size_t)(m0 + i_tok) * MIXK + 4 * g * HP; const bf16* zrow = pr0 + (size_t)i_tok * INP + CZ + 4 * g * HP; float ssq = 0.f;
    bf16x8 hp[16];
#pragma unroll
    for (int q = 0; q < 16; ++q) hp[q] = *(const bf16x8*)(hpv + ((size_t)(16 * (q >> 2) + fr)) * SN + 32 * (q & 3) + 8 * fq);
#pragma unroll 1
    for (int e = 0; e < 4; ++e) {
        const float ai = acs[e * 128 + i_tok];
        u32x2 zv4[4];
#pragma unroll
        for (int pt = 0; pt < 4; ++pt) zv4[pt] = *(const u32x2*)(zrow + e * HP + 16 * pt + 4 * fq);
        f32x4 acc[4];
#pragma unroll
        for (int pt = 0; pt < 4; ++pt) { acc[pt] = (f32x4){0.f, 0.f, 0.f, 0.f};
#pragma unroll
            for (int ks = 0; ks < 4; ++ks) acc[pt] = MFMA16(hp[pt * 4 + ks], cf[ks], acc[pt]); }
        if (e < 3) {
#pragma unroll
            for (int q = 0; q < 16; ++q) hp[q] = *(const bf16x8*)(hpv + ((size_t)(e + 1) * HP + 16 * (q >> 2) + fr) * SN + 32 * (q & 3) + 8 * fq); }
        const float ei = __expf(ai);
#pragma unroll
        for (int pt = 0; pt < 4; ++pt) acc[pt] = acc[pt] * ei;
#pragma unroll
        for (int s2 = 0; s2 < 4; ++s2) {
            if (2 * s2 <= wave) {
                f32x4 mv[2];
#pragma unroll
                for (int hf = 0; hf < 2; ++hf) { const int jt = 2 * s2 + hf; const int j0 = 16 * jt + 4 * fq;
                    const f32x4 aj = *(const LAS f32x4*)(acs + e * 128 + j0), dj = *(const LAS f32x4*)(dts + e * 128 + j0);
#pragma unroll
                    for (int r = 0; r < 4; ++r) mv[hf][r] = (j0 + r <= i_tok) ? cb[jt][r] * __expf(ai - aj[r]) * dj[r] : 0.f; }
                const bf16x8 mf = pack8(mv[0], mv[1]);
#pragma unroll
                for (int pt = 0; pt < 4; ++pt) { const LAS unsigned char* a = Xs + e * 20480 + (32 * s2 + troff) * 160 + (16 * pt + 4 * (fr & 3)) * 2; acc[pt] = MFMA16(cat4(tr_read(a), tr_read(a + 16 * 160)), mf, acc[pt]); }
            }
        }
        const float dsk = p.in[I_DSKIP][4 * g + e];
#pragma unroll
        for (int pt = 0; pt < 4; ++pt) { const int pc = e * HP + 16 * pt + 4 * fq;
            const u32x2 xv = *(const LAS u32x2*)(Xs + e * 20480 + i_tok * 160 + (16 * pt + 4 * fq) * 2), zv = zv4[pt];
            const float y0 = (acc[pt][0] + dsk * bf2f(xv.x & 0xffffu)) * siluf(bf2f(zv.x & 0xffffu)), y1 = (acc[pt][1] + dsk * bf2f(xv.x >> 16)) * siluf(bf2f(zv.x >> 16));
            const float y2 = (acc[pt][2] + dsk * bf2f(xv.y & 0xffffu)) * siluf(bf2f(zv.y & 0xffffu)), y3 = (acc[pt][3] + dsk * bf2f(xv.y >> 16)) * siluf(bf2f(zv.y >> 16));
            ssq += (y0 * y0 + y1 * y1) + (y2 * y2 + y3 * y3);
            u32x2 w; w.x = pk2(y0, y1); w.y = pk2(y2, y3); *(u32x2*)(a1row + pc) = w; }
    }
    ssq += __shfl_xor(ssq, 16); ssq += __shfl_xor(ssq, 32);
    if (fq == 0 && do_atomic) atomicAdd((float*)(c.ws + WS_RS) + m0 + i_tok, ssq);
    __syncthreads();
}

struct AttnPre { u32x4 k[8], v[8]; bf16x8 q[4]; float bias; };
struct AttnIt { int b, hd, r, n; };
__device__ __forceinline__ AttnIt attn_decode(int a) { const int gi = a / 512, q = a % 512; AttnIt t; t.b = q >> 7; const int slot = (q >> 4) & 7; t.hd = gi * 8 + slot;
    if (gi == 0) { t.r = 0; t.n = q & 15; } else if (gi == 1) { t.r = (q >> 2) & 3; t.n = q & 3; } else { t.r = q & 15; t.n = 0; } return t; }
__device__ __forceinline__ void attn_prefetch(CP& p, const Ctx& c, const AttnIt it, AttnPre& pre) {
    const int gi = it.hd >> 3, dil = gi == 0 ? 1 : (gi == 1 ? 4 : 16), Ls = SEQ / dil, tid = c.tid, lane = c.lane, wave = c.wave;
    const bf16* proj = (const bf16*)(c.ws + WS_PROJ);
    const int cc = tid & 15;
#pragma unroll
    for (int j = 0; j < 8; ++j) { const int row = (tid >> 4) + 32 * j; int sp = 128 * (it.n - 1) + row; sp = sp < 0 ? 0 : (sp > Ls - 1 ? Ls - 1 : sp);
        const bf16* pr = proj + (size_t)(it.b * SEQ + sp * dil + it.r) * INP + it.hd * HD + cc * 8; pre.k[j] = *(const u32x4*)(pr + CK); pre.v[j] = *(const u32x4*)(pr + CV); }
    const int tokq = it.b * SEQ + (128 * it.n + 16 * wave + (lane & 15)) * dil + it.r;
#pragma unroll
    for (int ks = 0; ks < 4; ++ks) pre.q[ks] = *(const bf16x8*)(proj + (size_t)tokq * INP + CQ + it.hd * HD + 32 * ks + 8 * (lane >> 4));
    { const int t = tid - 16; pre.bias = (tid < 176 && t >= 0 && t <= 128) ? p.in[I_RELB][rel_bucket((128 - t) * dil) * AH + it.hd] : -1e30f; }
}
__device__ __forceinline__ void attn_store_lds(const Ctx& c, const AttnPre& pre) {
    LAS unsigned char* Ks = c.lds; LAS unsigned char* Vs = c.lds + 69632; LAS float* rb = (LAS float*)(c.lds + 143360);
    const int tid = c.tid, cc = tid & 15;
#pragma unroll
    for (int j = 0; j < 8; ++j) { const int row = (tid >> 4) + 32 * j; *(LAS u32x4*)(Ks + row * 272 + cc * 16) = pre.k[j]; *(LAS u32x4*)(Vs + row * 288 + cc * 16) = pre.v[j]; }
    if (tid < 176) rb[tid] = pre.bias;
}
__device__ __forceinline__ void attn_compute(CP& p, const Ctx& c, const AttnIt it, const bf16x8 (&qf)[4]) {
    const int gi = it.hd >> 3, slot = it.hd & 7, dil = gi == 0 ? 1 : (gi == 1 ? 4 : 16), n = it.n;
    const LAS unsigned char* Ks = c.lds; const LAS unsigned char* Vs = c.lds + 69632; const LAS float* rb = (const LAS float*)(c.lds + 143360);
    const int lane = c.lane, wave = c.wave, fq = lane >> 4, fr = lane & 15;
    const int q0 = 16 * wave, qi = q0 + fr;
    const int tokq = it.b * SEQ + (128 * n + qi) * dil + it.r;
    f32x4 sa[10];
#pragma unroll
    for (int kt = 0; kt < 10; ++kt) { int kr = q0 + 16 * kt + fr; kr = kr > 255 ? 255 : kr;
        sa[kt] = (f32x4){0.f, 0.f, 0.f, 0.f};
#pragma unroll
        for (int ks = 0; ks < 4; ++ks) sa[kt] = MFMA16(*(const LAS bf16x8*)(Ks + kr * 272 + (32 * ks + 8 * fq) * 2), qf[ks], sa[kt]);
        if (kt & 1) __builtin_amdgcn_sched_barrier(0); }
    float mx = -1e30f;
#pragma unroll
    for (int kt = 0; kt < 10; ++kt)
#pragma unroll
        for (int rg = 0; rg < 4; ++rg) { const int t = 16 * kt + 4 * fq + rg - fr; float lg = sa[kt][rg] * 0.08838834764831845f + rb[t + 16];
            if (n == 0 && (q0 + 16 * kt + 4 * fq + rg) < 128) lg = -1e30f;
            sa[kt][rg] = lg; mx = fmaxf(mx, lg); }
    mx = fmaxf(mx, __shfl_xor(mx, 16)); mx = fmaxf(mx, __shfl_xor(mx, 32));
    float sum = 0.f;
#pragma unroll
    for (int kt = 0; kt < 10; ++kt)
#pragma unroll
        for (int rg = 0; rg < 4; ++rg) { const float e = __expf(sa[kt][rg] - mx); sa[kt][rg] = e; sum += e; }
    sum += __shfl_xor(sum, 16); sum += __shfl_xor(sum, 32);
    bf16x8 pf[5];
#pragma unroll
    for (int s2 = 0; s2 < 5; ++s2) pf[s2] = pack8(sa[2 * s2], sa[2 * s2 + 1]);
    const float inv = 1.f / sum;
    bf16* orow = (bf16*)(c.ws + WS_ATT) + ((size_t)gi * MP + tokq) * AOUT + slot * HD;
#pragma unroll
    for (int dt = 0; dt < 8; ++dt) { f32x4 o = (f32x4){0.f, 0.f, 0.f, 0.f};
#pragma unroll
        for (int s2 = 0; s2 < 5; ++s2) { int r0 = q0 + 32 * s2 + 4 * fq + (fr >> 2), r1 = r0 + 16; r0 = r0 > 255 ? 255 : r0; r1 = r1 > 255 ? 255 : r1;
            const int cb2 = (16 * dt + 4 * (fr & 3)) * 2; o = MFMA16(cat4(tr_read(Vs + r0 * 288 + cb2), tr_read(Vs + r1 * 288 + cb2)), pf[s2], o); }
        u32x2 w; w.x = pk2(o[0] * inv, o[1] * inv); w.y = pk2(o[2] * inv, o[3] * inv); *(u32x2*)(orow + 16 * dt + 4 * fq) = w;
        if (dt & 1) __builtin_amdgcn_sched_barrier(0); }
    if (fq == 0) ((float*)(c.ws + WS_LSE))[((size_t)gi * MP + tokq) * HPP + slot] = mx + __logf(sum);
}

__device__ __forceinline__ void ph_mixers(CP& p, const Ctx& c) {
    const int G = gridDim.x;
    int it = blockIdx.x;
    for (; it < 512; it += G) ssd_states_item(p, c, it >> 7, (it >> 3) & 15, it & 7);
    int a = it - 512;
    if (a < 1536) {
        AttnPre pre; attn_prefetch(p, c, attn_decode(a), pre);
#pragma clang loop unroll(disable)
        for (; a < 1536; a += G) {
            const AttnIt cur = attn_decode(a);
            attn_store_lds(c, pre);
            bf16x8 qf[4];
#pragma unroll
            for (int ks = 0; ks < 4; ++ks) qf[ks] = pre.q[ks];
            __syncthreads();
            if (a + G < 1536) attn_prefetch(p, c, attn_decode(a + G), pre);
            attn_compute(p, c, cur, qf);
            __syncthreads();
        }
    }
}
__device__ __forceinline__ void ph_sample_mix(CP& p, const Ctx& c) {
    const int lane = c.lane;
    for (int it = c.gw; it < SB * NH * HP; it += c.ngw) {
        const int b = it >> 11, h = (it >> 6) & 31, pp = it & 63, g = h >> 2;
        const float* xcs = (const float*)(c.ws + WS_SMP + SM_XC) + (size_t)b * CONVD;
        const float dtv = ((const float*)(c.ws + WS_SMP + SM_DT))[b * NH + h], a = __expf(-__expf(p.in[I_ALOG][h]) * dtv), xdt = dtv * xcs[h * HP + pp];
        const float* h0 = p.in[I_SSM] + (((size_t)b * NH + h) * HP + pp) * SN; float* ho = p.out + O_SSSM + (((size_t)b * NH + h) * HP + pp) * SN;
        const f32x2 hv = *(const f32x2*)(h0 + 2 * lane), bv = *(const f32x2*)(xcs + INNER + g * SN + 2 * lane), cv = *(const f32x2*)(xcs + INNER + SG * SN + g * SN + 2 * lane);
        const f32x2 hn = (f32x2){a * hv.x + xdt * bv.x, a * hv.y + xdt * bv.y};
        *(f32x2*)(ho + 2 * lane) = hn;
        const float y = wave_sum(hn.x * cv.x + hn.y * cv.y);
        if (lane == 0) ((float*)(c.ws + WS_SMP + SM_Y))[b * INNER + h * HP + pp] = y;
    }
}
__device__ __forceinline__ void ph_sample_attn(CP& p, const Ctx& c) {
    const int lane = c.lane;
    for (int it = c.gw; it < SB * AH; it += c.ngw) {
        const int b = it / AH, hd = it % AH, gi = hd >> 3, slot = hd & 7, dil = gi == 0 ? 1 : (gi == 1 ? 4 : 16), W = kvlen(gi);
        const float* qk = (const float*)(c.ws + WS_SMP + SM_QK) + (size_t)b * 6144; const float* q = qk + hd * HD; const float* knew = qk + (AH + hd) * HD;
        const float* vnew = (const float*)(c.ws + WS_SMP + SM_PROJ) + (size_t)b * INP + CV + hd * HD;
        const float* const kc0 = p.in[I_KV128]; const float* const kc1 = p.in[I_KV512]; const float* const kc2 = p.in[I_KV2048];
        const float* cache = (gi == 0 ? kc0 : (gi == 1 ? kc1 : kc2)) + (size_t)b * W * 2048;
        LAS float* ps = (LAS float*)c.lds + c.wave * 160;
        const int sub = lane & 3, kg = lane >> 2;
        f32x4 qv[8];
#pragma unroll
        for (int e = 0; e < 8; ++e) qv[e] = *(const f32x4*)(q + sub * 32 + 4 * e);
        float lg[9]; float mx = -1e30f;
#pragma unroll
        for (int ps9 = 0; ps9 < 9; ++ps9) { const int jj = ps9 * 16 + kg; const int jc = jj > 128 ? 128 : jj;
            const float* kr = (jc == 0 ? knew : cache + ((size_t)(W - dil * jc) * 2 + 0) * 1024 + slot * HD) + sub * 32; float sdot = 0.f;
#pragma unroll
            for (int e = 0; e < 8; ++e) { const f32x4 kv = *(const f32x4*)(kr + 4 * e); sdot += (kv.x * qv[e].x + kv.y * qv[e].y) + (kv.z * qv[e].z + kv.w * qv[e].w); }
            sdot += __shfl_xor(sdot, 1); sdot += __shfl_xor(sdot, 2);
            lg[ps9] = jj <= 128 ? sdot * 0.08838834764831845f + p.in[I_RELB][rel_bucket(jc * dil) * AH + hd] : -1e30f; mx = fmaxf(mx, lg[ps9]); }
        mx = wave_max(mx); float sum = 0.f;
#pragma unroll
        for (int ps9 = 0; ps9 < 9; ++ps9) { const int jj = ps9 * 16 + kg; const float e = jj <= 128 ? __expf(lg[ps9] - mx) : 0.f; if (sub == 0) { ps[jj] = e; sum += e; } }
        sum = wave_sum(sum);
        LDS_WAIT();
        const int ksl = lane >> 3, dc = lane & 7;
        f32x4 oa[4];
#pragma unroll
        for (int q4 = 0; q4 < 4; ++q4) oa[q4] = (f32x4){0.f, 0.f, 0.f, 0.f};
#pragma unroll 1
        for (int j0 = 0; j0 < 160; j0 += 32) { f32x4 vv[4][4]; float pj[4];
#pragma unroll
            for (int st = 0; st < 4; ++st) { const int jj = j0 + 8 * st + ksl; const int jc = jj > 128 ? 128 : jj; const float* vr = (jc == 0 ? vnew : cache + ((size_t)(W - dil * jc) * 2 + 1) * 1024 + slot * HD) + 16 * dc;
                pj[st] = jj <= 128 ? ps[jj] : 0.f;
#pragma unroll
                for (int q4 = 0; q4 < 4; ++q4) vv[st][q4] = *(const f32x4*)(vr + 4 * q4); }
#pragma unroll
            for (int st = 0; st < 4; ++st)
#pragma unroll
                for (int q4 = 0; q4 < 4; ++q4) oa[q4] += vv[st][q4] * pj[st]; }
#pragma unroll
        for (int q4 = 0; q4 < 4; ++q4)
#pragma unroll
            for (int e = 0; e < 4; ++e) { float t = oa[q4][e]; t += __shfl_xor(t, 8); t += __shfl_xor(t, 16); t += __shfl_xor(t, 32); oa[q4][e] = t; }
        const float inv = 1.f / sum;
        if (ksl == 0) { float* ao = (float*)(c.ws + WS_SMP + SM_ATT) + ((size_t)gi * SB + b) * AOUT + slot * HD + 16 * dc;
#pragma unroll
            for (int q4 = 0; q4 < 4; ++q4) *(f32x4*)(ao + 4 * q4) = oa[q4] * inv; }
        if (lane == 0) ((float*)(c.ws + WS_SMP + SM_LSE))[(gi * SB + b) * HPP + slot] = mx + __logf(sum);
        LDS_WAIT();
    }
}

__device__ __forceinline__ void ph_combine(CP& p, const Ctx& c, int blk0) {
    if ((int)blockIdx.x < blk0) return;
    const int lane = c.lane; const float* lse = (const float*)(c.ws + WS_LSE);
    for (int m = c.gw - blk0 * NWAVES; m < MP; m += c.ngw - blk0 * NWAVES) {
        bf16* arow = (bf16*)(c.ws + WS_A1) + (size_t)m * MIXK;
#pragma unroll
        for (int j = 0; j < 4; ++j) { const int ch = 4 * (lane + 64 * j), slot = ch >> 7;
            const float l0 = lse[((size_t)0 * MP + m) * HPP + slot], l1 = lse[((size_t)1 * MP + m) * HPP + slot], l2 = lse[((size_t)2 * MP + m) * HPP + slot];
            const float mx = fmaxf(l0, fmaxf(l1, l2)); float w0 = __expf(l0 - mx), w1 = __expf(l1 - mx), w2 = __expf(l2 - mx); const float inv = 1.f / (w0 + w1 + w2); w0 *= inv; w1 *= inv; w2 *= inv;
            const bf16* ab = (const bf16*)(c.ws + WS_ATT) + (size_t)m * AOUT + ch;
            const u32x2 a0 = *(const u32x2*)ab, a1 = *(const u32x2*)(ab + (size_t)MP * AOUT), a2 = *(const u32x2*)(ab + (size_t)2 * MP * AOUT);
            const float o0 = w0 * bf2f(a0.x & 0xffffu) + w1 * bf2f(a1.x & 0xffffu) + w2 * bf2f(a2.x & 0xffffu), o1 = w0 * bf2f(a0.x >> 16) + w1 * bf2f(a1.x >> 16) + w2 * bf2f(a2.x >> 16);
            const float o2 = w0 * bf2f(a0.y & 0xffffu) + w1 * bf2f(a1.y & 0xffffu) + w2 * bf2f(a2.y & 0xffffu), o3 = w0 * bf2f(a0.y >> 16) + w1 * bf2f(a1.y >> 16) + w2 * bf2f(a2.y >> 16);
            u32x2 w; w.x = pk2(o0, o1); w.y = pk2(o2, o3); *(u32x2*)(arow + INNER + ch) = w; }
    }
}
__device__ __forceinline__ void ph_sample_a1(CP& p, const Ctx& c) {
    const int lane = c.lane;
    for (int b = c.gw; b < SB; b += c.ngw) {
        f32x4 v[8]; load_row((const float*)(c.ws + WS_SMP + SM_Y) + (size_t)b * INNER, v, lane);
        const float* xcs = (const float*)(c.ws + WS_SMP + SM_XC) + (size_t)b * CONVD; const float* zs = (const float*)(c.ws + WS_SMP + SM_PROJ) + (size_t)b * INP + CZ;
        float ss = 0.f;
#pragma unroll
        for (int j = 0; j < 8; ++j) { const int ch = 4 * (lane + 64 * j); const float dsk = p.in[I_DSKIP][ch >> 6]; const f32x4 xv = *(const f32x4*)(xcs + ch), zv = *(const f32x4*)(zs + ch);
            v[j].x = (v[j].x + dsk * xv.x) * siluf(zv.x); v[j].y = (v[j].y + dsk * xv.y) * siluf(zv.y); v[j].z = (v[j].z + dsk * xv.z) * siluf(zv.z); v[j].w = (v[j].w + dsk * xv.w) * siluf(zv.w);
            ss += (v[j].x * v[j].x + v[j].y * v[j].y) + (v[j].z * v[j].z + v[j].w * v[j].w); }
        const float rs = rsqrtf(wave_sum(ss) * (1.f / INNER) + EPS);
        bf16* arow = (bf16*)(c.ws + WS_SMP + SM_A1BF) + (size_t)b * MIXK;
#pragma unroll
        for (int j = 0; j < 8; ++j) { const int ch = 4 * (lane + 64 * j); const f32x4 o = v[j] * rs; u32x2 w; w.x = pk2(o.x, o.y); w.y = pk2(o.z, o.w); *(u32x2*)(arow + ch) = w; }
        const float* lse = (const float*)(c.ws + WS_SMP + SM_LSE); const float* att = (const float*)(c.ws + WS_SMP + SM_ATT);
#pragma unroll
        for (int j = 0; j < 4; ++j) { const int ch = 4 * (lane + 64 * j), slot = ch >> 7;
            const float l0 = lse[(0 * SB + b) * HPP + slot], l1 = lse[(1 * SB + b) * HPP + slot], l2 = lse[(2 * SB + b) * HPP + slot];
            const float mx = fmaxf(l0, fmaxf(l1, l2)); float w0 = __expf(l0 - mx), w1 = __expf(l1 - mx), w2 = __expf(l2 - mx); const float inv = 1.f / (w0 + w1 + w2); w0 *= inv; w1 *= inv; w2 *= inv;
            const f32x4 a0 = *(const f32x4*)(att + ((size_t)0 * SB + b) * AOUT + ch), a1 = *(const f32x4*)(att + ((size_t)1 * SB + b) * AOUT + ch), a2 = *(const f32x4*)(att + ((size_t)2 * SB + b) * AOUT + ch);
            const f32x4 o = a0 * w0 + a1 * w1 + a2 * w2;
            u32x2 w; w.x = pk2(o.x, o.y); w.y = pk2(o.z, o.w); *(u32x2*)(arow + INNER + ch) = w; }
    }
}

__device__ __forceinline__ void ph_pool(CP& p, const Ctx& c) {
    const int lane = c.lane;
    const bf16* x2 = (const bf16*)(c.ws + WS_Y); const float* rss = (const float*)(c.ws + WS_RS) + MP;
    bf16* pg = (bf16*)(c.ws + WS_A1);
    const int gt = blockIdx.x * NT + c.tid, gn = gridDim.x * NT;
    for (int task = gt; task < BATCH * 128 * 512; task += gn) {
        const int cq = task & 511, seg = (task >> 9) & 127, b = task >> 16, ch = 4 * cq, gi = cq >> 7, t0 = seg * 16;
        const f32x4 gg = *(const f32x4*)(p.in[I_NMIX] + D + ch), s1 = *(const f32x4*)(modp(c.ws, 1, b, 1) + ch), sh = *(const f32x4*)(modp(c.ws, 1, b, 0) + ch);
        const f32x4 gm = gg * (s1 + 1.f);
        const bf16* xb = x2 + (size_t)b * SEQ * D + ch; const float* rb = rss + b * SEQ;
        f32x4 xh[31];
#pragma unroll
        for (int i = 0; i < 31; ++i) { const int t = t0 - 15 + i; if (t >= 0 && i >= 16 - (2 << gi)) { const u32x2 x = *(const u32x2*)(xb + (size_t)t * D); xh[i] = (f32x4){__uint_as_float(x.x << 16), __uint_as_float(x.x & 0xffff0000u), __uint_as_float(x.y << 16), __uint_as_float(x.y & 0xffff0000u)} * rsqrtf(rb[t] * (1.f / D) + EPS); } else xh[i] = (f32x4){0.f, 0.f, 0.f, 0.f}; }
        auto emit = [&](int i, const f32x4& S, int w) { const int t = t0 + i; const int cnt = t + 1 < w ? t + 1 : w; const f32x4 xn = xh[15 + i]; const f32x4 o = gm * (S * __builtin_amdgcn_rcpf((float)cnt) - xn);
            u32x2 wv; wv.x = pk2(o.x, o.y); wv.y = pk2(o.z, o.w); *(u32x2*)(pg + (size_t)(b * SEQ + t) * D + ch) = wv;
            if (t >= SEQ - 15) *(f32x4*)(p.out + O_PPOOL + ((size_t)b * 15 + (t - (SEQ - 15))) * D + ch) = xn * gm + sh; };
#define POOL_W(W_) { f32x4 S = (f32x4){0.f, 0.f, 0.f, 0.f}; _Pragma("unroll") for (int k = 0; k < W_; ++k) S += xh[15 - k]; \
            _Pragma("unroll") for (int i = 0; i < 16; ++i) { emit(i, S, W_); if (i < 15) S += xh[16 + i] - xh[16 + i - W_]; } }
        if (gi == 0) POOL_W(2) else if (gi == 1) POOL_W(4) else if (gi == 2) POOL_W(8) else POOL_W(16)
#undef POOL_W
    }
    for (int it = c.gw; it < 112 + 64; it += c.ngw) {
        if (it < 112) { const int b = it / 14, k = it % 14; f32x4 t4[8]; load_row(p.in[I_POOL] + ((size_t)b * 15 + k + 1) * D, t4, lane); store_row_f32(p.out + O_SPOOL + ((size_t)b * 15 + k) * D, t4, lane); continue; }
        const int b = (it - 112) >> 3, j = (it - 112) & 7;
        f32x4 v[8]; load_row((const float*)(c.ws + WS_SMP + SM_X2) + (size_t)b * D, v, lane);
        const float rs = row_rs(v);
        const int ch = 4 * (lane + 64 * j), gi = ch >> 9, w = 2 << gi;
        const f32x4 xr = v[0];
        (void)xr;
        f32x4 xo;
#pragma unroll
        for (int jj = 0; jj < 8; ++jj) if (jj == j) xo = v[jj];
        ((f32x4*)((float*)(c.ws + WS_SMP + SM_X3) + (size_t)b * D))[lane + 64 * j] = xo;
        const f32x4 gg = *(const f32x4*)(p.in[I_NMIX] + D + ch), s1 = *(const f32x4*)(modp(c.ws, 1, 4 + b, 1) + ch), s0 = *(const f32x4*)(modp(c.ws, 1, 4 + b, 0) + ch);
        const f32x4 u = xo * rs * gg * (s1 + 1.f) + s0;
        const float* sp = p.in[I_POOL] + (size_t)b * 15 * D;
        *(f32x4*)(p.out + O_SPOOL + ((size_t)b * 15 + 14) * D + ch) = u;
        f32x4 pr[15];
#pragma unroll
        for (int k = 1; k < 16; ++k) pr[k - 1] = *(const f32x4*)(sp + (size_t)(15 - k) * D + ch);
        f32x4 sacc = u;
#pragma unroll
        for (int k = 1; k < 16; ++k) if (k < w) sacc += pr[k - 1];
        const f32x4 o = sacc * (1.f / (float)w) - u; u32x2 wv; wv.x = pk2(o.x, o.y); wv.y = pk2(o.z, o.w); *(u32x2*)((bf16*)(c.ws + WS_SMP + SM_PGBF) + (size_t)b * D + ch) = wv;
    }
}

constexpr int NPHASE = 15;
constexpr int KV_SPLIT = 7000;
__device__ __forceinline__ unsigned char* launder(unsigned char* q) { const unsigned long long v = (unsigned long long)q; unsigned lo = (unsigned)__builtin_amdgcn_readfirstlane((int)(unsigned)v), hi = (unsigned)__builtin_amdgcn_readfirstlane((int)(unsigned)(v >> 32)); asm volatile("" : "+s"(lo), "+s"(hi)); return (unsigned char*)(((unsigned long long)hi << 32) | (unsigned long long)lo); }
__device__ __forceinline__ CP* kernarg_p() { unsigned long long v = (unsigned long long)__builtin_amdgcn_kernarg_segment_ptr(); unsigned lo = (unsigned)v, hi = (unsigned)(v >> 32); asm volatile("" : "+s"(lo), "+s"(hi)); return (CP*)(((unsigned long long)hi << 32) | (unsigned long long)lo); }
__global__ void __launch_bounds__(NT, 2) mk_fwd(P p_unused) {
    (void)p_unused;
    CP& p0 = *kernarg_p();
    extern __shared__ __attribute__((aligned(16))) unsigned char lds_raw[];
    Ctx c0; c0.lds = (LAS unsigned char*)lds_raw; c0.tid = threadIdx.x; c0.lane = c0.tid & 63; c0.wave = __builtin_amdgcn_readfirstlane(c0.tid >> 6);
    c0.gw = blockIdx.x * NWAVES + c0.wave; c0.ngw = gridDim.x * NWAVES; c0.ws = nullptr;
    volatile LAS unsigned* bst = (volatile LAS unsigned*)(c0.lds + LDS_BYTES - 16);
    if (c0.tid < 4) bst[c0.tid] = 0u;
    __syncthreads();
#define WS_UNIFORM() ((unsigned char*)((((unsigned long long)(unsigned)__builtin_amdgcn_readfirstlane((int)((unsigned long long)p0.ws >> 32))) << 32) | (unsigned long long)(unsigned)__builtin_amdgcn_readfirstlane((int)(unsigned)(unsigned long long)p0.ws)))
    (void)xcd_barrier_post((unsigned*)(WS_UNIFORM() + WS_CTL) + 1024, bst);
    const int lo = p0.ph_lo, hi = p0.ph_hi;
    const int G = gridDim.x;
#ifndef PHMASK
#define PHMASK 0xFFFFF
#endif
#define IN(k) (((PHMASK >> (k)) & 1) && lo <= (k) && (k) < hi)
#ifndef REPMASK
#define REPMASK 0
#endif
#define REPLOOP(k) _Pragma("clang loop unroll(disable)") for (int rep_ = 0; rep_ < 1 + ((REPMASK >> (k)) & 1); ++rep_)
#define SEAM(k) do { if (IN(k) && IN((k) + 1)) { XcdBarrier bb_; bb_.bar = (unsigned*)(WS_UNIFORM() + WS_CTL) + 1024; bb_.x = xb_xcc_id(); bb_.st = (volatile LAS unsigned*)(c0.lds + LDS_BYTES - 16); xcd_barrier(bb_); } } while (0)
    if (IN(0)) REPLOOP(0) { CP& p = *kernarg_p(); Ctx c = c0; c.ws = launder(p.ws); unsigned char* ws = c.ws; (void)ws; ph_prologue(p, c); }
    SEAM(0);
    if (IN(1)) REPLOOP(1) { CP& p = *kernarg_p(); Ctx c = c0; c.ws = launder(p.ws); unsigned char* ws = c.ws; (void)ws; ph_normmod<false>(p, c, p.in[I_XP], p.in[I_XS], p.in[I_NMIX], 0, 0, 1, (float*)(ws + WS_SMP + SM_X1)); }
    SEAM(1);
    if (IN(2)) REPLOOP(2) { CP& p = *kernarg_p(); Ctx c = c0; c.ws = launder(p.ws); unsigned char* ws = c.ws; (void)ws;
        pg8::Gemm g{(const bf16*)(ws + WS_A0), (const bf16*)(ws + WS_WIN), MP, INP, D, D, D, 1 << 20, D / 64, D / 64}; pg8::StaticOrder S; S.init(MP, INP, G, blockIdx.x);
        if (G == 256 && blockIdx.x >= 160) { ph_kvcopy(p, c, 0, KV_SPLIT, (blockIdx.x - 160) * NWAVES + c.wave, 96 * NWAVES); __syncthreads(); }
        pg8::EpiProj E{(bf16*)(ws + WS_PROJ), (float*)(ws + WS_DT), p.out, p.in[I_QG], p.in[I_KG], p.in[I_DTB], (LAS float*)(c.lds + 131072)};
        pg8::gemm_phase<pg8::EpiProj>(c.lds, g, S, E);
        float* sp = (float*)(ws + WS_SMP + SM_PROJ); const bf16* ua = (const bf16*)(ws + WS_SMP + SM_USBF);
        if (rep_ == 0) skinny(c, [&](int r, int k) { return *(const bf16x8*)(ua + (size_t)r * D + k); }, (const bf16*)(ws + WS_WIN), D, D, INP, 2, [&](int r, int n, float v) { atomicAdd(sp + (size_t)r * INP + n, v); }, D / 64);
    }
    SEAM(2);
    if (IN(3)) REPLOOP(3) { CP& p = *kernarg_p(); Ctx c = c0; c.ws = launder(p.ws); unsigned char* ws = c.ws; (void)ws; ph_mixers(p, c); ph_sample_postproj(p, c); ph_kvcopy(p, c, (G == 256 ? KV_SPLIT : 0), 10740, c.gw, c.ngw); }
    SEAM(3);
    if (IN(4)) REPLOOP(4) { CP& p = *kernarg_p(); Ctx c = c0; c.ws = launder(p.ws); unsigned char* ws = c.ws; (void)ws; const int sb0 = G >= 64 ? 24 : 0; ph_sample_attn(p, c); ph_ssd_scan(p, c, sb0); ph_combine(p, c, sb0); ph_sample_mix(p, c); }
    SEAM(4);
    if (IN(5)) REPLOOP(5) { CP& p = *kernarg_p(); Ctx c = c0; c.ws = launder(p.ws); unsigned char* ws = c.ws; (void)ws;
        for (int it = blockIdx.x; it < 512; it += gridDim.x) ssd_out_item(p, c, it >> 7, (it >> 3) & 15, it & 7, rep_ == 0);
        ph_sample_a1(p, c); }
    SEAM(5);
    if (IN(6)) REPLOOP(6) { CP& p = *kernarg_p(); Ctx c = c0; c.ws = launder(p.ws); unsigned char* ws = c.ws; (void)ws;
        pg8::Gemm g{(const bf16*)(ws + WS_A1), (const bf16*)(ws + WS_WOUT), MP, D, MIXK, MIXK, MIXK, 1 << 20}; pg8::StaticOrder S; S.init(MP, D, G, blockIdx.x);
        pg8::EpiResid<false, true> E{p.in[I_XP], (void*)(ws + WS_XC), D, modp(c.ws, 0, 0, 2), MODW, nullptr, nullptr};
        pg8::RowScaleHook H{(const float*)(ws + WS_RS)};
        pg8::gemm_phase<pg8::EpiResid<false, true>, true, pg8::RowScaleHook>(c.lds, g, S, E, H);
        float* x1s = (float*)(ws + WS_SMP + SM_X1); const bf16* aa = (const bf16*)(ws + WS_SMP + SM_A1BF);
        if (rep_ == 0) skinny(c, [&](int r, int k) { return *(const bf16x8*)(aa + (size_t)r * MIXK + k); }, (const bf16*)(ws + WS_WOUT), MIXK, MIXK, D, 12, [&](int r, int n, float v) { atomicAdd(x1s + r * D + n, modp(c.ws, 0, 4 + r, 2)[n] * v); });
    }
    SEAM(6);
    if (IN(7)) REPLOOP(7) { CP& p = *kernarg_p(); Ctx c = c0; c.ws = launder(p.ws); unsigned char* ws = c.ws; (void)ws; ph_normmod<true>(p, c, (const void*)(ws + WS_XC), (const float*)(ws + WS_SMP + SM_X1), p.in[I_NMLP], 0, 3, 4, (float*)(ws + WS_SMP + SM_X2)); }
    SEAM(7);
    if (IN(8)) REPLOOP(8) { CP& p = *kernarg_p(); Ctx c = c0; c.ws = launder(p.ws); unsigned char* ws = c.ws; (void)ws;
        pg8::Gemm g{(const bf16*)(ws + WS_A0), (const bf16*)(ws + WS_W1), MP, DFF, D, D, D, 1 << 20, D / 64, D / 64}; pg8::StaticOrder S; S.init(MP, DFF, G, blockIdx.x);
        pg8::EpiBf16<1> E{(bf16*)(ws + WS_HDN), DFF, DFF / 64};
        pg8::gemm_phase<pg8::EpiBf16<1>>(c.lds, g, S, E);
        float* hacc = (float*)(ws + WS_SMP + SM_H0); const bf16* ua = (const bf16*)(ws + WS_SMP + SM_USBF);
        if (rep_ == 0) skinny(c, [&](int r, int k) { return *(const bf16x8*)(ua + (size_t)r * D + k); }, (const bf16*)(ws + WS_W1), D, D, DFF, 4, [&](int r, int n, float v) { atomicAdd(hacc + (size_t)r * DFF + n, v); }, D / 64);
    }
    SEAM(8);
    if (IN(9)) REPLOOP(9) { CP& p = *kernarg_p(); Ctx c = c0; c.ws = launder(p.ws); unsigned char* ws = c.ws; (void)ws;
        pg8::Gemm g{(const bf16*)(ws + WS_HDN), (const bf16*)(ws + WS_W2), MP, D, DFF, DFF, DFF, 1 << 20, DFF / 64, DFF / 64}; pg8::StaticOrder S; S.init(MP, D, G, blockIdx.x);
        pg8::EpiResid<true, true> E{(const void*)(ws + WS_XC), (void*)(ws + WS_Y), D, modp(c.ws, 0, 0, 5), MODW, nullptr, rep_ == 0 ? (float*)(ws + WS_RS) + MP : nullptr};
        pg8::gemm_phase<pg8::EpiResid<true, true>>(c.lds, g, S, E);
        float* x2s = (float*)(ws + WS_SMP + SM_X2); const float* hacc = (const float*)(ws + WS_SMP + SM_H0);
        if (rep_ == 0) skinny(c, [&](int r, int k) { return relu2_bf16x8(hacc + (size_t)r * DFF + k); }, (const bf16*)(ws + WS_W2), DFF, DFF, D, 16, [&](int r, int n, float v) { atomicAdd(x2s + r * D + n, modp(c.ws, 0, 4 + r, 5)[n] * v); }, DFF / 64);
    }
    SEAM(9);
    if (IN(10)) REPLOOP(10) { CP& p = *kernarg_p(); Ctx c = c0; c.ws = launder(p.ws); unsigned char* ws = c.ws; (void)ws; ph_pool(p, c); }
    SEAM(10);
    if (IN(11)) REPLOOP(11) { CP& p = *kernarg_p(); Ctx c = c0; c.ws = launder(p.ws); unsigned char* ws = c.ws; (void)ws;
        pg8::Gemm g{(const bf16*)(ws + WS_A1), (const bf16*)(ws + WS_WPOOL), MP, D, 512, D, 512, 2}; pg8::StaticOrder S; S.init(MP, D, G, blockIdx.x);
        pg8::EpiResid<true, true> E{(const void*)(ws + WS_Y), (void*)(ws + WS_XC), D, modp(c.ws, 1, 0, 2), MODW, p.in[I_POOLS], nullptr};
        pg8::gemm_phase<pg8::EpiResid<true, true>>(c.lds, g, S, E);
        float* x3s = (float*)(ws + WS_SMP + SM_X3); const float* psc = p.in[I_POOLS]; const bf16* pa = (const bf16*)(ws + WS_SMP + SM_PGBF);
#pragma unroll 1
        for (int gq = 0; gq < 4; ++gq)
            if (rep_ == 0) skinny(c, [&](int r, int k) { return *(const bf16x8*)(pa + (size_t)r * D + gq * 512 + k); }, (const bf16*)(ws + WS_WPOOL) + (size_t)gq * 512 * 512, 512, 512, 512, 4,
                   [&](int r, int n, float v) { const int col = gq * 512 + n; atomicAdd(x3s + r * D + col, modp(c.ws, 1, 4 + r, 2)[col] * psc[col] * v); });
    }
    SEAM(11);
    if (IN(12)) REPLOOP(12) { CP& p = *kernarg_p(); Ctx c = c0; c.ws = launder(p.ws); unsigned char* ws = c.ws; (void)ws; ph_normmod<true>(p, c, (const void*)(ws + WS_XC), (const float*)(ws + WS_SMP + SM_X3), p.in[I_NMLP] + D, 1, 3, 4, p.out + O_YS); }
    SEAM(12);
    if (IN(13)) REPLOOP(13) { CP& p = *kernarg_p(); Ctx c = c0; c.ws = launder(p.ws); unsigned char* ws = c.ws; (void)ws;
        pg8::Gemm g{(const bf16*)(ws + WS_A0), (const bf16*)(ws + WS_W1) + (size_t)DFF * D, MP, DFF, D, D, D, 1 << 20, D / 64, D / 64}; pg8::StaticOrder S; S.init(MP, DFF, G, blockIdx.x);
        pg8::EpiBf16<1> E{(bf16*)(ws + WS_HDN), DFF, DFF / 64};
        pg8::gemm_phase<pg8::EpiBf16<1>>(c.lds, g, S, E);
        float* hacc = (float*)(ws + WS_SMP + SM_H1); const bf16* ua = (const bf16*)(ws + WS_SMP + SM_USBF);
        if (rep_ == 0) skinny(c, [&](int r, int k) { return *(const bf16x8*)(ua + (size_t)r * D + k); }, (const bf16*)(ws + WS_W1) + (size_t)DFF * D, D, D, DFF, 4, [&](int r, int n, float v) { atomicAdd(hacc + (size_t)r * DFF + n, v); }, D / 64);
    }
    SEAM(13);
    if (IN(14)) REPLOOP(14) { CP& p = *kernarg_p(); Ctx c = c0; c.ws = launder(p.ws); unsigned char* ws = c.ws; (void)ws;
        pg8::Gemm g{(const bf16*)(ws + WS_HDN), (const bf16*)(ws + WS_W2) + (size_t)D * DFF, MP, D, DFF, DFF, DFF, 1 << 20, DFF / 64, DFF / 64}; pg8::StaticOrder S; S.init(MP, D, G, blockIdx.x);
        pg8::EpiResid<true, false> E{(const void*)(ws + WS_XC), (void*)(p.out + O_YP), D, modp(c.ws, 1, 0, 5), MODW, nullptr, nullptr};
        pg8::gemm_phase<pg8::EpiResid<true, false>>(c.lds, g, S, E);
        float* ys = p.out + O_YS; const float* hacc = (const float*)(ws + WS_SMP + SM_H1);
        if (rep_ == 0) skinny(c, [&](int r, int k) { return relu2_bf16x8(hacc + (size_t)r * DFF + k); }, (const bf16*)(ws + WS_W2) + (size_t)D * DFF, DFF, DFF, D, 16, [&](int r, int n, float v) { atomicAdd(ys + r * D + n, modp(c.ws, 1, 4 + r, 5)[n] * v); }, DFF / 64);
    }
#undef IN
#undef SEAM
}

extern "C" void kernel_launch(void* const* d_in, const int* in_sizes, int n_in, void* d_out, int out_size, void* d_ws, size_t ws_size, hipStream_t stream) {
    static int grid = 0;
    if (grid == 0) {
        if (n_in != N_IN || (size_t)out_size != O_END || ws_size < WS_END) { fprintf(stderr, "kernel_launch: shape mismatch: n_in %d (want %d), out %d (want %zu), ws %zu (want >= %zu)\n", n_in, (int)N_IN, out_size, (size_t)O_END, ws_size, (size_t)WS_END); grid = -1; return; }
        int dev = 0, cus = 0, per_cu = 0;
        if (hipGetDevice(&dev) != hipSuccess || hipDeviceGetAttribute(&cus, hipDeviceAttributeMultiprocessorCount, dev) != hipSuccess) { grid = -1; return; }
        if (hipFuncSetAttribute((const void*)mk_fwd, hipFuncAttributeMaxDynamicSharedMemorySize, LDS_BYTES) != hipSuccess) { fprintf(stderr, "kernel_launch: hipFuncSetAttribute failed\n"); grid = -1; return; }
        if (hipOccupancyMaxActiveBlocksPerMultiprocessor(&per_cu, (const void*)mk_fwd, NT, LDS_BYTES) != hipSuccess || per_cu < 1) { fprintf(stderr, "kernel_launch: occupancy query says %d blocks per CU\n", per_cu); (void)hipGetLastError(); per_cu = 1; }
        grid = cus;
        fprintf(stderr, "kernel_launch: %d CUs, occupancy query %d per CU, grid %d\n", cus, per_cu, grid);
    }
    if (grid < 0) return;
    if (hipMemsetAsync((char*)d_ws + WS_CTL, 0, WS_MOD + (size_t)2 * 12 * MODW * 4, stream) != hipSuccess) { fprintf(stderr, "kernel_launch: memset failed\n"); return; }
    P a{};
    for (int i = 0; i < N_IN; ++i) a.in[i] = (const float*)d_in[i];
    a.out = (float*)d_out; a.ws = (unsigned char*)d_ws;
#if MK_ONE_LAUNCH
    a.ph_lo = 0; a.ph_hi = NPHASE;
    { void* args[] = {&a}; hipError_t e = hipLaunchKernel((const void*)mk_fwd, dim3(grid), dim3(NT), args, LDS_BYTES, stream);
      if (e != hipSuccess) fprintf(stderr, "kernel_launch: cooperative launch failed: %s\n", hipGetErrorString(e)); }
#else
    for (int ph = 0; ph < NPHASE; ++ph) { a.ph_lo = ph; a.ph_hi = ph + 1; void* args[] = {&a};
        hipError_t e = hipLaunchCooperativeKernel((const void*)mk_fwd, dim3(grid), dim3(NT), args, LDS_BYTES, stream);
        if (e != hipSuccess) { fprintf(stderr, "kernel_launch: launch %d failed: %s\n", ph, hipGetErrorString(e)); break; } }
#endif
}
```

```cpp
#include <hip/hip_runtime.h>
#include <hip/hip_cooperative_groups.h>
#include <cstdio>
#include <cstdint>
namespace cg = cooperative_groups;

#ifndef MK_ONE_LAUNCH
#define MK_ONE_LAUNCH 1
#endif

#define LAS __attribute__((address_space(3)))
typedef unsigned short bf16;
typedef short bf16x8 __attribute__((ext_vector_type(8)));
typedef float f32x4 __attribute__((ext_vector_type(4)));
typedef float f32x2 __attribute__((ext_vector_type(2)));
typedef unsigned u32x4 __attribute__((ext_vector_type(4)));
typedef unsigned u32x2 __attribute__((ext_vector_type(2)));

constexpr int D = 2048, BATCH = 4, SEQ = 2048, MP = BATCH * SEQ, SB = 8;
constexpr int NH = 32, HP = 64, SN = 128, SG = 8, INNER = 2048, CONVD = 4096;
constexpr int AH = 24, HD = 128, HPP = 8, AQKV = 3072, AOUT = 1024;
constexpr int INC = 15392, INP = 15616;
constexpr int CZ = 0, CX = 2048, CQ = 6144, CK = 9216, CV = 12288, CDT = 15360;
constexpr int MIXK = 3072, DFF = 8192, MODW = 6 * D;
constexpr float EPS = 1e-6f;
constexpr int NWAVES = 8, NT = 512;

enum { I_XP = 0, I_XS, I_SSM, I_CONV, I_KV128, I_KV512, I_KV2048, I_POOL, I_CP, I_CS, I_RELB, I_ADAW, I_ADAB, I_NMIX, I_NMLP, I_INW, I_CONVW, I_CONVB,
       I_DTB, I_ALOG, I_DSKIP, I_SSDG, I_QG, I_KG, I_OUTW, I_POOLW, I_POOLS, I_W1, I_W2, N_IN };

constexpr size_t O_YP = 0;
constexpr size_t O_YS = O_YP + (size_t)MP * D;
constexpr size_t O_PSSM = O_YS + (size_t)SB * D;
constexpr size_t O_PCONV = O_PSSM + (size_t)BATCH * NH * HP * SN;
constexpr size_t O_PKV128 = O_PCONV + (size_t)BATCH * 3 * CONVD;
constexpr size_t O_PKV512 = O_PKV128 + (size_t)BATCH * 128 * 2048;
constexpr size_t O_PKV2048 = O_PKV512 + (size_t)BATCH * 512 * 2048;
constexpr size_t O_PPOOL = O_PKV2048 + (size_t)BATCH * 2048 * 2048;
constexpr size_t O_SSSM = O_PPOOL + (size_t)BATCH * 15 * D;
constexpr size_t O_SCONV = O_SSSM + (size_t)SB * NH * HP * SN;
constexpr size_t O_SKV128 = O_SCONV + (size_t)SB * 3 * CONVD;
constexpr size_t O_SKV512 = O_SKV128 + (size_t)SB * 128 * 2048;
constexpr size_t O_SKV2048 = O_SKV512 + (size_t)SB * 512 * 2048;
constexpr size_t O_SPOOL = O_SKV2048 + (size_t)SB * 2048 * 2048;
constexpr size_t O_END = O_SPOOL + (size_t)SB * 15 * D;

constexpr size_t MiB = 1u << 20;
constexpr size_t WS_CTL = 0;
constexpr size_t WS_MOD = 1 * MiB;
constexpr size_t WS_WIN = 4 * MiB;
constexpr size_t WS_WOUT = 66 * MiB;
constexpr size_t WS_W1 = 78 * MiB;
constexpr size_t WS_W2 = 142 * MiB;
constexpr size_t WS_WPOOL = 206 * MiB;
constexpr size_t WS_A0 = 208 * MiB;
constexpr size_t WS_SMP = 240 * MiB;
constexpr size_t WS_PROJ = 244 * MiB;
constexpr size_t WS_HDN = WS_PROJ;
constexpr size_t WS_U = WS_PROJ + 128 * MiB;
constexpr size_t WS_XC = 488 * MiB;
constexpr size_t WS_Y = 552 * MiB;
constexpr size_t WS_ATT = 616 * MiB;
constexpr size_t WS_LSE = 664 * MiB;
constexpr size_t WS_DT = 665 * MiB;
constexpr size_t WS_A1 = 668 * MiB;
constexpr size_t WS_END = 716 * MiB;
constexpr size_t SM_USBF = 0;
constexpr size_t SM_PROJ = 64 * 1024;
constexpr size_t SM_XC = 576 * 1024;
constexpr size_t SM_DT = 704 * 1024;
constexpr size_t SM_QK = 708 * 1024;
constexpr size_t SM_Y = 900 * 1024;
constexpr size_t SM_ATT = 964 * 1024;
constexpr size_t SM_LSE = 1060 * 1024;
constexpr size_t SM_A1BF = 1064 * 1024;
constexpr size_t SM_X1 = 1112 * 1024;
constexpr size_t SM_HBF = 1176 * 1024;
constexpr size_t SM_X2 = 1304 * 1024;
constexpr size_t SM_PGBF = 1368 * 1024;
constexpr size_t SM_X3 = 1400 * 1024;
constexpr size_t SM_H0 = 1500 * 1024;
constexpr size_t SM_H1 = 1756 * 1024;
constexpr size_t WS_RS = 667 * MiB;

constexpr int LDS_BYTES = 147456;

struct P { const float* in[N_IN]; float* out; unsigned char* ws; int ph_lo, ph_hi; };
static_assert(sizeof(P) == 8 * (N_IN + 2) + 8, "no padding in P");
typedef const __attribute__((address_space(4))) P CP;

__device__ __forceinline__ float bf2f(unsigned b) { return __uint_as_float(b << 16); }
__device__ __forceinline__ unsigned f2bf(float f) { unsigned u = __float_as_uint(f); return (u + 0x7fffu + ((u >> 16) & 1u)) >> 16; }
typedef float f32x2v_ __attribute__((ext_vector_type(2)));
typedef __bf16 bf16x2v_ __attribute__((ext_vector_type(2)));
__device__ __forceinline__ unsigned pk2(float lo, float hi) { const f32x2v_ v = {lo, hi}; return __builtin_bit_cast(unsigned, __builtin_convertvector(v, bf16x2v_)); }
__device__ __forceinline__ float wave_sum(float v) {
#pragma unroll
    for (int o = 1; o < 64; o <<= 1) v += __shfl_xor(v, o);
    return v;
}
__device__ __forceinline__ float wave_max(float v) {
#pragma unroll
    for (int o = 1; o < 64; o <<= 1) v = fmaxf(v, __shfl_xor(v, o));
    return v;
}
__device__ __forceinline__ float siluf(float x) { return x * __builtin_amdgcn_rcpf(1.f + __expf(-x)); }
__device__ __forceinline__ float softplusf(float x) { return log1pf(__expf(-fabsf(x))) + fmaxf(x, 0.f); }
#define LDS_WAIT() asm volatile("s_waitcnt lgkmcnt(0)" ::: "memory")

namespace pg8 {
constexpr int BM = 256, BK = 64, HALF = 128, HTB = HALF * BK * 2, STAGE_BYTES = 8 * HTB, NXCD = 8, WGM = 4;
__host__ __device__ __forceinline__ int lds_byte(int r, int c) { const int st = (r >> 4) * 2 + (c >> 5), rr = r & 15, cc = c & 31, ob = rr * 64 + cc * 2; return st * 1024 + (ob ^ (((ob >> 9) & 1) << 5)); }
__host__ __device__ __forceinline__ void stage_rc(int b, int& R, int& C) { const int st = b / 1024, sb = b % 1024, swz = sb ^ (((sb >> 9) & 1) << 5); R = (st >> 1) * 16 + swz / 64; C = (st & 1) * 32 + (swz % 64) / 2; }
__host__ __device__ __forceinline__ int perm32(int rho) { const int n = rho >> 4, i = rho & 15; return 8 * (i >> 2) + 4 * n + (i & 3); }
struct Unit { int pm, pn; };
struct Gemm { const bf16* A; const bf16* Bt; int M, N, K, lda, ldb, agrp; int akt = 0, bkt = 0; };
struct StaticOrder {
    int nM, nN, nwg, G, c;
    __device__ void init(int M, int N, int G_, int c_) { nM = M / BM; nN = N / BM; nwg = nM * nN; G = G_; c = c_; }
    __device__ bool next(int i, Unit& u) const {
        const long L = (long)i * G + c; if (L >= nwg) return false;
        int wgid = (int)L; { const int q = nwg / NXCD, r = nwg % NXCD, xcd = wgid % NXCD, off = wgid / NXCD; wgid = (xcd < r ? xcd * (q + 1) : r * (q + 1) + (xcd - r) * q) + off; }
        const int nig = WGM * nN, gid = wgid / nig, fm = gid * WGM, gsz = (nM - fm) < WGM ? (nM - fm) : WGM;
        u.pm = fm + ((wgid % nig) % gsz); u.pn = (wgid % nig) / gsz;
        { const int rot = gid * (nN / NXCD); u.pn = (u.pn + rot) % nN; }
        return true;
    }
    static constexpr bool DYN = false;
};
struct DynOrder {
    int nM, nN, nwg, G, c; unsigned* cnt; volatile LAS int* slot;
    __device__ void init(int M, int N, int G_, int c_, unsigned* cnt_, volatile LAS int* slot_) { nM = M / BM; nN = N / BM; nwg = nM * nN; G = G_; c = c_; cnt = cnt_ + (c_ % NXCD) * 32; slot = slot_; }
    __device__ bool at(int off, Unit& u) const {
        const int q = nwg / NXCD; if (off >= q) return false;
        const int wgid = (c % NXCD) * q + off;
        const int nig = WGM * nN, gid = wgid / nig, fm = gid * WGM, gsz = (nM - fm) < WGM ? (nM - fm) : WGM;
        u.pm = fm + ((wgid % nig) % gsz); u.pn = (wgid % nig) / gsz;
        { const int rot = gid * (nN / NXCD); u.pn = (u.pn + rot) % nN; }
        return true;
    }
    static constexpr bool DYN = true;
};
__device__ __forceinline__ unsigned cvt_pk_bf16(float lo, float hi) { unsigned r; asm volatile("v_cvt_pk_bf16_f32 %0, %1, %2" : "=v"(r) : "v"(lo), "v"(hi)); return r; }

template <int ACT  > struct EpiBf16 {
    static constexpr bool PERM = true;
    bf16* O; int ldc; int okt;
    __device__ __forceinline__ void operator()(const f32x4 (&acc)[2][2][4][2], const Unit& u, int wr, int wc, int fr, int fq) const {
        const int row0 = u.pm * BM + wr * 64 + fr; const int col0 = u.pn * BM + wc * 32 + 8 * fq;
#pragma unroll
        for (int ai = 0; ai < 2; ++ai)
#pragma unroll
            for (int m = 0; m < 4; ++m) { const int rrow = row0 + ai * HALF + m * 16; bf16* rowp = okt ? O + ((size_t)(rrow >> 8) * okt + (col0 >> 6)) * 16384 + (rrow & 255) * 64 + (col0 & 63) : O + (size_t)rrow * ldc + col0;
#pragma unroll
                for (int bj = 0; bj < 2; ++bj) { f32x4 v0 = acc[ai][bj][m][0], v1 = acc[ai][bj][m][1];
                    if (ACT == 1) {
#pragma unroll
                        for (int j = 0; j < 4; ++j) { const float a = fmaxf(v0[j], 0.f), b = fmaxf(v1[j], 0.f); v0[j] = a * a; v1[j] = b * b; } }
                    u32x4 w; w.x = cvt_pk_bf16(v0[0], v0[1]); w.y = cvt_pk_bf16(v0[2], v0[3]); w.z = cvt_pk_bf16(v1[0], v1[1]); w.w = cvt_pk_bf16(v1[2], v1[3]);
                    *(u32x4*)(rowp + (okt ? bj * 2 * 16384 : bj * HALF)) = w; } }
    }
};
template <bool BIN  , bool BOUT  > struct EpiResid {
    static constexpr bool PERM = true;
    const void* base; void* out; int ldc; const float* gate; int gate_bstride; const float* cscale; float* rowss;
    __device__ __forceinline__ void operator()(const f32x4 (&acc)[2][2][4][2], const Unit& u, int wr, int wc, int fr, int fq) const {
        const int row0 = u.pm * BM + wr * 64 + fr, col0 = u.pn * BM + wc * 32 + 8 * fq;
        const float* gp = gate + (size_t)(u.pm / 8) * gate_bstride;
        f32x4 gv[2][2];
#pragma unroll
        for (int bj = 0; bj < 2; ++bj)
#pragma unroll
            for (int n = 0; n < 2; ++n) { gv[bj][n] = *(const f32x4*)(gp + col0 + bj * HALF + 4 * n); if (cscale) gv[bj][n] = gv[bj][n] * *(const f32x4*)(cscale + col0 + bj * HALF + 4 * n); }
#pragma unroll
        for (int ai = 0; ai < 2; ++ai)
#pragma unroll
            for (int m = 0; m < 4; ++m) { const size_t off = (size_t)(row0 + ai * HALF + m * 16) * ldc + col0; float ssq = 0.f;
#pragma unroll
                for (int bj = 0; bj < 2; ++bj) { f32x4 b0, b1;
                    if (BIN) { const u32x4 x = *(const u32x4*)((const bf16*)base + off + bj * HALF);
                        b0 = (f32x4){__uint_as_float(x.x << 16), __uint_as_float(x.x & 0xffff0000u), __uint_as_float(x.y << 16), __uint_as_float(x.y & 0xffff0000u)};
                        b1 = (f32x4){__uint_as_float(x.z << 16), __uint_as_float(x.z & 0xffff0000u), __uint_as_float(x.w << 16), __uint_as_float(x.w & 0xffff0000u)}; }
                    else { b0 = *(const f32x4*)((const float*)base + off + bj * HALF); b1 = *(const f32x4*)((const float*)base + off + bj * HALF + 4); }
                    const f32x4 o0 = b0 + gv[bj][0] * acc[ai][bj][m][0], o1 = b1 + gv[bj][1] * acc[ai][bj][m][1];
                    if (BOUT) { u32x4 w; w.x = cvt_pk_bf16(o0[0], o0[1]); w.y = cvt_pk_bf16(o0[2], o0[3]); w.z = cvt_pk_bf16(o1[0], o1[1]); w.w = cvt_pk_bf16(o1[2], o1[3]); *(u32x4*)((bf16*)out + off + bj * HALF) = w; }
                    else { *(f32x4*)((float*)out + off + bj * HALF) = o0; *(f32x4*)((float*)out + off + bj * HALF + 4) = o1; }
                    ssq += (o0.x * o0.x + o0.y * o0.y) + (o0.z * o0.z + o0.w * o0.w) + (o1.x * o1.x + o1.y * o1.y) + (o1.z * o1.z + o1.w * o1.w); }
                if (rowss) { ssq += __shfl_xor(ssq, 16); ssq += __shfl_xor(ssq, 32); if (fq == 0) atomicAdd(rowss + row0 + ai * HALF + m * 16, ssq); } }
    }
};


struct EpiProj {
    static constexpr bool PERM = true;
    bf16* O; float* dtout; float* out; const float* qg; const float* kg; const float* dtb; LAS float* xch;
    __device__ __forceinline__ void operator()(const f32x4 (&acc)[2][2][4][2], const Unit& u, int wr, int wc, int fr, int fq) const {
        const int rt0 = wr * 64 + fr;
        const int row0 = u.pm * BM + rt0, colt = u.pn * BM, cw8 = wc * 32 + 8 * fq;
        const int b = u.pm >> 3, tb = (u.pm & 7) * BM;
        if (u.pn == 60) {
            if (wc == 0) { const f32x4 b0 = *(const f32x4*)(dtb + 8 * fq), b1 = *(const f32x4*)(dtb + 8 * fq + 4);
#pragma unroll
                for (int ai = 0; ai < 2; ++ai)
#pragma unroll
                    for (int m = 0; m < 4; ++m) { float* d = dtout + (size_t)(row0 + ai * HALF + m * 16) * 32 + 8 * fq; const f32x4 v0 = acc[ai][0][m][0] + b0, v1 = acc[ai][0][m][1] + b1;
                        *(f32x4*)d = (f32x4){softplusf(v0.x), softplusf(v0.y), softplusf(v0.z), softplusf(v0.w)}; *(f32x4*)(d + 4) = (f32x4){softplusf(v1.x), softplusf(v1.y), softplusf(v1.z), softplusf(v1.w)}; } }
            return;
        }
        const bool isq = u.pn >= 24 && u.pn < 36, isk = u.pn >= 36 && u.pn < 48, isv = u.pn >= 48, isx = u.pn >= 8 && u.pn < 24;
        float scl[2][4][2];
        f32x4 g0 = (f32x4){1.f, 1.f, 1.f, 1.f}, g1 = g0;
        if (isq || isk) {
#pragma unroll
            for (int ai = 0; ai < 2; ++ai)
#pragma unroll
                for (int m = 0; m < 4; ++m)
#pragma unroll
                    for (int bj = 0; bj < 2; ++bj) { const f32x4 a = acc[ai][bj][m][0], c2 = acc[ai][bj][m][1];
                        float ssq = (a.x * a.x + a.y * a.y) + (a.z * a.z + a.w * a.w) + (c2.x * c2.x + c2.y * c2.y) + (c2.z * c2.z + c2.w * c2.w);
                        ssq += __shfl_xor(ssq, 16); ssq += __shfl_xor(ssq, 32);
                        if (fq == 0) xch[((ai * HALF + rt0 + m * 16) * 2 + bj) * 4 + wc] = ssq; }
            asm volatile("s_waitcnt lgkmcnt(0)" ::: "memory"); __builtin_amdgcn_s_barrier(); asm volatile("" ::: "memory");
#pragma unroll
            for (int ai = 0; ai < 2; ++ai)
#pragma unroll
                for (int m = 0; m < 4; ++m)
#pragma unroll
                    for (int bj = 0; bj < 2; ++bj) { const f32x4 pz = *(const LAS f32x4*)(xch + ((ai * HALF + rt0 + m * 16) * 2 + bj) * 4);
                        scl[ai][m][bj] = rsqrtf(((pz.x + pz.y) + (pz.z + pz.w)) * (1.f / 128.f) + 1e-6f); }
            const float* gp = (isq ? qg : kg) + cw8; g0 = *(const f32x4*)gp; g1 = *(const f32x4*)(gp + 4);
        } else {
#pragma unroll
            for (int ai = 0; ai < 2; ++ai)
#pragma unroll
                for (int m = 0; m < 4; ++m) { scl[ai][m][0] = 1.f; scl[ai][m][1] = 1.f; }
        }
#pragma unroll
        for (int ai = 0; ai < 2; ++ai)
#pragma unroll
            for (int m = 0; m < 4; ++m) { const int rr = ai * HALF + m * 16; bf16* rowp = O + (size_t)(row0 + rr) * ldo() + colt + cw8; const int t = tb + rt0 + rr;
#pragma unroll
                for (int bj = 0; bj < 2; ++bj) { const f32x4 v0 = acc[ai][bj][m][0] * scl[ai][m][bj] * g0, v1 = acc[ai][bj][m][1] * scl[ai][m][bj] * g1;
                    u32x4 w; w.x = cvt_pk_bf16(v0[0], v0[1]); w.y = cvt_pk_bf16(v0[2], v0[3]); w.z = cvt_pk_bf16(v1[0], v1[1]); w.w = cvt_pk_bf16(v1[2], v1[3]);
                    *(u32x4*)(rowp + bj * HALF) = w;
                    if (isk || isv) { const int hd = (u.pn - (isk ? 36 : 48)) * 2 + bj, gi = hd >> 3, slot = hd & 7, W = gi == 0 ? 128 : (gi == 1 ? 512 : 2048);
                        if (t >= 2048 - W) { float* o = out + (gi == 0 ? O_PKV128 : (gi == 1 ? O_PKV512 : O_PKV2048)) + (((size_t)b * W + (t - (2048 - W))) * 2 + (isv ? 1 : 0)) * 1024 + slot * 128 + cw8;
                            *(f32x4*)o = v0; *(f32x4*)(o + 4) = v1; } }
                    if (isx && t >= 2045) { float* o = out + O_PCONV + ((size_t)b * 3 + (t - 2045)) * 4096 + (colt - 2048) + bj * HALF + cw8; *(f32x4*)o = v0; *(f32x4*)(o + 4) = v1; } } }
    }
    __device__ __forceinline__ static constexpr int ldo() { return 15616; }
};

struct NoHook { static constexpr int T = -1; __device__ __forceinline__ void operator()(f32x4 (&)[2][2][4][2], const Unit&, int, int) const {} };
struct RowScaleHook { static constexpr int T = 32; const float* ss;
    __device__ __forceinline__ void operator()(f32x4 (&acc)[2][2][4][2], const Unit& u, int wr, int fr) const {
#pragma unroll
        for (int ai = 0; ai < 2; ++ai)
#pragma unroll
            for (int m = 0; m < 4; ++m) { const float rs = rsqrtf(ss[u.pm * BM + ai * HALF + wr * 64 + m * 16 + fr] * (1.f / 2048.f) + 1e-6f);
#pragma unroll
                for (int bj = 0; bj < 2; ++bj)
#pragma unroll
                    for (int n = 0; n < 2; ++n) acc[ai][bj][m][n] = acc[ai][bj][m][n] * rs; } } };
template <class Epi, bool ALIGN_EPI = true, class Hook = NoHook, class Order = StaticOrder>
__device__ __forceinline__ void gemm_phase(LAS unsigned char* lds, const Gemm g, const Order& S, const Epi& E, const Hook& H = Hook(), unsigned long long* clkq = nullptr) {
#ifdef CLKSEL
    volatile LAS unsigned* clk_w = (volatile LAS unsigned*)(lds + 147456 - 8);
#define CLK_SET() do { if (clkq && tid == 0) clk_w[0] = (unsigned)__builtin_readcyclecounter(); } while (0)
#define CLK_ACC() do { if (clkq && tid == 0) clk_w[1] = clk_w[1] + ((unsigned)__builtin_readcyclecounter() - clk_w[0]); } while (0)
#endif
    const int tid = threadIdx.x, wid = __builtin_amdgcn_readfirstlane(tid >> 6), lane = tid & 63, wr = wid >> 2, wc = wid & 3, fr = lane & 15, fq = lane >> 4;
    const int K = g.K, nt = K / BK;
    unsigned voffA[2], voffB[2];
#pragma unroll
    for (int i = 0; i < 2; ++i) { int R, C; stage_rc(tid * 16 + i * 8192, R, C); const int Rb = Epi::PERM ? ((R & ~31) + perm32(R & 31)) : R;
        voffA[i] = (unsigned)(R * (g.akt ? 64 : g.lda) + C) * 2u; voffB[i] = (unsigned)(Rb * (g.bkt ? 64 : g.ldb) + C) * 2u; }
    const size_t kstepA = g.akt ? (size_t)32768 : (size_t)(BK * 2), kstepB = g.bkt ? (size_t)32768 : (size_t)(BK * 2);
    const size_t hstepA = (size_t)HALF * (g.akt ? 64 : g.lda) * 2, hstepB = (size_t)HALF * (g.bkt ? 64 : g.ldb) * 2;
    const size_t tstepA = g.akt ? (size_t)g.akt * 32768 : 2 * hstepA, tstepB = g.bkt ? (size_t)g.bkt * 32768 : 2 * hstepB;
    const unsigned ldsw = (unsigned)wid * 1024u;
    const int aoff = lds_byte(wr * 64 + fr, fq * 8), boff = lds_byte(wc * 32 + fr, fq * 8);
#define PG8_SA(b, h) (((b) * 2 + (h)) * HTB)
#define PG8_SB(b, h) ((4 + (b) * 2 + (h)) * HTB)
#define PG8_STAGE(bufoff, gbase, voff) do { _Pragma("unroll") for (int _i = 0; _i < 2; ++_i) \
        __builtin_amdgcn_global_load_lds((const unsigned*)((const char*)(gbase) + (voff)[_i]), (LAS unsigned*)(lds + (bufoff) + ldsw + _i * 8192), 16, 0, 0); } while (0)
#define PG8_LDA(dst, b, h) do { _Pragma("unroll") for (int m = 0; m < 4; ++m) _Pragma("unroll") for (int k = 0; k < 2; ++k) dst[m][k] = *(const LAS bf16x8*)(lds + PG8_SA(b, h) + aoff + m * 2048 + k * 1024); } while (0)
#define PG8_LDB(dst, b, h) do { _Pragma("unroll") for (int n = 0; n < 2; ++n) _Pragma("unroll") for (int k = 0; k < 2; ++k) dst[n][k] = *(const LAS bf16x8*)(lds + PG8_SB(b, h) + boff + n * 2048 + k * 1024); } while (0)
#define PG8_MMA(ai, bj, At, Bt) do { __builtin_amdgcn_s_setprio(1); _Pragma("unroll") for (int m = 0; m < 4; ++m) _Pragma("unroll") for (int n = 0; n < 2; ++n) _Pragma("unroll") for (int k = 0; k < 2; ++k) \
        acc[ai][bj][m][n] = __builtin_amdgcn_mfma_f32_16x16x32_bf16(Bt[n][k], At[m][k], acc[ai][bj][m][n], 0, 0, 0); __builtin_amdgcn_s_setprio(0); } while (0)
#define PG8_WAIT_V(n) asm volatile("s_waitcnt vmcnt(" #n ")" ::: "memory")
#define PG8_WAIT_L(n) asm volatile("s_waitcnt lgkmcnt(" #n ")" ::: "memory")
#define PG8_BAR __builtin_amdgcn_s_barrier()
#define PG8_SCHED __builtin_amdgcn_sched_barrier(0)
    Unit cur, nxt; int ui = 0; int off_nxt = 0; unsigned fv = 0u;
    if constexpr (Order::DYN) {
        if (tid == 0) { const unsigned o0 = __hip_atomic_fetch_add(S.cnt, 1u, __ATOMIC_RELAXED, __HIP_MEMORY_SCOPE_AGENT); S.slot[0] = (int)o0; }
        __syncthreads();
        const int off_cur = __builtin_amdgcn_readfirstlane(S.slot[0]);
        if (!S.at(off_cur, cur)) return;
    } else { if (!S.next(0, cur)) return; }
    f32x4 acc[2][2][4][2];
#pragma unroll
    for (int a = 0; a < 2; ++a)
#pragma unroll
        for (int b = 0; b < 2; ++b)
#pragma unroll
            for (int m = 0; m < 4; ++m)
#pragma unroll
                for (int n = 0; n < 2; ++n) acc[a][b][m][n] = (f32x4){0.f, 0.f, 0.f, 0.f};
    bf16x8 At[4][2], B0[2][2], B1[2][2];
    const char* cA = (const char*)g.A + (size_t)cur.pm * tstepA + (size_t)(cur.pn / g.agrp) * (K / BK) * kstepA; const char* cB = (const char*)g.Bt + (size_t)cur.pn * tstepB;
    PG8_STAGE(PG8_SB(0, 0), cB, voffB); PG8_STAGE(PG8_SB(0, 1), cB + hstepB, voffB); PG8_STAGE(PG8_SA(0, 0), cA, voffA); PG8_STAGE(PG8_SA(0, 1), cA + hstepA, voffA);
    if (wr == 1) PG8_BAR;
    PG8_WAIT_V(2); PG8_BAR;
    PG8_STAGE(PG8_SB(1, 0), cB + kstepB, voffB); PG8_STAGE(PG8_SA(1, 0), cA + kstepA, voffA); PG8_STAGE(PG8_SB(1, 1), cB + hstepB + kstepB, voffB);
    PG8_WAIT_V(6); PG8_BAR;
    for (;;) {
#ifdef CLKSEL
        if (CLKSEL == 1) CLK_SET();
#endif
        bool has_next = false; const char* nA = cA; const char* nB = cB;
        if constexpr (Order::DYN) {
            if (tid == 0) { const unsigned one = 1u; asm volatile("global_atomic_add %0, %1, %2, off sc0 sc1" : "=v"(fv) : "v"(S.cnt), "v"(one) : "memory"); }
        } else { has_next = S.next(ui + 1, nxt);
            if (has_next) { nA = (const char*)g.A + (size_t)nxt.pm * tstepA + (size_t)(nxt.pn / g.agrp) * (K / BK) * kstepA; nB = (const char*)g.Bt + (size_t)nxt.pn * tstepB; } }
        for (int t = 0; t < nt; t += 2) {
            const bool last = (t == nt - 2);
            if constexpr (Order::DYN) {
                if (t == nt - 6) { if (tid == 0) S.slot[0] = (int)fv; }
                if (t == nt - 4) { off_nxt = __builtin_amdgcn_readfirstlane(S.slot[0]); has_next = S.at(off_nxt, nxt);
                    if (has_next) { nA = (const char*)g.A + (size_t)nxt.pm * tstepA + (size_t)(nxt.pn / g.agrp) * (K / BK) * kstepA; nB = (const char*)g.Bt + (size_t)nxt.pn * tstepB; } } }
            if constexpr (Hook::T >= 0) { if (t == Hook::T) H(acc, cur, wr, fr); }
            const char* a1 = cA + (size_t)(t + 1) * kstepA;
            const char* a2 = last ? nA : cA + (size_t)(t + 2) * kstepA; const char* b2 = last ? nB : cB + (size_t)(t + 2) * kstepB;
            const char* a3 = a2 + kstepA; const char* b3 = b2 + kstepB;
            PG8_LDB(B0, 0, 0); PG8_LDB(B1, 0, 1); PG8_SCHED; PG8_LDA(At, 0, 0); PG8_STAGE(PG8_SA(1, 1), a1 + hstepA, voffA);
            PG8_WAIT_V(8); PG8_WAIT_L(0); PG8_BAR; PG8_MMA(0, 0, At, B0); PG8_MMA(0, 1, At, B1); PG8_BAR; PG8_SCHED;
            PG8_LDA(At, 0, 1); PG8_STAGE(PG8_SB(0, 0), b2, voffB); PG8_STAGE(PG8_SB(0, 1), b2 + hstepB, voffB); PG8_STAGE(PG8_SA(0, 0), a2, voffA);
            PG8_WAIT_V(8); PG8_WAIT_L(0); PG8_BAR; PG8_MMA(1, 0, At, B0); PG8_MMA(1, 1, At, B1); PG8_BAR; PG8_SCHED;
            PG8_LDB(B0, 1, 0); PG8_LDB(B1, 1, 1); PG8_SCHED; PG8_LDA(At, 1, 0); PG8_STAGE(PG8_SA(0, 1), a2 + hstepA, voffA);
            PG8_WAIT_V(8); PG8_WAIT_L(0); PG8_BAR; PG8_MMA(0, 0, At, B0); PG8_MMA(0, 1, At, B1); PG8_BAR; PG8_SCHED;
            PG8_LDA(At, 1, 1); PG8_STAGE(PG8_SB(1, 0), b3, voffB); PG8_STAGE(PG8_SB(1, 1), b3 + hstepB, voffB); PG8_STAGE(PG8_SA(1, 0), a3, voffA);
            PG8_WAIT_V(8); PG8_WAIT_L(0); PG8_BAR; PG8_MMA(1, 0, At, B0); PG8_MMA(1, 1, At, B1); PG8_BAR; PG8_SCHED;
#ifdef CLKSEL
            if (t == 0) { if (CLKSEL == 1) CLK_ACC(); if (CLKSEL == 0) CLK_SET(); }
#endif
        }
#ifdef CLKSEL
        if (CLKSEL == 0) CLK_ACC(); if (CLKSEL == 2) CLK_SET();
#endif
        if constexpr (ALIGN_EPI) { if (wr == 0) PG8_BAR; }
        E(acc, cur, wr, wc, fr, fq);
#ifdef CLKSEL
        if (CLKSEL == 2) CLK_ACC();
#endif
        if (!has_next) break;
#pragma unroll
        for (int a = 0; a < 2; ++a)
#pragma unroll
            for (int b = 0; b < 2; ++b)
#pragma unroll
                for (int m = 0; m < 4; ++m)
#pragma unroll
                    for (int n = 0; n < 2; ++n) acc[a][b][m][n] = (f32x4){0.f, 0.f, 0.f, 0.f};
        cur = nxt; cA = nA; cB = nB; ++ui;
        if constexpr (ALIGN_EPI) { if (wr == 1) PG8_BAR; }
    }
    PG8_WAIT_V(0);
    if constexpr (!ALIGN_EPI) { if (wr == 0) PG8_BAR; }
    PG8_BAR;
#ifdef CLKSEL
    if (clkq && blockIdx.x == 0 && tid == 0) { clkq[0] = clk_w[1]; }
#endif
#undef PG8_SA
#undef PG8_SB
#undef PG8_STAGE
#undef PG8_LDA
#undef PG8_LDB
#undef PG8_MMA
#undef PG8_WAIT_V
#undef PG8_WAIT_L
#undef PG8_BAR
#undef PG8_SCHED
}
}


#define XB_TMO      128
#define XB_XCNT(j)  (256  + 64 * (j))
#define XB_XSUB(j)  (1280 + 64 * (j))
#define XB_XGEN(j)  (2304 + 64 * (j))
#define XB_TOP      3328
#define XB_TOPGEN   3392
#define XCD_BAR_WORDS 3456
#define XB_SPIN_CAP (1u << 18)
__device__ __forceinline__ unsigned xb_ld(unsigned* p)              { return __hip_atomic_load(p, __ATOMIC_RELAXED, __HIP_MEMORY_SCOPE_AGENT); }
__device__ __forceinline__ unsigned xb_add(unsigned* p, unsigned v) { return __hip_atomic_fetch_add(p, v, __ATOMIC_RELAXED, __HIP_MEMORY_SCOPE_AGENT); }
__device__ __forceinline__ unsigned xb_xcc_id() { return (unsigned)__builtin_amdgcn_s_getreg((3 << 11) | 20) & 0xFu; }
#define XB_SPIN(cond, bar) do { unsigned _sp = 0; while (cond) { __builtin_amdgcn_s_sleep(1); \
    if ((++_sp & 255u) == 0u) { if (xb_ld(&(bar)[XB_TMO])) break; if (_sp > XB_SPIN_CAP) { atomicAdd(&(bar)[XB_TMO], 1u); break; } } } } while (0)
struct XcdBarrier { unsigned* bar; unsigned x; volatile LAS unsigned* st; };
__device__ __forceinline__ XcdBarrier xcd_barrier_post(unsigned* bar, volatile LAS unsigned* st) {
    XcdBarrier b; b.bar = bar; b.x = xb_xcc_id(); b.st = st;
    if (threadIdx.x == 0) (void)xb_add(&bar[XB_XCNT(b.x)], 1u);
    return b;
}
__device__ __forceinline__ void xcd_barrier_complete(unsigned* bar, unsigned x, unsigned& nloc, unsigned& nx) {
    const unsigned G = gridDim.x * gridDim.y * gridDim.z;
    unsigned sum, cnt, mine, sp = 0u;
    for (;;) {
        sum = 0u; cnt = 0u; mine = 0u;
#pragma unroll
        for (unsigned j = 0; j < 16; ++j) { const unsigned c = xb_ld(&bar[XB_XCNT(j)]); sum += c; cnt += (c > 0u) ? 1u : 0u; mine = (j == x) ? c : mine; }
        if (sum == G) break;
        __builtin_amdgcn_s_sleep(1);
        if ((++sp & 255u) == 0u) { if (xb_ld(&bar[XB_TMO])) break; if (sp > XB_SPIN_CAP) { atomicAdd(&bar[XB_TMO], 1u); break; } }
    }
    nloc = mine > 0u ? mine : 1u; nx = cnt > 0u ? cnt : 1u;
}
__device__ __forceinline__ void xcd_barrier(const XcdBarrier& b) {
    asm volatile("s_waitcnt vmcnt(0)" ::: "memory");
    __syncthreads();
    if (threadIdx.x == 0) {
        unsigned* bar = b.bar;
        __builtin_amdgcn_s_waitcnt(0);
        unsigned nloc = b.st[0], nx = b.st[1];
        if (nloc == 0u) { xcd_barrier_complete(bar, b.x, nloc, nx); b.st[0] = nloc; b.st[1] = nx; }
        const unsigned old = xb_add(&bar[XB_XSUB(b.x)], 1u);
        const unsigned gen = old / nloc;
        if (old + 1u == (gen + 1u) * nloc) {
            __builtin_amdgcn_fence(__ATOMIC_RELEASE, "agent");
            asm volatile("s_waitcnt vmcnt(0)" ::: "memory");
            const unsigned og = xb_add(&bar[XB_TOP], 1u);
            const unsigned tg = og / nx;
            if (og + 1u == (tg + 1u) * nx) xb_add(&bar[XB_TOPGEN], 1u);
            else XB_SPIN(xb_ld(&bar[XB_TOPGEN]) == tg, bar);
            __builtin_amdgcn_fence(__ATOMIC_ACQUIRE, "agent");
            xb_add(&bar[XB_XGEN(b.x)], 1u);
            asm volatile("s_waitcnt vmcnt(0)" ::: "memory");
        } else {
            XB_SPIN(xb_ld(&bar[XB_XGEN(b.x)]) == gen, bar);
            __builtin_amdgcn_fence(__ATOMIC_ACQUIRE, "agent");
            asm volatile("s_waitcnt vmcnt(0)" ::: "memory");
        }
    }
    __syncthreads();
}

struct Ctx { int tid, lane, wave, gw, ngw; LAS unsigned char* lds; unsigned char* ws; };

template <class LA, class F> __device__ __forceinline__ void skinny(const Ctx& c, LA&& aload, const bf16* WT, int ldb, int K, int N, int KS, F&& epi, int bkt = 0) {
    const int lane = c.lane, ncg = N / 16, kl = K / KS;
    for (int it = c.gw; it < ncg * KS; it += c.ngw) {
        const int cg = it % ncg, kb = (it / ncg) * kl;
        f32x4 acc = (f32x4){0.f, 0.f, 0.f, 0.f};
        const int nn = cg * 16 + (lane & 15);
        const bf16* bp = bkt ? WT + ((size_t)(nn >> 8) * bkt + (kb >> 6)) * 16384 + (nn & 255) * 64 + 8 * (lane >> 4) : WT + (size_t)nn * ldb + kb + 8 * (lane >> 4);
#pragma unroll 8
        for (int k0 = 0; k0 < kl; k0 += 32) { const bf16x8 av = aload(lane & 7, kb + k0 + 8 * (lane >> 4)), bv = *(const bf16x8*)(bp + (bkt ? (k0 >> 6) * 16384 + (k0 & 63) : k0)); acc = __builtin_amdgcn_mfma_f32_16x16x32_bf16(av, bv, acc, 0, 0, 0); }
        if ((lane >> 4) < 2) {
#pragma unroll
            for (int j = 0; j < 4; ++j) epi((lane >> 4) * 4 + j, cg * 16 + (lane & 15), acc[j]);
        }
    }
}
__device__ __forceinline__ bf16x8 relu2_bf16x8(const float* q) { const f32x4 a = *(const f32x4*)q, b = *(const f32x4*)(q + 4);
    u32x4 w; float t0, t1;
    t0 = fmaxf(a.x, 0.f); t1 = fmaxf(a.y, 0.f); w.x = pk2(t0 * t0, t1 * t1); t0 = fmaxf(a.z, 0.f); t1 = fmaxf(a.w, 0.f); w.y = pk2(t0 * t0, t1 * t1);
    t0 = fmaxf(b.x, 0.f); t1 = fmaxf(b.y, 0.f); w.z = pk2(t0 * t0, t1 * t1); t0 = fmaxf(b.z, 0.f); t1 = fmaxf(b.w, 0.f); w.w = pk2(t0 * t0, t1 * t1);
    return __builtin_bit_cast(bf16x8, w); }

__device__ __forceinline__ void load_row(const float* row, f32x4 (&v)[8], int lane) {
#pragma unroll
    for (int j = 0; j < 8; ++j) v[j] = ((const f32x4*)row)[lane + 64 * j];
}
__device__ __forceinline__ void load_row_bf16(const bf16* row, f32x4 (&v)[8], int lane) {
#pragma unroll
    for (int j = 0; j < 8; ++j) { const u32x2 x = ((const u32x2*)row)[lane + 64 * j]; v[j] = (f32x4){__uint_as_float(x.x << 16), __uint_as_float(x.x & 0xffff0000u), __uint_as_float(x.y << 16), __uint_as_float(x.y & 0xffff0000u)}; }
}
__device__ __forceinline__ float row_rs(const f32x4 (&v)[8]) {
    float s = 0.f;
#pragma unroll
    for (int j = 0; j < 8; ++j) s += (v[j].x * v[j].x + v[j].y * v[j].y) + (v[j].z * v[j].z + v[j].w * v[j].w);
    return rsqrtf(wave_sum(s) * (1.f / D) + EPS);
}
__device__ __forceinline__ void normmod(f32x4 (&v)[8], const float* g, const float* sc, const float* sh, int lane) {
    const float rs = row_rs(v);
#pragma unroll
    for (int j = 0; j < 8; ++j) { const int c = 4 * (lane + 64 * j); const f32x4 gg = *(const f32x4*)(g + c), s1 = *(const f32x4*)(sc + c), s0 = *(const f32x4*)(sh + c);
        v[j] = v[j] * rs * gg * (s1 + 1.f) + s0; }
}
__device__ __forceinline__ void store_row_bf16(bf16* row, const f32x4 (&v)[8], int lane) {
#pragma unroll
    for (int j = 0; j < 8; ++j) { u32x2 w; w.x = pk2(v[j].x, v[j].y); w.y = pk2(v[j].z, v[j].w); ((u32x2*)row)[lane + 64 * j] = w; }
}
__device__ __forceinline__ void store_row_bf16_tiled(bf16* base, int m, const f32x4 (&v)[8], int lane) {
#pragma unroll
    for (int j = 0; j < 8; ++j) { const int col = 4 * (lane + 64 * j); u32x2 w; w.x = pk2(v[j].x, v[j].y); w.y = pk2(v[j].z, v[j].w);
        *(u32x2*)(base + ((size_t)(m >> 8) * 32 + (col >> 6)) * 16384 + (m & 255) * 64 + (col & 63)) = w; }
}
__device__ __forceinline__ void store_row_f32(float* row, const f32x4 (&v)[8], int lane) {
#pragma unroll
    for (int j = 0; j < 8; ++j) ((f32x4*)row)[lane + 64 * j] = v[j];
}

__device__ __forceinline__ const float* modp(const unsigned char* ws, int layer, int r, int chunk) { return (const float*)(ws + WS_MOD) + ((size_t)(layer * 12 + r) * 6 + chunk) * D; }

struct TDesc { const float* W; bf16* WT; const float* ks; int N, ldt, row0, k0, n0, tkt; };
__device__ __forceinline__ TDesc tdecode(CP& p, const Ctx& c, int it) {
    constexpr int I_IN = (D / 64) * (INC / 32), I_OUT = (MIXK / 64) * (D / 32), I_1 = (D / 64) * (DFF / 32), I_2 = (DFF / 64) * (D / 32), I_P = (512 / 64) * (512 / 32);
    TDesc d; d.ks = nullptr; d.tkt = 0; d.row0 = 0; int r = it;
    if (r < I_IN) { const int nb = INC / 32, n0 = (r % nb) * 32; const int nd = n0 < 6144 ? n0 : (n0 < 6176 ? CDT + (n0 - 6144) : n0 - 32);
        d.W = p.in[I_INW]; d.N = INC; d.WT = (bf16*)(c.ws + WS_WIN); d.ldt = D; d.row0 = nd - n0; d.k0 = (r / nb) * 64; d.n0 = n0; d.tkt = D / 64; return d; } r -= I_IN;
    if (r < I_OUT) { const int nb = D / 32; d.W = p.in[I_OUTW]; d.N = D; d.WT = (bf16*)(c.ws + WS_WOUT); d.ldt = MIXK; d.k0 = (r / nb) * 64; d.n0 = (r % nb) * 32; if (d.k0 < INNER) d.ks = p.in[I_SSDG]; return d; } r -= I_OUT;
    if (r < 2 * I_1) { const int l = r / I_1, q = r % I_1, nb = DFF / 32; d.W = p.in[I_W1] + (size_t)l * D * DFF; d.N = DFF; d.WT = (bf16*)(c.ws + WS_W1) + (size_t)l * DFF * D; d.ldt = D; d.k0 = (q / nb) * 64; d.n0 = (q % nb) * 32; d.tkt = D / 64; return d; } r -= 2 * I_1;
    if (r < 2 * I_2) { const int l = r / I_2, q = r % I_2, nb = D / 32; d.W = p.in[I_W2] + (size_t)l * DFF * D; d.N = D; d.WT = (bf16*)(c.ws + WS_W2) + (size_t)l * D * DFF; d.ldt = DFF; d.k0 = (q / nb) * 64; d.n0 = (q % nb) * 32; d.tkt = DFF / 64; return d; } r -= 2 * I_2;
    { const int gq = r / I_P, q = r % I_P, nb = 512 / 32; d.W = p.in[I_POOLW] + (size_t)gq * 512 * 512; d.N = 512; d.WT = (bf16*)(c.ws + WS_WPOOL) + (size_t)gq * 512 * 512; d.ldt = 512; d.k0 = (q / nb) * 64; d.n0 = (q % nb) * 32; return d; }
}
__device__ __forceinline__ void tload(const TDesc& d, int lane, float (&v)[32]) {
    const float* wp = d.W + (size_t)(d.k0 + (lane >> 5)) * d.N + d.n0 + (lane & 31);
#pragma unroll
    for (int i = 0; i < 32; ++i) v[i] = __builtin_nontemporal_load(wp + (size_t)(2 * i) * d.N);
}
__device__ __forceinline__ void tstore(const TDesc& d, LAS float* scr, int lane, const float (&v)[32]) {
#pragma unroll
    for (int i = 0; i < 32; ++i) { const int kk = 2 * i + (lane >> 5); float wv = v[i]; if (d.ks) wv *= d.ks[d.k0 + kk]; scr[kk * 33 + (lane & 31)] = wv; }
    LDS_WAIT();
    const int cc = lane & 7;
#pragma unroll
    for (int j = 0; j < 4; ++j) { const int n = (lane >> 3) + 8 * j; const LAS float* s = scr + (8 * cc) * 33 + n;
        u32x4 o; o.x = pk2(s[0 * 33], s[1 * 33]); o.y = pk2(s[2 * 33], s[3 * 33]); o.z = pk2(s[4 * 33], s[5 * 33]); o.w = pk2(s[6 * 33], s[7 * 33]);
        const int nn = d.row0 + d.n0 + n;
        *(u32x4*)(d.tkt ? d.WT + ((size_t)(nn >> 8) * d.tkt + (d.k0 >> 6)) * 16384 + (nn & 255) * 64 + 8 * cc : d.WT + (size_t)nn * d.ldt + d.k0 + 8 * cc) = o; }
    LDS_WAIT();
}

__device__ __forceinline__ void ph_prologue(CP& p, const Ctx& c) {
    const int lane = c.lane, wave = c.wave, tid = c.tid;
    const float* const cpp_ = p.in[I_CP]; const float* const csp_ = p.in[I_CS];
    __syncthreads();
    for (int it = blockIdx.x; it < 768; it += gridDim.x) {
        const int kq = it & 7, cgp = (it >> 3) % 48, layer = it / 384, n0 = cgp * 256, kb = kq * 256 + wave * 32;
        LAS float* cs = (LAS float*)c.lds + wave * (12 * 32);
        for (int i = lane; i < 12 * 32; i += 64) { const int r = i >> 5, k = kb + (i & 31); const float cv = r < 4 ? cpp_[r * D + k] : csp_[(r - 4) * D + k]; cs[i] = siluf(cv); }
        LDS_WAIT();
        f32x4 acc[12];
#pragma unroll
        for (int r = 0; r < 12; ++r) acc[r] = (f32x4){0.f, 0.f, 0.f, 0.f};
        const float* W = p.in[I_ADAW] + (size_t)layer * D * MODW + (size_t)kb * MODW + n0 + lane * 4;
#pragma unroll
        for (int h = 0; h < 2; ++h) { f32x4 w[16];
#pragma unroll
            for (int kk = 0; kk < 16; ++kk) w[kk] = __builtin_nontemporal_load((const f32x4*)(W + (size_t)(16 * h + kk) * MODW));
#pragma unroll
            for (int kk = 0; kk < 16; ++kk)
#pragma unroll
                for (int r = 0; r < 12; ++r) acc[r] += w[kk] * cs[r * 32 + 16 * h + kk]; }
        __syncthreads();
        LAS f32x4* red = (LAS f32x4*)(c.lds + 16384);
#pragma unroll
        for (int r = 0; r < 12; ++r) red[(wave * 12 + r) * 64 + lane] = acc[r];
        __syncthreads();
        for (int o = tid; o < 12 * 256; o += NT) { const int r = o >> 8, cc = o & 255; float sacc = kq == 0 ? p.in[I_ADAB][layer * MODW + n0 + cc] : 0.f;
#pragma unroll
            for (int w = 0; w < 8; ++w) sacc += ((LAS float*)(c.lds + 16384))[(w * 12 + r) * 256 + cc];
            atomicAdd((float*)(c.ws + WS_MOD) + (size_t)(layer * 12 + r) * MODW + n0 + cc, sacc); }
        __syncthreads();
    }
    {
        LAS float* scr = (LAS float*)(c.lds + wave * 16384);
        constexpr int NITEMS = (D / 64) * (INC / 32) + (MIXK / 64) * (D / 32) + 2 * (D / 64) * (DFF / 32) + 2 * (DFF / 64) * (D / 32) + 4 * (512 / 64) * (512 / 32);
        int it = c.gw;
        if (it < NITEMS) {
            TDesc d = tdecode(p, c, it); float v[32]; tload(d, lane, v);
#pragma clang loop unroll(disable)
            for (;;) { const int itn = it + c.ngw; TDesc dn = d; float vn[32];
                if (itn < NITEMS) { dn = tdecode(p, c, itn); tload(dn, lane, vn); }
                tstore(d, scr, lane, v);
                if (itn >= NITEMS) break;
                d = dn; it = itn;
#pragma unroll
                for (int i = 0; i < 32; ++i) v[i] = vn[i]; }
        }
    }
    { const int gt = blockIdx.x * NT + tid, gn = gridDim.x * NT;
      f32x4* z0 = (f32x4*)(c.ws + WS_SMP + SM_PROJ); for (int i = gt; i < SB * INP / 4; i += gn) z0[i] = (f32x4){0.f, 0.f, 0.f, 0.f};
      f32x4* z1 = (f32x4*)(c.ws + WS_SMP + SM_H0); for (int i = gt; i < 2 * SB * DFF / 4; i += gn) z1[i] = (f32x4){0.f, 0.f, 0.f, 0.f};
      f32x4* z2 = (f32x4*)(c.ws + WS_RS); for (int i = gt; i < 4 * MP / 4; i += gn) z2[i] = (f32x4){0.f, 0.f, 0.f, 0.f}; }
    { bf16* wt = (bf16*)(c.ws + WS_WIN) + (size_t)60 * 32 * 16384;
      for (int i = blockIdx.x * NT + tid; i < 32 * 224 * 8; i += gridDim.x * NT) { const int kt = i / (224 * 8), rem = i % (224 * 8), row = 32 + rem / 8, cc = rem % 8; *(u32x4*)(wt + (size_t)kt * 16384 + row * 64 + cc * 8) = (u32x4){0u, 0u, 0u, 0u}; } }
}

template <bool XBF> __device__ __forceinline__ void ph_normmod(CP& p, const Ctx& c, const void* xp, const float* xs, const float* g, int layer, int csh, int csc, float* xs_copy) {
    for (int m = c.gw; m < MP + SB; m += c.ngw) {
        f32x4 v[8];
        if (m < MP) { if (XBF) load_row_bf16((const bf16*)xp + (size_t)m * D, v, c.lane); else load_row((const float*)xp + (size_t)m * D, v, c.lane); normmod(v, g, modp(c.ws, layer, m >> 11, csc), modp(c.ws, layer, m >> 11, csh), c.lane); store_row_bf16_tiled((bf16*)(c.ws + WS_A0), m, v, c.lane); }
        else { const int r = m - MP; load_row(xs + (size_t)r * D, v, c.lane); store_row_f32(xs_copy + (size_t)r * D, v, c.lane); normmod(v, g, modp(c.ws, layer, 4 + r, csc), modp(c.ws, layer, 4 + r, csh), c.lane); store_row_bf16((bf16*)(c.ws + WS_SMP + SM_USBF) + (size_t)r * D, v, c.lane); }
    }
}

__device__ __forceinline__ int kvlen(int gi) { return gi == 0 ? 128 : (gi == 1 ? 512 : 2048); }
__device__ __forceinline__ size_t pkv_off(int gi) { return gi == 0 ? O_PKV128 : (gi == 1 ? O_PKV512 : O_PKV2048); }
__device__ __forceinline__ size_t skv_off(int gi) { return gi == 0 ? O_SKV128 : (gi == 1 ? O_SKV512 : O_SKV2048); }

__device__ __forceinline__ void ph_sample_postproj(CP& p, const Ctx& c) {
    const int lane = c.lane;
    const float* cw = p.in[I_CONVW]; const float* cb = p.in[I_CONVB]; const float* const qgp = p.in[I_QG]; const float* const kgp = p.in[I_KG];
    const float* sproj = (const float*)(c.ws + WS_SMP + SM_PROJ);
    for (int it = c.gw; it < 64 + 384 + 192; it += c.ngw) {
        if (it < 64) { const int b = it >> 3, ch = (it & 7) * 512 + lane * 8; const float* prow = sproj + (size_t)b * INP;
            const float* st = p.in[I_CONV] + (size_t)b * 3 * CONVD + ch;
            f32x4 o0 = *(const f32x4*)(cb + ch), o1 = *(const f32x4*)(cb + ch + 4);
            const f32x4 s00 = *(const f32x4*)(st), s01 = *(const f32x4*)(st + 4), s10 = *(const f32x4*)(st + CONVD), s11 = *(const f32x4*)(st + CONVD + 4), s20 = *(const f32x4*)(st + 2 * CONVD), s21 = *(const f32x4*)(st + 2 * CONVD + 4);
            const f32x4 x0 = *(const f32x4*)(prow + CX + ch), x1 = *(const f32x4*)(prow + CX + ch + 4);
            o0 += *(const f32x4*)(cw + ch) * s00 + *(const f32x4*)(cw + CONVD + ch) * s10 + *(const f32x4*)(cw + 2 * CONVD + ch) * s20 + *(const f32x4*)(cw + 3 * CONVD + ch) * x0;
            o1 += *(const f32x4*)(cw + ch + 4) * s01 + *(const f32x4*)(cw + CONVD + ch + 4) * s11 + *(const f32x4*)(cw + 2 * CONVD + ch + 4) * s21 + *(const f32x4*)(cw + 3 * CONVD + ch + 4) * x1;
            float* xo = (float*)(c.ws + WS_SMP + SM_XC) + (size_t)b * CONVD + ch;
            *(f32x4*)xo = (f32x4){siluf(o0.x), siluf(o0.y), siluf(o0.z), siluf(o0.w)}; *(f32x4*)(xo + 4) = (f32x4){siluf(o1.x), siluf(o1.y), siluf(o1.z), siluf(o1.w)};
            float* sc = p.out + O_SCONV + (size_t)b * 3 * CONVD + ch;
            *(f32x4*)sc = s10; *(f32x4*)(sc + 4) = s11; *(f32x4*)(sc + CONVD) = s20; *(f32x4*)(sc + CONVD + 4) = s21; *(f32x4*)(sc + 2 * CONVD) = x0; *(f32x4*)(sc + 2 * CONVD + 4) = x1;
            if ((it & 7) == 0 && lane < NH) ((float*)(c.ws + WS_SMP + SM_DT))[b * NH + lane] = softplusf(prow[CDT + lane] + p.in[I_DTB][lane]);
        } else if (it < 64 + 384) { const int q = it - 64, b = q / 48, hh = q % 48; const float* prow = sproj + (size_t)b * INP;
            float* qk = (float*)(c.ws + WS_SMP + SM_QK) + (size_t)b * 6144;
            const float x0 = prow[CQ + hh * HD + lane], x1 = prow[CQ + hh * HD + 64 + lane];
            const float rs = rsqrtf(wave_sum(x0 * x0 + x1 * x1) * (1.f / HD) + EPS); const float* gg = hh < AH ? qgp : kgp;
            const float y0 = x0 * rs * gg[lane], y1 = x1 * rs * gg[64 + lane];
            qk[hh * HD + lane] = y0; qk[hh * HD + 64 + lane] = y1;
            if (hh >= AH) { const int kh = hh - AH, gi = kh >> 3, slot = kh & 7, W = kvlen(gi);
                float* o = p.out + skv_off(gi) + (((size_t)b * W + (W - 1)) * 2 + 0) * 1024 + slot * HD; o[lane] = y0; o[64 + lane] = y1; }
        } else { const int q = it - 448, b = q / AH, vh = q % AH, gi = vh >> 3, slot = vh & 7, W = kvlen(gi); const float* prow = sproj + (size_t)b * INP;
            float* o = p.out + skv_off(gi) + (((size_t)b * W + (W - 1)) * 2 + 1) * 1024 + slot * HD; o[lane] = prow[CV + vh * HD + lane]; o[64 + lane] = prow[CV + vh * HD + 64 + lane]; }
    }
}
__device__ __forceinline__ void ph_kvcopy(CP& p, const Ctx& c, int rp0, int rp1, int w0, int nw) {
    constexpr int R0 = 8 * 127, R1 = 8 * 511, R2 = 8 * 2047, TOTR = R0 + R1 + R2;
    const int lane = c.lane;
    const float* const kc0 = p.in[I_KV128]; const float* const kc1 = p.in[I_KV512]; const float* const kc2 = p.in[I_KV2048];
#pragma clang loop unroll(disable)
    for (int rp = rp0 + w0; rp < rp1; rp += nw) {
        const u32x4* src[2]; u32x4* dst[2];
#pragma unroll
        for (int h = 0; h < 2; ++h) { int q = 2 * rp + h; const float* cb; size_t ob; int W;
            if (q < R0) { cb = kc0; ob = O_SKV128; W = 128; } else if (q < R0 + R1) { q -= R0; cb = kc1; ob = O_SKV512; W = 512; } else { q -= R0 + R1; cb = kc2; ob = O_SKV2048; W = 2048; }
            const int b = q / (W - 1), r = q - b * (W - 1); const size_t base = ((size_t)b * W + r) * 512;
            src[h] = (const u32x4*)cb + base + 512 + lane; dst[h] = (u32x4*)(p.out + ob) + base + lane; }
        u32x4 v[2][8];
#pragma unroll
        for (int h = 0; h < 2; ++h)
#pragma unroll
            for (int j = 0; j < 8; ++j) v[h][j] = __builtin_nontemporal_load(src[h] + 64 * j);
#pragma unroll
        for (int h = 0; h < 2; ++h)
#pragma unroll
            for (int j = 0; j < 8; ++j) __builtin_nontemporal_store(v[h][j], dst[h] + 64 * j);
    }
}

__device__ __forceinline__ int rel_bucket(int dist) {
    if (dist < 16) return dist;
    int l = 16 + (int)(logf((float)dist * (1.f / 16.f)) / 4.852030263919617f * 16.f);
    return l < 31 ? l : 31;
}

typedef short s16x4 __attribute__((ext_vector_type(4)));
__device__ __forceinline__ s16x4 tr_read(const LAS unsigned char* p) { return __builtin_bit_cast(s16x4, __builtin_amdgcn_ds_read_tr16_b64_v4i16((LAS s16x4*)p)); }
__device__ __forceinline__ bf16x8 cat4(s16x4 a, s16x4 b) { return (bf16x8){a[0], a[1], a[2], a[3], b[0], b[1], b[2], b[3]}; }
__device__ __forceinline__ bf16x8 pack8(f32x4 a, f32x4 b) { u32x4 w; w.x = pk2(a[0], a[1]); w.y = pk2(a[2], a[3]); w.z = pk2(b[0], b[1]); w.w = pk2(b[2], b[3]); return __builtin_bit_cast(bf16x8, w); }
#define MFMA16(a, b, c) __builtin_amdgcn_mfma_f32_16x16x32_bf16((a), (b), (c), 0, 0, 0)


struct ConvW { f32x4 w[4][2]; f32x4 b[2]; };
__device__ __forceinline__ void conv_load_w(ConvW& cwv, const float* cw, const float* cb, int ch) {
#pragma unroll
    for (int k = 0; k < 4; ++k) { cwv.w[k][0] = *(const f32x4*)(cw + k * CONVD + ch); cwv.w[k][1] = *(const f32x4*)(cw + k * CONVD + ch + 4); }
    cwv.b[0] = *(const f32x4*)(cb + ch); cwv.b[1] = *(const f32x4*)(cb + ch + 4);
}
__device__ __forceinline__ void conv8(const bf16* prow, int t, int ch, const ConvW& cwv, f32x4& o0, f32x4& o1) {
    o0 = cwv.b[0]; o1 = cwv.b[1];
#pragma unroll
    for (int k = 0; k < 4; ++k) { if (t + k - 3 >= 0) { const u32x4 xv = *(const u32x4*)(prow + (ptrdiff_t)(k - 3) * INP + CX + ch);
            o0 += cwv.w[k][0] * (f32x4){bf2f(xv.x & 0xffffu), bf2f(xv.x >> 16), bf2f(xv.y & 0xffffu), bf2f(xv.y >> 16)};
            o1 += cwv.w[k][1] * (f32x4){bf2f(xv.z & 0xffffu), bf2f(xv.z >> 16), bf2f(xv.w & 0xffffu), bf2f(xv.w >> 16)}; } }
    o0 = (f32x4){siluf(o0.x), siluf(o0.y), siluf(o0.z), siluf(o0.w)}; o1 = (f32x4){siluf(o1.x), siluf(o1.y), siluf(o1.z), siluf(o1.w)};
}

template <int R> __device__ __forceinline__ void conv_rows(const bf16* prow0, int t0, int ch, const ConvW& cwv, f32x4 (&o0)[R], f32x4 (&o1)[R]) {
    u32x4 raw[R + 3];
#pragma unroll
    for (int i = 0; i < R + 3; ++i) raw[i] = (t0 - 3 + i >= 0) ? *(const u32x4*)(prow0 + (ptrdiff_t)(i - 3) * INP + CX + ch) : (u32x4){0u, 0u, 0u, 0u};
#pragma unroll
    for (int r = 0; r < R; ++r) { f32x4 a0 = cwv.b[0], a1 = cwv.b[1];
#pragma unroll
        for (int k = 0; k < 4; ++k) { const u32x4 xv = raw[r + k];
            a0 += cwv.w[k][0] * (f32x4){bf2f(xv.x & 0xffffu), bf2f(xv.x >> 16), bf2f(xv.y & 0xffffu), bf2f(xv.y >> 16)};
            a1 += cwv.w[k][1] * (f32x4){bf2f(xv.z & 0xffffu), bf2f(xv.z >> 16), bf2f(xv.w & 0xffffu), bf2f(xv.w >> 16)}; }
        o0[r] = (f32x4){siluf(a0.x), siluf(a0.y), siluf(a0.z), siluf(a0.w)}; o1[r] = (f32x4){siluf(a1.x), siluf(a1.y), siluf(a1.z), siluf(a1.w)}; }
}

constexpr size_t WS_ACUM = 666 * MiB;
constexpr size_t WS_STATES = WS_Y;
constexpr size_t WS_HPREV = WS_XC;
__device__ __forceinline__ void ssd_states_item(CP& p, const Ctx& c, int b, int ch, int g) {
    LAS unsigned char* Bm = c.lds;
    LAS unsigned char* Xw = c.lds + 36864;
    LAS float* wts = (LAS float*)(c.lds + 118784);
    const int lane = c.lane, wave = c.wave, tid = c.tid, fq = lane >> 4, fr = lane & 15;
    const int m0 = b * SEQ + ch * 128;
    const bf16* pr0 = (const bf16*)(c.ws + WS_PROJ) + (size_t)m0 * INP; const int tch = ch * 128;
    if (wave < 4) {
        const int h = 4 * g + wave; const float A = -__expf(p.in[I_ALOG][h]);
        const float* dtp = (const float*)(c.ws + WS_DT) + (size_t)m0 * NH + h;
        const float d0 = dtp[(size_t)(2 * lane) * NH], d1 = dtp[(size_t)(2 * lane + 1) * NH];
        const float a0 = d0 * A, a1 = d1 * A; float sc = a0 + a1;
#pragma unroll
        for (int o = 1; o < 64; o <<= 1) { const float t = __shfl_up(sc, o); if (lane >= o) sc += t; }
        const float aend = __shfl(sc, 63); const float ac1 = sc, ac0 = sc - a1;
        float* ag = (float*)(c.ws + WS_ACUM) + (size_t)m0 * NH + h; ag[(size_t)(2 * lane) * NH] = ac0; ag[(size_t)(2 * lane + 1) * NH] = ac1;
        wts[wave * 128 + 2 * lane] = d0 * __expf(aend - ac0); wts[wave * 128 + 2 * lane + 1] = d1 * __expf(aend - ac1);
    }
    f32x4 xo0[8], xo1[8];
    { const int cc = tid & 7, e = (tid >> 3) & 3, chn = (4 * g + e) * HP + cc * 8, r0 = 8 * (tid >> 5); ConvW cwv; conv_load_w(cwv, p.in[I_CONVW], p.in[I_CONVB], chn);
      conv_rows<8>(pr0 + (size_t)r0 * INP, tch + r0, chn, cwv, xo0, xo1); }
    { const int cc = tid & 15, chn = INNER + g * SN + cc * 8, r0 = 4 * (tid >> 4); ConvW cwv; conv_load_w(cwv, p.in[I_CONVW], p.in[I_CONVB], chn);
      f32x4 o0[4], o1[4]; conv_rows<4>(pr0 + (size_t)r0 * INP, tch + r0, chn, cwv, o0, o1);
#pragma unroll
      for (int r = 0; r < 4; ++r) *(LAS bf16x8*)(Bm + (r0 + r) * 288 + cc * 16) = pack8(o0[r], o1[r]); }
    __syncthreads();
    { const int cc = tid & 7, e = (tid >> 3) & 3, r0 = 8 * (tid >> 5);
#pragma unroll
      for (int r = 0; r < 8; ++r) { const float w = wts[e * 128 + r0 + r]; *(LAS bf16x8*)(Xw + e * 20480 + (r0 + r) * 160 + cc * 16) = pack8(xo0[r] * w, xo1[r] * w); } }
    __syncthreads();
    const int troff = (4 * fq + (fr >> 2));
    bf16x8 bfr[4];
#pragma unroll
    for (int ks = 0; ks < 4; ++ks) { const LAS unsigned char* a = Bm + (32 * ks + troff) * 288 + (16 * wave + 4 * (fr & 3)) * 2; bfr[ks] = cat4(tr_read(a), tr_read(a + 16 * 288)); }
    float* st = (float*)(c.ws + WS_STATES) + (((size_t)(b * 16 + ch) * NH + 4 * g) * HP) * SN;
#pragma unroll 1
    for (int e = 0; e < 4; ++e) {
#pragma unroll
        for (int pt = 0; pt < 4; ++pt) { f32x4 acc = (f32x4){0.f, 0.f, 0.f, 0.f};
#pragma unroll
            for (int ks = 0; ks < 4; ++ks) { const LAS unsigned char* a = Xw + e * 20480 + (32 * ks + troff) * 160 + (16 * pt + 4 * (fr & 3)) * 2; acc = MFMA16(cat4(tr_read(a), tr_read(a + 16 * 160)), bfr[ks], acc); }
#pragma unroll
            for (int r = 0; r < 4; ++r) st[((size_t)e * HP + 16 * pt + 4 * fq + r) * SN + 16 * wave + fr] = acc[r]; }
    }
    __syncthreads();
}

__device__ __forceinline__ void ph_ssd_scan(CP& p, const Ctx& c, int blk0) {
    if ((int)blockIdx.x < blk0) return;
    const size_t gt = (size_t)(blockIdx.x - blk0) * NT + c.tid, gn = (size_t)(gridDim.x - blk0) * NT;
    const float* st = (const float*)(c.ws + WS_STATES); bf16* hp = (bf16*)(c.ws + WS_HPREV); const float* ac = (const float*)(c.ws + WS_ACUM);
    for (size_t i = gt; i < (size_t)BATCH * NH * HP * (SN / 4); i += gn) { const int n4 = (int)(i & 31), pp = (int)(i >> 5) & 63, h = (int)(i >> 11) & 31, b = (int)(i >> 16);
        f32x4 hr = (f32x4){0.f, 0.f, 0.f, 0.f};
        f32x4 stv[16]; float dcv[16];
#pragma unroll
        for (int ch = 0; ch < 16; ++ch) { stv[ch] = __builtin_nontemporal_load((const f32x4*)(st + ((((size_t)(b * 16 + ch) * NH + h) * HP + pp) * SN) + 4 * n4)); dcv[ch] = ac[(size_t)(b * SEQ + ch * 128 + 127) * NH + h]; }
#pragma unroll
        for (int ch = 0; ch < 16; ++ch) { const size_t off = ((((size_t)(b * 16 + ch) * NH + h) * HP + pp) * SN) + 4 * n4;
            u32x2 w; w.x = pk2(hr.x, hr.y); w.y = pk2(hr.z, hr.w); *(u32x2*)(hp + off) = w;
            hr = hr * __expf(dcv[ch]) + stv[ch]; }
        *(f32x4*)(p.out + O_PSSM + (((size_t)b * NH + h) * HP + pp) * SN + 4 * n4) = hr; }
}

__device__ __forceinline__ void ssd_out_item(CP& p, const Ctx& c, int b, int ch, int g, bool do_atomic = true) {
    LAS unsigned char* Bm = c.lds;
    LAS unsigned char* Xs = c.lds + 34816;
    LAS float* acs = (LAS float*)(c.lds + 116736);
    LAS float* dts = (LAS float*)(c.lds + 118784);
    const int lane = c.lane, wave = c.wave, tid = c.tid, fq = lane >> 4, fr = lane & 15;
    const int m0 = b * SEQ + ch * 128;
    const bf16* pr0 = (const bf16*)(c.ws + WS_PROJ) + (size_t)m0 * INP; const int tch = ch * 128;
    { const int cc = tid & 7, e = (tid >> 3) & 3, chn = (4 * g + e) * HP + cc * 8, r0 = 8 * (tid >> 5); ConvW cwv; conv_load_w(cwv, p.in[I_CONVW], p.in[I_CONVB], chn);
      f32x4 o0[8], o1[8]; conv_rows<8>(pr0 + (size_t)r0 * INP, tch + r0, chn, cwv, o0, o1);
#pragma unroll
      for (int r = 0; r < 8; ++r) *(LAS bf16x8*)(Xs + e * 20480 + (r0 + r) * 160 + cc * 16) = pack8(o0[r], o1[r]); }
    { const int cc = tid & 15, chn = INNER + g * SN + cc * 8, r0 = 4 * (tid >> 4); ConvW cwv; conv_load_w(cwv, p.in[I_CONVW], p.in[I_CONVB], chn);
      f32x4 o0[4], o1[4]; conv_rows<4>(pr0 + (size_t)r0 * INP, tch + r0, chn, cwv, o0, o1);
#pragma unroll
      for (int r = 0; r < 4; ++r) *(LAS bf16x8*)(Bm + (r0 + r) * 272 + cc * 16) = pack8(o0[r], o1[r]); }
    { const int e = tid >> 7, j = tid & 127; acs[tid] = ((const float*)(c.ws + WS_ACUM))[(size_t)(m0 + j) * NH + 4 * g + e]; dts[tid] = ((const float*)(c.ws + WS_DT))[(size_t)(m0 + j) * NH + 4 * g + e]; }
    __syncthreads();
    const int i_tok = 16 * wave + fr;
    bf16x8 cf[4];
#pragma unroll
    for (int ks = 0; ks < 4; ++ks) { const int chn = INNER + SG * SN + g * SN + 32 * ks + 8 * fq; ConvW cwv; conv_load_w(cwv, p.in[I_CONVW], p.in[I_CONVB], chn);
        f32x4 o0, o1; conv8(pr0 + (size_t)i_tok * INP, tch + i_tok, chn, cwv, o0, o1); cf[ks] = pack8(o0, o1); }
    f32x4 cb[8];
#pragma unroll
    for (int jt = 0; jt < 8; ++jt) { cb[jt] = (f32x4){0.f, 0.f, 0.f, 0.f};
        if (jt <= wave) {
#pragma unroll
            for (int ks = 0; ks < 4; ++ks) cb[jt] = MFMA16(*(const LAS bf16x8*)(Bm + (16 * jt + fr) * 272 + (32 * ks + 8 * fq) * 2), cf[ks], cb[jt]); } }
    const int troff = 4 * fq + (fr >> 2);
    const bf16* hpv = (const bf16*)(c.ws + WS_HPREV) + (((size_t)(b * 16 + ch) * NH + 4 * g) * HP) * SN;
    bf16* a1row = (bf16*)(c.ws + WS_A1) + (size_t)(m0 + i_tok) * MIXK + 4 * g * HP; const bf16* zrow = pr0 + (size_t)i_tok * INP + CZ + 4 * g * HP; float ssq = 0.f;
    bf16x8 hp[16];
#pragma unroll
    for (int q = 0; q < 16; ++q) hp[q] = *(const bf16x8*)(hpv + ((size_t)(16 * (q >> 2) + fr)) * SN + 32 * (q & 3) + 8 * fq);
#pragma unroll 1
    for (int e = 0; e < 4; ++e) {
        const float ai = acs[e * 128 + i_tok];
        u32x2 zv4[4];
#pragma unroll
        for (int pt = 0; pt < 4; ++pt) zv4[pt] = *(const u32x2*)(zrow + e * HP + 16 * pt + 4 * fq);
        f32x4 acc[4];
#pragma unroll
        for (int pt = 0; pt < 4; ++pt) { acc[pt] = (f32x4){0.f, 0.f, 0.f, 0.f};
#pragma unroll
            for (int ks = 0; ks < 4; ++ks) acc[pt] = MFMA16(hp[pt * 4 + ks], cf[ks], acc[pt]); }
        if (e < 3) {
#pragma unroll
            for (int q = 0; q < 16; ++q) hp[q] = *(const bf16x8*)(hpv + ((size_t)(e + 1) * HP + 16 * (q >> 2) + fr) * SN + 32 * (q & 3) + 8 * fq); }
        const float ei = __expf(ai);
#pragma unroll
        for (int pt = 0; pt < 4; ++pt) acc[pt] = acc[pt] * ei;
#pragma unroll
        for (int s2 = 0; s2 < 4; ++s2) {
            if (2 * s2 <= wave) {
                f32x4 mv[2];
#pragma unroll
                for (int hf = 0; hf < 2; ++hf) { const int jt = 2 * s2 + hf; const int j0 = 16 * jt + 4 * fq;
                    const f32x4 aj = *(const LAS f32x4*)(acs + e * 128 + j0), dj = *(const LAS f32x4*)(dts + e * 128 + j0);
#pragma unroll
                    for (int r = 0; r < 4; ++r) mv[hf][r] = (j0 + r <= i_tok) ? cb[jt][r] * __expf(ai - aj[r]) * dj[r] : 0.f; }
                const bf16x8 mf = pack8(mv[0], mv[1]);
#pragma unroll
                for (int pt = 0; pt < 4; ++pt) { const LAS unsigned char* a = Xs + e * 20480 + (32 * s2 + troff) * 160 + (16 * pt + 4 * (fr & 3)) * 2; acc[pt] = MFMA16(cat4(tr_read(a), tr_read(a + 16 * 160)), mf, acc[pt]); }
            }
        }
        const float dsk = p.in[I_DSKIP][4 * g + e];
#pragma unroll
        for (int pt = 0; pt < 4; ++pt) { const int pc = e * HP + 16 * pt + 4 * fq;
            const u32x2 xv = *(const LAS u32x2*)(Xs + e * 20480 + i_tok * 160 + (16 * pt + 4 * fq) * 2), zv = zv4[pt];
            const float y0 = (acc[pt][0] + dsk * bf2f(xv.x & 0xffffu)) * siluf(bf2f(zv.x & 0xffffu)), y1 = (acc[pt][1] + dsk * bf2f(xv.x >> 16)) * siluf(bf2f(zv.x >> 16));
            const float y2 = (acc[pt][2] + dsk * bf2f(xv.y & 0xffffu)) * siluf(bf2f(zv.y & 0xffffu)), y3 = (acc[pt][3] + dsk * bf2f(xv.y >> 16)) * siluf(bf2f(zv.y >> 16));
            ssq += (y0 * y0 + y1 * y1) + (y2 * y2 + y3 * y3);
            u32x2 w; w.x = pk2(y0, y1); w.y = pk2(y2, y3); *(u32x2*)(a1row + pc) = w; }
    }
    ssq += __shfl_xor(ssq, 16); ssq += __shfl_xor(ssq, 32);
    if (fq == 0 && do_atomic) atomicAdd((float*)(c.ws + WS_RS) + m0 + i_tok, ssq);
    __syncthreads();
}

struct AttnPre { u32x4 k[8], v[8]; bf16x8 q[4]; float bias; };
struct AttnIt { int b, hd, r, n; };
__device__ __forceinline__ AttnIt attn_decode(int a) { const int gi = a / 512, q = a % 512; AttnIt t; t.b = q >> 7; const int slot = (q >> 4) & 7; t.hd = gi * 8 + slot;
    if (gi == 0) { t.r = 0; t.n = q & 15; } else if (gi == 1) { t.r = (q >> 2) & 3; t.n = q & 3; } else { t.r = q & 15; t.n = 0; } return t; }
__device__ __forceinline__ void attn_prefetch(CP& p, const Ctx& c, const AttnIt it, AttnPre& pre) {
    const int gi = it.hd >> 3, dil = gi == 0 ? 1 : (gi == 1 ? 4 : 16), Ls = SEQ / dil, tid = c.tid, lane = c.lane, wave = c.wave;
    const bf16* proj = (const bf16*)(c.ws + WS_PROJ);
    const int cc = tid & 15;
#pragma unroll
    for (int j = 0; j < 8; ++j) { const int row = (tid >> 4) + 32 * j; int sp = 128 * (it.n - 1) + row; sp = sp < 0 ? 0 : (sp > Ls - 1 ? Ls - 1 : sp);
        const bf16* pr = proj + (size_t)(it.b * SEQ + sp * dil + it.r) * INP + it.hd * HD + cc * 8; pre.k[j] = *(const u32x4*)(pr + CK); pre.v[j] = *(const u32x4*)(pr + CV); }
    const int tokq = it.b * SEQ + (128 * it.n + 16 * wave + (lane & 15)) * dil + it.r;
#pragma unroll
    for (int ks = 0; ks < 4; ++ks) pre.q[ks] = *(const bf16x8*)(proj + (size_t)tokq * INP + CQ + it.hd * HD + 32 * ks + 8 * (lane >> 4));
    { const int t = tid - 16; pre.bias = (tid < 176 && t >= 0 && t <= 128) ? p.in[I_RELB][rel_bucket((128 - t) * dil) * AH + it.hd] : -1e30f; }
}
__device__ __forceinline__ void attn_store_lds(const Ctx& c, const AttnPre& pre) {
    LAS unsigned char* Ks = c.lds; LAS unsigned char* Vs = c.lds + 69632; LAS float* rb = (LAS float*)(c.lds + 143360);
    const int tid = c.tid, cc = tid & 15;
#pragma unroll
    for (int j = 0; j < 8; ++j) { const int row = (tid >> 4) + 32 * j; *(LAS u32x4*)(Ks + row * 272 + cc * 16) = pre.k[j]; *(LAS u32x4*)(Vs + row * 288 + cc * 16) = pre.v[j]; }
    if (tid < 176) rb[tid] = pre.bias;
}
__device__ __forceinline__ void attn_compute(CP& p, const Ctx& c, const AttnIt it, const bf16x8 (&qf)[4]) {
    const int gi = it.hd >> 3, slot = it.hd & 7, dil = gi == 0 ? 1 : (gi == 1 ? 4 : 16), n = it.n;
    const LAS unsigned char* Ks = c.lds; const LAS unsigned char* Vs = c.lds + 69632; const LAS float* rb = (const LAS float*)(c.lds + 143360);
    const int lane = c.lane, wave = c.wave, fq = lane >> 4, fr = lane & 15;
    const int q0 = 16 * wave, qi = q0 + fr;
    const int tokq = it.b * SEQ + (128 * n + qi) * dil + it.r;
    f32x4 sa[10];
#pragma unroll
    for (int kt = 0; kt < 10; ++kt) { int kr = q0 + 16 * kt + fr; kr = kr > 255 ? 255 : kr;
        sa[kt] = (f32x4){0.f, 0.f, 0.f, 0.f};
#pragma unroll
        for (int ks = 0; ks < 4; ++ks) sa[kt] = MFMA16(*(const LAS bf16x8*)(Ks + kr * 272 + (32 * ks + 8 * fq) * 2), qf[ks], sa[kt]);
        if (kt & 1) __builtin_amdgcn_sched_barrier(0); }
    float mx = -1e30f;
#pragma unroll
    for (int kt = 0; kt < 10; ++kt)
#pragma unroll
        for (int rg = 0; rg < 4; ++rg) { const int t = 16 * kt + 4 * fq + rg - fr; float lg = sa[kt][rg] * 0.08838834764831845f + rb[t + 16];
            if (n == 0 && (q0 + 16 * kt + 4 * fq + rg) < 128) lg = -1e30f;
            sa[kt][rg] = lg; mx = fmaxf(mx, lg); }
    mx = fmaxf(mx, __shfl_xor(mx, 16)); mx = fmaxf(mx, __shfl_xor(mx, 32));
    float sum = 0.f;
#pragma unroll
    for (int kt = 0; kt < 10; ++kt)
#pragma unroll
        for (int rg = 0; rg < 4; ++rg) { const float e = __expf(sa[kt][rg] - mx); sa[kt][rg] = e; sum += e; }
    sum += __shfl_xor(sum, 16); sum += __shfl_xor(sum, 32);
    bf16x8 pf[5];
#pragma unroll
    for (int s2 = 0; s2 < 5; ++s2) pf[s2] = pack8(sa[2 * s2], sa[2 * s2 + 1]);
    const float inv = 1.f / sum;
    bf16* orow = (bf16*)(c.ws + WS_ATT) + ((size_t)gi * MP + tokq) * AOUT + slot * HD;
#pragma unroll
    for (int dt = 0; dt < 8; ++dt) { f32x4 o = (f32x4){0.f, 0.f, 0.f, 0.f};
#pragma unroll
        for (int s2 = 0; s2 < 5; ++s2) { int r0 = q0 + 32 * s2 + 4 * fq + (fr >> 2), r1 = r0 + 16; r0 = r0 > 255 ? 255 : r0; r1 = r1 > 255 ? 255 : r1;
            const int cb2 = (16 * dt + 4 * (fr & 3)) * 2; o = MFMA16(cat4(tr_read(Vs + r0 * 288 + cb2), tr_read(Vs + r1 * 288 + cb2)), pf[s2], o); }
        u32x2 w; w.x = pk2(o[0] * inv, o[1] * inv); w.y = pk2(o[2] * inv, o[3] * inv); *(u32x2*)(orow + 16 * dt + 4 * fq) = w;
        if (dt & 1) __builtin_amdgcn_sched_barrier(0); }
    if (fq == 0) ((float*)(c.ws + WS_LSE))[((size_t)gi * MP + tokq) * HPP + slot] = mx + __logf(sum);
}

__device__ __forceinline__ void ph_mixers(CP& p, const Ctx& c) {
    const int G = gridDim.x;
    int it = blockIdx.x;
    for (; it < 512; it += G) ssd_states_item(p, c, it >> 7, (it >> 3) & 15, it & 7);
    int a = it - 512;
    if (a < 1536) {
        AttnPre pre; attn_prefetch(p, c, attn_decode(a), pre);
#pragma clang loop unroll(disable)
        for (; a < 1536; a += G) {
            const AttnIt cur = attn_decode(a);
            attn_store_lds(c, pre);
            bf16x8 qf[4];
#pragma unroll
            for (int ks = 0; ks < 4; ++ks) qf[ks] = pre.q[ks];
            __syncthreads();
            if (a + G < 1536) attn_prefetch(p, c, attn_decode(a + G), pre);
            attn_compute(p, c, cur, qf);
            __syncthreads();
        }
    }
}
__device__ __forceinline__ void ph_sample_mix(CP& p, const Ctx& c) {
    const int lane = c.lane;
    for (int grp = c.gw; grp < SB * NH * (HP / 8); grp += c.ngw) {
        const int b = grp >> 8, h = (grp >> 3) & 31, pp0 = (grp & 7) * 8, g = h >> 2;
        const float* xcs = (const float*)(c.ws + WS_SMP + SM_XC) + (size_t)b * CONVD;
        const float* h0 = p.in[I_SSM] + (((size_t)b * NH + h) * HP + pp0) * SN; float* ho = p.out + O_SSSM + (((size_t)b * NH + h) * HP + pp0) * SN;
        f32x2 hv[8];
#pragma unroll
        for (int k = 0; k < 8; ++k) hv[k] = *(const f32x2*)(h0 + (size_t)k * SN + 2 * lane);
        const float dtv = ((const float*)(c.ws + WS_SMP + SM_DT))[b * NH + h], a = __expf(-__expf(p.in[I_ALOG][h]) * dtv);
        const f32x2 bv = *(const f32x2*)(xcs + INNER + g * SN + 2 * lane), cv = *(const f32x2*)(xcs + INNER + SG * SN + g * SN + 2 * lane);
        const float xl = xcs[h * HP + pp0 + (lane & 7)];
        float yk = 0.f;
#pragma unroll
        for (int k = 0; k < 8; ++k) { const float xdt = dtv * __shfl(xl, k);
            const f32x2 hn = (f32x2){a * hv[k].x + xdt * bv.x, a * hv[k].y + xdt * bv.y};
            *(f32x2*)(ho + (size_t)k * SN + 2 * lane) = hn;
            const float y = wave_sum(hn.x * cv.x + hn.y * cv.y); if (lane == k) yk = y; }
        if (lane < 8) ((float*)(c.ws + WS_SMP + SM_Y))[b * INNER + h * HP + pp0 + lane] = yk;
    }
}
__device__ __forceinline__ void ph_sample_attn(CP& p, const Ctx& c) {
    const int lane = c.lane, wq = c.wave & 3, half = c.wave >> 2;
    LAS float* part = (LAS float*)c.lds;
    LAS float* ps = (LAS float*)c.lds + 8 * 132 + c.wave * 48;
    for (int pair = blockIdx.x; pair < SB * AH / 2; pair += gridDim.x) {
        const int it = pair * 2 + half;
        const int b = it / AH, hd = it % AH, gi = hd >> 3, slot = hd & 7, dil = gi == 0 ? 1 : (gi == 1 ? 4 : 16), W = kvlen(gi), kb = wq * 33;
        const float* qk = (const float*)(c.ws + WS_SMP + SM_QK) + (size_t)b * 6144; const float* q = qk + hd * HD; const float* knew = qk + (AH + hd) * HD;
        const float* vnew = (const float*)(c.ws + WS_SMP + SM_PROJ) + (size_t)b * INP + CV + hd * HD;
        const float* const kc0 = p.in[I_KV128]; const float* const kc1 = p.in[I_KV512]; const float* const kc2 = p.in[I_KV2048];
        const float* cache = (gi == 0 ? kc0 : (gi == 1 ? kc1 : kc2)) + (size_t)b * W * 2048;
        const int sub = lane & 3, kg = lane >> 2;
        f32x4 qv[8];
#pragma unroll
        for (int e = 0; e < 8; ++e) qv[e] = *(const f32x4*)(q + sub * 32 + 4 * e);
        f32x4 kv[3][8];
#pragma unroll
        for (int ps3 = 0; ps3 < 3; ++ps3) { const int jj = kb + ps3 * 16 + kg; const int jc = jj > 128 ? 128 : jj;
            const float* kr = (jc == 0 ? knew : cache + ((size_t)(W - dil * jc) * 2 + 0) * 1024 + slot * HD) + sub * 32;
#pragma unroll
            for (int e = 0; e < 8; ++e) kv[ps3][e] = *(const f32x4*)(kr + 4 * e); }
        float lg[3]; float mx = -1e30f;
#pragma unroll
        for (int ps3 = 0; ps3 < 3; ++ps3) { const int loc = ps3 * 16 + kg, jj = kb + loc; const int jc = jj > 128 ? 128 : jj; float sdot = 0.f;
#pragma unroll
            for (int e = 0; e < 8; ++e) sdot += (kv[ps3][e].x * qv[e].x + kv[ps3][e].y * qv[e].y) + (kv[ps3][e].z * qv[e].z + kv[ps3][e].w * qv[e].w);
            sdot += __shfl_xor(sdot, 1); sdot += __shfl_xor(sdot, 2);
            lg[ps3] = (loc < 33 && jj <= 128) ? sdot * 0.08838834764831845f + p.in[I_RELB][rel_bucket(jc * dil) * AH + hd] : -1e30f; mx = fmaxf(mx, lg[ps3]); }
        mx = wave_max(mx); float sum = 0.f;
#pragma unroll
        for (int ps3 = 0; ps3 < 3; ++ps3) { const int loc = ps3 * 16 + kg, jj = kb + loc; const float e = (loc < 33 && jj <= 128) ? __expf(lg[ps3] - mx) : 0.f; if (sub == 0) { ps[loc] = e; sum += e; } }
        sum = wave_sum(sum);
        LDS_WAIT();
        const int ksl = lane >> 3, dc = lane & 7;
        f32x4 vv[5][4]; float pj[5];
#pragma unroll
        for (int st = 0; st < 5; ++st) { const int loc = 8 * st + ksl, jj = kb + loc; const int jc = jj > 128 ? 128 : jj;
            const float* vr = (jc == 0 ? vnew : cache + ((size_t)(W - dil * jc) * 2 + 1) * 1024 + slot * HD) + 16 * dc;
            pj[st] = ps[loc];
#pragma unroll
            for (int q4 = 0; q4 < 4; ++q4) vv[st][q4] = *(const f32x4*)(vr + 4 * q4); }
        f32x4 oa[4];
#pragma unroll
        for (int q4 = 0; q4 < 4; ++q4) oa[q4] = (f32x4){0.f, 0.f, 0.f, 0.f};
#pragma unroll
        for (int st = 0; st < 5; ++st)
#pragma unroll
            for (int q4 = 0; q4 < 4; ++q4) oa[q4] += vv[st][q4] * pj[st];
#pragma unroll
        for (int q4 = 0; q4 < 4; ++q4)
#pragma unroll
            for (int e = 0; e < 4; ++e) { float t = oa[q4][e]; t += __shfl_xor(t, 8); t += __shfl_xor(t, 16); t += __shfl_xor(t, 32); oa[q4][e] = t; }
        if (ksl == 0) {
#pragma unroll
            for (int q4 = 0; q4 < 4; ++q4) *(LAS f32x4*)(part + c.wave * 132 + 16 * dc + 4 * q4) = oa[q4]; }
        if (lane == 0) { part[c.wave * 132 + 128] = mx; part[c.wave * 132 + 129] = sum; }
        __syncthreads();
        if (wq == 0 && lane < 32) { const LAS float* pw = part + (half * 4) * 132;
            const float m0 = pw[128], m1 = pw[132 + 128], m2 = pw[264 + 128], m3 = pw[396 + 128], M = fmaxf(fmaxf(m0, m1), fmaxf(m2, m3));
            const float w0 = __expf(m0 - M), w1 = __expf(m1 - M), w2 = __expf(m2 - M), w3 = __expf(m3 - M);
            const float S = pw[129] * w0 + pw[132 + 129] * w1 + pw[264 + 129] * w2 + pw[396 + 129] * w3;
            const f32x4 o = *(const LAS f32x4*)(pw + 4 * lane) * w0 + *(const LAS f32x4*)(pw + 132 + 4 * lane) * w1 + *(const LAS f32x4*)(pw + 264 + 4 * lane) * w2 + *(const LAS f32x4*)(pw + 396 + 4 * lane) * w3;
            float* ao = (float*)(c.ws + WS_SMP + SM_ATT) + ((size_t)gi * SB + b) * AOUT + slot * HD + 4 * lane;
            *(f32x4*)ao = o * (1.f / S);
            if (lane == 0) ((float*)(c.ws + WS_SMP + SM_LSE))[(gi * SB + b) * HPP + slot] = M + __logf(S); }
        __syncthreads();
    }
}

__device__ __forceinline__ void ph_combine(CP& p, const Ctx& c, int blk0) {
    if ((int)blockIdx.x < blk0) return;
    const int lane = c.lane; const float* lse = (const float*)(c.ws + WS_LSE);
    for (int m = c.gw - blk0 * NWAVES; m < MP; m += c.ngw - blk0 * NWAVES) {
        bf16* arow = (bf16*)(c.ws + WS_A1) + (size_t)m * MIXK;
#pragma unroll
        for (int j = 0; j < 4; ++j) { const int ch = 4 * (lane + 64 * j), slot = ch >> 7;
            const float l0 = lse[((size_t)0 * MP + m) * HPP + slot], l1 = lse[((size_t)1 * MP + m) * HPP + slot], l2 = lse[((size_t)2 * MP + m) * HPP + slot];
            const float mx = fmaxf(l0, fmaxf(l1, l2)); float w0 = __expf(l0 - mx), w1 = __expf(l1 - mx), w2 = __expf(l2 - mx); const float inv = 1.f / (w0 + w1 + w2); w0 *= inv; w1 *= inv; w2 *= inv;
            const bf16* ab = (const bf16*)(c.ws + WS_ATT) + (size_t)m * AOUT + ch;
            const u32x2 a0 = *(const u32x2*)ab, a1 = *(const u32x2*)(ab + (size_t)MP * AOUT), a2 = *(const u32x2*)(ab + (size_t)2 * MP * AOUT);
            const float o0 = w0 * bf2f(a0.x & 0xffffu) + w1 * bf2f(a1.x & 0xffffu) + w2 * bf2f(a2.x & 0xffffu), o1 = w0 * bf2f(a0.x >> 16) + w1 * bf2f(a1.x >> 16) + w2 * bf2f(a2.x >> 16);
            const float o2 = w0 * bf2f(a0.y & 0xffffu) + w1 * bf2f(a1.y & 0xffffu) + w2 * bf2f(a2.y & 0xffffu), o3 = w0 * bf2f(a0.y >> 16) + w1 * bf2f(a1.y >> 16) + w2 * bf2f(a2.y >> 16);
            u32x2 w; w.x = pk2(o0, o1); w.y = pk2(o2, o3); *(u32x2*)(arow + INNER + ch) = w; }
    }
}
__device__ __forceinline__ void ph_sample_a1(CP& p, const Ctx& c) {
    const int lane = c.lane;
    for (int b = c.gw; b < SB; b += c.ngw) {
        f32x4 v[8]; load_row((const float*)(c.ws + WS_SMP + SM_Y) + (size_t)b * INNER, v, lane);
        const float* xcs = (const float*)(c.ws + WS_SMP + SM_XC) + (size_t)b * CONVD; const float* zs = (const float*)(c.ws + WS_SMP + SM_PROJ) + (size_t)b * INP + CZ;
        float ss = 0.f;
#pragma unroll
        for (int j = 0; j < 8; ++j) { const int ch = 4 * (lane + 64 * j); const float dsk = p.in[I_DSKIP][ch >> 6]; const f32x4 xv = *(const f32x4*)(xcs + ch), zv = *(const f32x4*)(zs + ch);
            v[j].x = (v[j].x + dsk * xv.x) * siluf(zv.x); v[j].y = (v[j].y + dsk * xv.y) * siluf(zv.y); v[j].z = (v[j].z + dsk * xv.z) * siluf(zv.z); v[j].w = (v[j].w + dsk * xv.w) * siluf(zv.w);
            ss += (v[j].x * v[j].x + v[j].y * v[j].y) + (v[j].z * v[j].z + v[j].w * v[j].w); }
        const float rs = rsqrtf(wave_sum(ss) * (1.f / INNER) + EPS);
        bf16* arow = (bf16*)(c.ws + WS_SMP + SM_A1BF) + (size_t)b * MIXK;
#pragma unroll
        for (int j = 0; j < 8; ++j) { const int ch = 4 * (lane + 64 * j); const f32x4 o = v[j] * rs; u32x2 w; w.x = pk2(o.x, o.y); w.y = pk2(o.z, o.w); *(u32x2*)(arow + ch) = w; }
        const float* lse = (const float*)(c.ws + WS_SMP + SM_LSE); const float* att = (const float*)(c.ws + WS_SMP + SM_ATT);
#pragma unroll
        for (int j = 0; j < 4; ++j) { const int ch = 4 * (lane + 64 * j), slot = ch >> 7;
            const float l0 = lse[(0 * SB + b) * HPP + slot], l1 = lse[(1 * SB + b) * HPP + slot], l2 = lse[(2 * SB + b) * HPP + slot];
            const float mx = fmaxf(l0, fmaxf(l1, l2)); float w0 = __expf(l0 - mx), w1 = __expf(l1 - mx), w2 = __expf(l2 - mx); const float inv = 1.f / (w0 + w1 + w2); w0 *= inv; w1 *= inv; w2 *= inv;
            const f32x4 a0 = *(const f32x4*)(att + ((size_t)0 * SB + b) * AOUT + ch), a1 = *(const f32x4*)(att + ((size_t)1 * SB + b) * AOUT + ch), a2 = *(const f32x4*)(att + ((size_t)2 * SB + b) * AOUT + ch);
            const f32x4 o = a0 * w0 + a1 * w1 + a2 * w2;
            u32x2 w; w.x = pk2(o.x, o.y); w.y = pk2(o.z, o.w); *(u32x2*)(arow + INNER + ch) = w; }
    }
}

__device__ __forceinline__ void ph_pool(CP& p, const Ctx& c) {
    const int lane = c.lane;
    const bf16* x2 = (const bf16*)(c.ws + WS_Y); const float* rss = (const float*)(c.ws + WS_RS) + MP;
    bf16* pg = (bf16*)(c.ws + WS_A1);
    const int gt = blockIdx.x * NT + c.tid, gn = gridDim.x * NT;
    for (int task = gt; task < BATCH * 128 * 512; task += gn) {
        const int cq = task & 511, seg = (task >> 9) & 127, b = task >> 16, ch = 4 * cq, gi = cq >> 7, t0 = seg * 16;
        const f32x4 gg = *(const f32x4*)(p.in[I_NMIX] + D + ch), s1 = *(const f32x4*)(modp(c.ws, 1, b, 1) + ch), sh = *(const f32x4*)(modp(c.ws, 1, b, 0) + ch);
        const f32x4 gm = gg * (s1 + 1.f);
        const bf16* xb = x2 + (size_t)b * SEQ * D + ch; const float* rb = rss + b * SEQ;
        f32x4 xh[31];
#pragma unroll
        for (int i = 0; i < 31; ++i) { const int t = t0 - 15 + i; if (t >= 0 && i >= 16 - (2 << gi)) { const u32x2 x = *(const u32x2*)(xb + (size_t)t * D); xh[i] = (f32x4){__uint_as_float(x.x << 16), __uint_as_float(x.x & 0xffff0000u), __uint_as_float(x.y << 16), __uint_as_float(x.y & 0xffff0000u)} * rsqrtf(rb[t] * (1.f / D) + EPS); } else xh[i] = (f32x4){0.f, 0.f, 0.f, 0.f}; }
        auto emit = [&](int i, const f32x4& S, int w) { const int t = t0 + i; const int cnt = t + 1 < w ? t + 1 : w; const f32x4 xn = xh[15 + i]; const f32x4 o = gm * (S * __builtin_amdgcn_rcpf((float)cnt) - xn);
            u32x2 wv; wv.x = pk2(o.x, o.y); wv.y = pk2(o.z, o.w); *(u32x2*)(pg + (size_t)(b * SEQ + t) * D + ch) = wv;
            if (t >= SEQ - 15) *(f32x4*)(p.out + O_PPOOL + ((size_t)b * 15 + (t - (SEQ - 15))) * D + ch) = xn * gm + sh; };
#define POOL_W(W_) { f32x4 S = (f32x4){0.f, 0.f, 0.f, 0.f}; _Pragma("unroll") for (int k = 0; k < W_; ++k) S += xh[15 - k]; \
            _Pragma("unroll") for (int i = 0; i < 16; ++i) { emit(i, S, W_); if (i < 15) S += xh[16 + i] - xh[16 + i - W_]; } }
        if (gi == 0) POOL_W(2) else if (gi == 1) POOL_W(4) else if (gi == 2) POOL_W(8) else POOL_W(16)
#undef POOL_W
    }
    for (int it = c.gw; it < 112 + 64; it += c.ngw) {
        if (it < 112) { const int b = it / 14, k = it % 14; f32x4 t4[8]; load_row(p.in[I_POOL] + ((size_t)b * 15 + k + 1) * D, t4, lane); store_row_f32(p.out + O_SPOOL + ((size_t)b * 15 + k) * D, t4, lane); continue; }
        const int b = (it - 112) >> 3, j = (it - 112) & 7;
        f32x4 v[8]; load_row((const float*)(c.ws + WS_SMP + SM_X2) + (size_t)b * D, v, lane);
        const float rs = row_rs(v);
        const int ch = 4 * (lane + 64 * j), gi = ch >> 9, w = 2 << gi;
        const f32x4 xr = v[0];
        (void)xr;
        f32x4 xo;
#pragma unroll
        for (int jj = 0; jj < 8; ++jj) if (jj == j) xo = v[jj];
        ((f32x4*)((float*)(c.ws + WS_SMP + SM_X3) + (size_t)b * D))[lane + 64 * j] = xo;
        const f32x4 gg = *(const f32x4*)(p.in[I_NMIX] + D + ch), s1 = *(const f32x4*)(modp(c.ws, 1, 4 + b, 1) + ch), s0 = *(const f32x4*)(modp(c.ws, 1, 4 + b, 0) + ch);
        const f32x4 u = xo * rs * gg * (s1 + 1.f) + s0;
        const float* sp = p.in[I_POOL] + (size_t)b * 15 * D;
        *(f32x4*)(p.out + O_SPOOL + ((size_t)b * 15 + 14) * D + ch) = u;
        f32x4 pr[15];
#pragma unroll
        for (int k = 1; k < 16; ++k) pr[k - 1] = *(const f32x4*)(sp + (size_t)(15 - k) * D + ch);
        f32x4 sacc = u;
#pragma unroll
        for (int k = 1; k < 16; ++k) if (k < w) sacc += pr[k - 1];
        const f32x4 o = sacc * (1.f / (float)w) - u; u32x2 wv; wv.x = pk2(o.x, o.y); wv.y = pk2(o.z, o.w); *(u32x2*)((bf16*)(c.ws + WS_SMP + SM_PGBF) + (size_t)b * D + ch) = wv;
    }
}

constexpr int NPHASE = 15;
constexpr int KV_SPLIT = 7000;
__device__ __forceinline__ unsigned char* launder(unsigned char* q) { const unsigned long long v = (unsigned long long)q; unsigned lo = (unsigned)__builtin_amdgcn_readfirstlane((int)(unsigned)v), hi = (unsigned)__builtin_amdgcn_readfirstlane((int)(unsigned)(v >> 32)); asm volatile("" : "+s"(lo), "+s"(hi)); return (unsigned char*)(((unsigned long long)hi << 32) | (unsigned long long)lo); }
__device__ __forceinline__ CP* kernarg_p() { unsigned long long v = (unsigned long long)__builtin_amdgcn_kernarg_segment_ptr(); unsigned lo = (unsigned)v, hi = (unsigned)(v >> 32); asm volatile("" : "+s"(lo), "+s"(hi)); return (CP*)(((unsigned long long)hi << 32) | (unsigned long long)lo); }
__global__ void __launch_bounds__(NT, 2) mk_fwd(P p_unused) {
    (void)p_unused;
    CP& p0 = *kernarg_p();
    extern __shared__ __attribute__((aligned(16))) unsigned char lds_raw[];
    Ctx c0; c0.lds = (LAS unsigned char*)lds_raw; c0.tid = threadIdx.x; c0.lane = c0.tid & 63; c0.wave = __builtin_amdgcn_readfirstlane(c0.tid >> 6);
    c0.gw = blockIdx.x * NWAVES + c0.wave; c0.ngw = gridDim.x * NWAVES; c0.ws = nullptr;
    volatile LAS unsigned* bst = (volatile LAS unsigned*)(c0.lds + LDS_BYTES - 16);
    if (c0.tid < 4) bst[c0.tid] = 0u;
    __syncthreads();
#if defined(CLKSEL) && CLKSEL == 6
    if (c0.tid == 0) bst[2] = (unsigned)__builtin_amdgcn_s_memrealtime();
#endif
#define WS_UNIFORM() ((unsigned char*)((((unsigned long long)(unsigned)__builtin_amdgcn_readfirstlane((int)((unsigned long long)p0.ws >> 32))) << 32) | (unsigned long long)(unsigned)__builtin_amdgcn_readfirstlane((int)(unsigned)(unsigned long long)p0.ws)))
    (void)xcd_barrier_post((unsigned*)(WS_UNIFORM() + WS_CTL) + 1024, bst);
    const int lo = p0.ph_lo, hi = p0.ph_hi;
    const int G = gridDim.x;
#ifndef PHMASK
#define PHMASK 0xFFFFF
#endif
#ifndef CLKPROBE
#define CLKPROBE -1
#endif
#define CLK_A(k) do { if (CLKPROBE == (k) && blockIdx.x == 0 && threadIdx.x == 0) { volatile unsigned long long* q_ = (volatile unsigned long long*)(ws + WS_CTL + 65536); q_[0] = __builtin_readcyclecounter(); q_[1] = __builtin_amdgcn_s_memrealtime(); } } while (0)
#define CLK_B(k) do { if (CLKPROBE == (k) && blockIdx.x == 0 && threadIdx.x == 0) { volatile unsigned long long* q_ = (volatile unsigned long long*)(ws + WS_CTL + 65536); const unsigned long long c1_ = __builtin_readcyclecounter(), r1_ = __builtin_amdgcn_s_memrealtime(); \
    const float dc_ = (float)(c1_ - q_[0]), dr_ = (float)(r1_ - q_[1]); const unsigned long long tgt_ = (unsigned long long)(dc_ * 5000.f / dr_); while (__builtin_amdgcn_s_memrealtime() - r1_ < tgt_) __builtin_amdgcn_s_sleep(8); } } while (0)
#ifdef CLKSEL
#ifndef CLKMUL
#define CLKMUL 8
#define CLKBLK 100
#endif
#undef CLK_B
#define CLK_B(k) do { if (CLKPROBE == (k) && blockIdx.x == 0 && threadIdx.x == 0) { volatile unsigned long long* q_ = (volatile unsigned long long*)(ws + WS_CTL + 65536); const unsigned long long r1_ = __builtin_amdgcn_s_memrealtime(); \
    const unsigned long long tgt_ = (CLKSEL == 3 ? (unsigned long long)__builtin_readcyclecounter() - q_[0] : q_[2]) * CLKMUL / 4; while (__builtin_amdgcn_s_memrealtime() - r1_ < tgt_) __builtin_amdgcn_s_sleep(8); } } while (0)
#endif
#if defined(CLKSEL) && CLKSEL >= 4
#undef CLK_A
#undef CLK_B
#define CLK_A(k) do { if (CLKPROBE == (k) && threadIdx.x == 0) bst[2] = (unsigned)__builtin_amdgcn_s_memrealtime(); } while (0)
#define CLK_B(k) do { if (CLKPROBE == (k) && threadIdx.x == 0) { unsigned* q_ = (unsigned*)(ws + WS_CTL + 131072); const unsigned d_ = (unsigned)__builtin_amdgcn_s_memrealtime() - bst[2]; atomicMax(q_, d_); atomicMax(q_ + 1, 0xFFFFFFFFu - d_); if (blockIdx.x == CLKBLK) q_[2] = d_; } } while (0)
#define CLK_C(k) do { if (blockIdx.x == 0 && threadIdx.x == 0) { volatile unsigned* q_ = (volatile unsigned*)(WS_UNIFORM() + WS_CTL + 131072); \
    const unsigned long long r1_ = __builtin_amdgcn_s_memrealtime(); const unsigned long long tgt_ = (unsigned long long)(CLKSEL == 4 ? q_[0] : (CLKSEL == 5 ? 0xFFFFFFFFu - q_[1] : q_[2])) * CLKMUL; while (__builtin_amdgcn_s_memrealtime() - r1_ < tgt_) __builtin_amdgcn_s_sleep(8); } } while (0)
#else
#define CLK_C(k) do { } while (0)
#endif
#if defined(CLKSEL) && CLKSEL == 6
#define CLK_T(k) do { if (CLKPROBE == (k) && blockIdx.x == 0 && threadIdx.x == 0) { const unsigned r1_ = (unsigned)__builtin_amdgcn_s_memrealtime(); const unsigned tgt_ = (r1_ - bst[2]) * CLKMUL; while ((unsigned)__builtin_amdgcn_s_memrealtime() - r1_ < tgt_) __builtin_amdgcn_s_sleep(8); } } while (0)
#else
#define CLK_T(k) do { } while (0)
#endif
#define IN(k) (((PHMASK >> (k)) & 1) && lo <= (k) && (k) < hi)
#ifndef REPMASK
#define REPMASK 0
#endif
#define REPLOOP(k) _Pragma("clang loop unroll(disable)") for (int rep_ = 0; rep_ < 1 + ((REPMASK >> (k)) & 1); ++rep_)
#define SEAM(k) do { if (IN(k) && IN((k) + 1)) { XcdBarrier bb_; bb_.bar = (unsigned*)(WS_UNIFORM() + WS_CTL) + 1024; bb_.x = xb_xcc_id(); bb_.st = (volatile LAS unsigned*)(c0.lds + LDS_BYTES - 16); xcd_barrier(bb_); CLK_T(k); } } while (0)
    if (IN(0)) REPLOOP(0) { CP& p = *kernarg_p(); Ctx c = c0; c.ws = launder(p.ws); unsigned char* ws = c.ws; (void)ws; CLK_A(0); ph_prologue(p, c); CLK_B(0); }
    SEAM(0);
    if (IN(1)) REPLOOP(1) { CP& p = *kernarg_p(); Ctx c = c0; c.ws = launder(p.ws); unsigned char* ws = c.ws; (void)ws; CLK_A(1); ph_normmod<false>(p, c, p.in[I_XP], p.in[I_XS], p.in[I_NMIX], 0, 0, 1, (float*)(ws + WS_SMP + SM_X1)); CLK_B(1); }
    SEAM(1);
    if (IN(2)) REPLOOP(2) { CP& p = *kernarg_p(); Ctx c = c0; c.ws = launder(p.ws); unsigned char* ws = c.ws; (void)ws;
        CLK_A(2);
        pg8::Gemm g{(const bf16*)(ws + WS_A0), (const bf16*)(ws + WS_WIN), MP, INP, D, D, D, 1 << 20, D / 64, D / 64};
        if (G == 256 && blockIdx.x >= 160) { ph_kvcopy(p, c, 0, KV_SPLIT, (blockIdx.x - 160) * NWAVES + c.wave, 96 * NWAVES); __syncthreads(); }
        pg8::EpiProj E{(bf16*)(ws + WS_PROJ), (float*)(ws + WS_DT), p.out, p.in[I_QG], p.in[I_KG], p.in[I_DTB], (LAS float*)(c.lds + 131072)};
        if (G % pg8::NXCD == 0) { pg8::DynOrder S; S.init(MP, INP, G, blockIdx.x, (unsigned*)(ws + WS_CTL + 262144), (volatile LAS int*)(c.lds + LDS_BYTES - 32));
            pg8::gemm_phase<pg8::EpiProj, true, pg8::NoHook, pg8::DynOrder>(c.lds, g, S, E); }
        else { pg8::StaticOrder S; S.init(MP, INP, G, blockIdx.x); pg8::gemm_phase<pg8::EpiProj>(c.lds, g, S, E); }
        float* sp = (float*)(ws + WS_SMP + SM_PROJ); const bf16* ua = (const bf16*)(ws + WS_SMP + SM_USBF);
        if (rep_ == 0) skinny(c, [&](int r, int k) { return *(const bf16x8*)(ua + (size_t)r * D + k); }, (const bf16*)(ws + WS_WIN), D, D, INP, 2, [&](int r, int n, float v) { atomicAdd(sp + (size_t)r * INP + n, v); }, D / 64);
        CLK_B(2);
    }
    SEAM(2);
    if (IN(3)) REPLOOP(3) { CP& p = *kernarg_p(); Ctx c = c0; c.ws = launder(p.ws); unsigned char* ws = c.ws; (void)ws; CLK_A(3); ph_mixers(p, c); ph_sample_postproj(p, c); ph_kvcopy(p, c, (G == 256 ? KV_SPLIT : 0), 10740, c.gw, c.ngw); CLK_B(3); }
    SEAM(3);
    if (IN(4)) REPLOOP(4) { CP& p = *kernarg_p(); Ctx c = c0; c.ws = launder(p.ws); unsigned char* ws = c.ws; (void)ws; const int sb0 = G >= 192 ? SB * AH / 2 : 0; CLK_A(4); ph_sample_attn(p, c); ph_ssd_scan(p, c, 0); ph_combine(p, c, sb0); ph_sample_mix(p, c); CLK_B(4); }
    SEAM(4);
    if (IN(5)) REPLOOP(5) { CP& p = *kernarg_p(); Ctx c = c0; c.ws = launder(p.ws); unsigned char* ws = c.ws; (void)ws;
        CLK_A(5);
        for (int it = blockIdx.x; it < 512; it += gridDim.x) ssd_out_item(p, c, it >> 7, (it >> 3) & 15, it & 7, rep_ == 0);
        ph_sample_a1(p, c); CLK_B(5); }
    SEAM(5);
    if (IN(6)) REPLOOP(6) { CP& p = *kernarg_p(); Ctx c = c0; c.ws = launder(p.ws); unsigned char* ws = c.ws; (void)ws;
        pg8::Gemm g{(const bf16*)(ws + WS_A1), (const bf16*)(ws + WS_WOUT), MP, D, MIXK, MIXK, MIXK, 1 << 20}; pg8::StaticOrder S; S.init(MP, D, G, blockIdx.x);
        pg8::EpiResid<false, true> E{p.in[I_XP], (void*)(ws + WS_XC), D, modp(c.ws, 0, 0, 2), MODW, nullptr, nullptr};
        pg8::RowScaleHook H{(const float*)(ws + WS_RS)};
        pg8::gemm_phase<pg8::EpiResid<false, true>, true, pg8::RowScaleHook>(c.lds, g, S, E, H);
        float* x1s = (float*)(ws + WS_SMP + SM_X1); const bf16* aa = (const bf16*)(ws + WS_SMP + SM_A1BF);
        if (rep_ == 0) skinny(c, [&](int r, int k) { return *(const bf16x8*)(aa + (size_t)r * MIXK + k); }, (const bf16*)(ws + WS_WOUT), MIXK, MIXK, D, 12, [&](int r, int n, float v) { atomicAdd(x1s + r * D + n, modp(c.ws, 0, 4 + r, 2)[n] * v); });
    }
    SEAM(6);
    if (IN(7)) REPLOOP(7) { CP& p = *kernarg_p(); Ctx c = c0; c.ws = launder(p.ws); unsigned char* ws = c.ws; (void)ws; ph_normmod<true>(p, c, (const void*)(ws + WS_XC), (const float*)(ws + WS_SMP + SM_X1), p.in[I_NMLP], 0, 3, 4, (float*)(ws + WS_SMP + SM_X2)); }
    SEAM(7);
    if (IN(8)) REPLOOP(8) { CP& p = *kernarg_p(); Ctx c = c0; c.ws = launder(p.ws); unsigned char* ws = c.ws; (void)ws;
        pg8::Gemm g{(const bf16*)(ws + WS_A0), (const bf16*)(ws + WS_W1), MP, DFF, D, D, D, 1 << 20, D / 64, D / 64}; pg8::StaticOrder S; S.init(MP, DFF, G, blockIdx.x);
        pg8::EpiBf16<1> E{(bf16*)(ws + WS_HDN), DFF, DFF / 64};
        CLK_A(8);
        pg8::gemm_phase<pg8::EpiBf16<1>>(c.lds, g, S, E, pg8::NoHook(), (unsigned long long*)(ws + WS_CTL + 65536) + 2);
        CLK_B(8);
        float* hacc = (float*)(ws + WS_SMP + SM_H0); const bf16* ua = (const bf16*)(ws + WS_SMP + SM_USBF);
        if (rep_ == 0) skinny(c, [&](int r, int k) { return *(const bf16x8*)(ua + (size_t)r * D + k); }, (const bf16*)(ws + WS_W1), D, D, DFF, 4, [&](int r, int n, float v) { atomicAdd(hacc + (size_t)r * DFF + n, v); }, D / 64);
    }
    SEAM(8);
    if (IN(9)) REPLOOP(9) { CP& p = *kernarg_p(); Ctx c = c0; c.ws = launder(p.ws); unsigned char* ws = c.ws; (void)ws;
        pg8::Gemm g{(const bf16*)(ws + WS_HDN), (const bf16*)(ws + WS_W2), MP, D, DFF, DFF, DFF, 1 << 20, DFF / 64, DFF / 64}; pg8::StaticOrder S; S.init(MP, D, G, blockIdx.x);
        pg8::EpiResid<true, true> E{(const void*)(ws + WS_XC), (void*)(ws + WS_Y), D, modp(c.ws, 0, 0, 5), MODW, nullptr, rep_ == 0 ? (float*)(ws + WS_RS) + MP : nullptr};
        CLK_A(9); CLK_A(19);
        pg8::gemm_phase<pg8::EpiResid<true, true>>(c.lds, g, S, E);
        CLK_B(9);
        float* x2s = (float*)(ws + WS_SMP + SM_X2); const float* hacc = (const float*)(ws + WS_SMP + SM_H0);
        if (rep_ == 0) skinny(c, [&](int r, int k) { return relu2_bf16x8(hacc + (size_t)r * DFF + k); }, (const bf16*)(ws + WS_W2), DFF, DFF, D, 16, [&](int r, int n, float v) { atomicAdd(x2s + r * D + n, modp(c.ws, 0, 4 + r, 5)[n] * v); }, DFF / 64);
        CLK_B(19);
    }
    SEAM(9);
    if (IN(10)) REPLOOP(10) { CP& p = *kernarg_p(); Ctx c = c0; c.ws = launder(p.ws); unsigned char* ws = c.ws; (void)ws; CLK_A(10); ph_pool(p, c); CLK_B(10); }
    SEAM(10);
    if (IN(11)) REPLOOP(11) { CP& p = *kernarg_p(); Ctx c = c0; c.ws = launder(p.ws); unsigned char* ws = c.ws; (void)ws;
        pg8::Gemm g{(const bf16*)(ws + WS_A1), (const bf16*)(ws + WS_WPOOL), MP, D, 512, D, 512, 2}; pg8::StaticOrder S; S.init(MP, D, G, blockIdx.x);
        pg8::EpiResid<true, true> E{(const void*)(ws + WS_Y), (void*)(ws + WS_XC), D, modp(c.ws, 1, 0, 2), MODW, p.in[I_POOLS], nullptr};
        pg8::gemm_phase<pg8::EpiResid<true, true>>(c.lds, g, S, E);
        float* x3s = (float*)(ws + WS_SMP + SM_X3); const float* psc = p.in[I_POOLS]; const bf16* pa = (const bf16*)(ws + WS_SMP + SM_PGBF);
#pragma unroll 1
        for (int gq = 0; gq < 4; ++gq)
            if (rep_ == 0) skinny(c, [&](int r, int k) { return *(const bf16x8*)(pa + (size_t)r * D + gq * 512 + k); }, (const bf16*)(ws + WS_WPOOL) + (size_t)gq * 512 * 512, 512, 512, 512, 4,
                   [&](int r, int n, float v) { const int col = gq * 512 + n; atomicAdd(x3s + r * D + col, modp(c.ws, 1, 4 + r, 2)[col] * psc[col] * v); });
    }
    SEAM(11);
    if (IN(12)) REPLOOP(12) { CP& p = *kernarg_p(); Ctx c = c0; c.ws = launder(p.ws); unsigned char* ws = c.ws; (void)ws; ph_normmod<true>(p, c, (const void*)(ws + WS_XC), (const float*)(ws + WS_SMP + SM_X3), p.in[I_NMLP] + D, 1, 3, 4, p.out + O_YS); }
    SEAM(12);
    if (IN(13)) REPLOOP(13) { CP& p = *kernarg_p(); Ctx c = c0; c.ws = launder(p.ws); unsigned char* ws = c.ws; (void)ws;
        pg8::Gemm g{(const bf16*)(ws + WS_A0), (const bf16*)(ws + WS_W1) + (size_t)DFF * D, MP, DFF, D, D, D, 1 << 20, D / 64, D / 64}; pg8::StaticOrder S; S.init(MP, DFF, G, blockIdx.x);
        pg8::EpiBf16<1> E{(bf16*)(ws + WS_HDN), DFF, DFF / 64};
        pg8::gemm_phase<pg8::EpiBf16<1>>(c.lds, g, S, E);
        float* hacc = (float*)(ws + WS_SMP + SM_H1); const bf16* ua = (const bf16*)(ws + WS_SMP + SM_USBF);
        if (rep_ == 0) skinny(c, [&](int r, int k) { return *(const bf16x8*)(ua + (size_t)r * D + k); }, (const bf16*)(ws + WS_W1) + (size_t)DFF * D, D, D, DFF, 4, [&](int r, int n, float v) { atomicAdd(hacc + (size_t)r * DFF + n, v); }, D / 64);
    }
    SEAM(13);
    if (IN(14)) REPLOOP(14) { CP& p = *kernarg_p(); Ctx c = c0; c.ws = launder(p.ws); unsigned char* ws = c.ws; (void)ws;
        pg8::Gemm g{(const bf16*)(ws + WS_HDN), (const bf16*)(ws + WS_W2) + (size_t)D * DFF, MP, D, DFF, DFF, DFF, 1 << 20, DFF / 64, DFF / 64}; pg8::StaticOrder S; S.init(MP, D, G, blockIdx.x);
        pg8::EpiResid<true, false> E{(const void*)(ws + WS_XC), (void*)(p.out + O_YP), D, modp(c.ws, 1, 0, 5), MODW, nullptr, nullptr};
        pg8::gemm_phase<pg8::EpiResid<true, false>>(c.lds, g, S, E);
        float* ys = p.out + O_YS; const float* hacc = (const float*)(ws + WS_SMP + SM_H1);
        if (rep_ == 0) skinny(c, [&](int r, int k) { return relu2_bf16x8(hacc + (size_t)r * DFF + k); }, (const bf16*)(ws + WS_W2) + (size_t)D * DFF, DFF, DFF, D, 16, [&](int r, int n, float v) { atomicAdd(ys + r * D + n, modp(c.ws, 1, 4 + r, 5)[n] * v); }, DFF / 64);
    }
#if defined(CLKSEL) && CLKSEL >= 4 && CLKSEL != 6
    { XcdBarrier bb_; bb_.bar = (unsigned*)(WS_UNIFORM() + WS_CTL) + 1024; bb_.x = xb_xcc_id(); bb_.st = (volatile LAS unsigned*)(c0.lds + LDS_BYTES - 16); xcd_barrier(bb_); }
    CLK_C(0);
#endif
#undef IN
#undef SEAM
}

extern "C" void kernel_launch(void* const* d_in, const int* in_sizes, int n_in, void* d_out, int out_size, void* d_ws, size_t ws_size, hipStream_t stream) {
    static int grid = 0;
    if (grid == 0) {
        if (n_in != N_IN || (size_t)out_size != O_END || ws_size < WS_END) { fprintf(stderr, "kernel_launch: shape mismatch: n_in %d (want %d), out %d (want %zu), ws %zu (want >= %zu)\n", n_in, (int)N_IN, out_size, (size_t)O_END, ws_size, (size_t)WS_END); grid = -1; return; }
        int dev = 0, cus = 0, per_cu = 0;
        if (hipGetDevice(&dev) != hipSuccess || hipDeviceGetAttribute(&cus, hipDeviceAttributeMultiprocessorCount, dev) != hipSuccess) { grid = -1; return; }
        if (hipFuncSetAttribute((const void*)mk_fwd, hipFuncAttributeMaxDynamicSharedMemorySize, LDS_BYTES) != hipSuccess) { fprintf(stderr, "kernel_launch: hipFuncSetAttribute failed\n"); grid = -1; return; }
        if (hipOccupancyMaxActiveBlocksPerMultiprocessor(&per_cu, (const void*)mk_fwd, NT, LDS_BYTES) != hipSuccess || per_cu < 1) { fprintf(stderr, "kernel_launch: occupancy query says %d blocks per CU\n", per_cu); (void)hipGetLastError(); per_cu = 1; }
        grid = cus;
        fprintf(stderr, "kernel_launch: %d CUs, occupancy query %d per CU, grid %d\n", cus, per_cu, grid);
    }
    if (grid < 0) return;
    if (hipMemsetAsync((char*)d_ws + WS_CTL, 0, WS_MOD + (size_t)2 * 12 * MODW * 4, stream) != hipSuccess) { fprintf(stderr, "kernel_launch: memset failed\n"); return; }
    P a{};
    for (int i = 0; i < N_IN; ++i) a.in[i] = (const float*)d_in[i];
    a.out = (float*)d_out; a.ws = (unsigned char*)d_ws;
#if MK_ONE_LAUNCH
    a.ph_lo = 0; a.ph_hi = NPHASE;
    { void* args[] = {&a}; hipError_t e = hipLaunchCooperativeKernel((const void*)mk_fwd, dim3(grid), dim3(NT), args, LDS_BYTES, stream);
      if (e != hipSuccess) fprintf(stderr, "kernel_launch: cooperative launch failed: %s\n", hipGetErrorString(e)); }
#else
    for (int ph = 0; ph < NPHASE; ++ph) { a.ph_lo = ph; a.ph_hi = ph + 1; void* args[] = {&a};
        hipError_t e = hipLaunchCooperativeKernel((const void*)mk_fwd, dim3(grid), dim3(NT), args, LDS_BYTES, stream);
        if (e != hipSuccess) { fprintf(stderr, "kernel_launch: launch %d failed: %s\n", ph, hipGetErrorString(e)); break; } }
#endif
}
```

```cpp
#include <hip/hip_runtime.h>
#include <hip/hip_cooperative_groups.h>
#include <cstdio>
#include <cstdint>
namespace cg = cooperative_groups;

#ifndef MK_ONE_LAUNCH
#define MK_ONE_LAUNCH 1
#endif

#define LAS __attribute__((address_space(3)))
typedef unsigned short bf16;
typedef short bf16x8 __attribute__((ext_vector_type(8)));
typedef float f32x4 __attribute__((ext_vector_type(4)));
typedef float f32x2 __attribute__((ext_vector_type(2)));
typedef unsigned u32x4 __attribute__((ext_vector_type(4)));
typedef unsigned u32x2 __attribute__((ext_vector_type(2)));

constexpr int D = 2048, BATCH = 4, SEQ = 2048, MP = BATCH * SEQ, SB = 8;
constexpr int NH = 32, HP = 64, SN = 128, SG = 8, INNER = 2048, CONVD = 4096;
constexpr int AH = 24, HD = 128, HPP = 8, AQKV = 3072, AOUT = 1024;
constexpr int INC = 15392, INP = 15616;
constexpr int CZ = 0, CX = 2048, CQ = 6144, CK = 9216, CV = 12288, CDT = 15360;
constexpr int MIXK = 3072, DFF = 8192, MODW = 6 * D;
constexpr float EPS = 1e-6f;
constexpr int NWAVES = 8, NT = 512;

enum { I_XP = 0, I_XS, I_SSM, I_CONV, I_KV128, I_KV512, I_KV2048, I_POOL, I_CP, I_CS, I_RELB, I_ADAW, I_ADAB, I_NMIX, I_NMLP, I_INW, I_CONVW, I_CONVB,
       I_DTB, I_ALOG, I_DSKIP, I_SSDG, I_QG, I_KG, I_OUTW, I_POOLW, I_POOLS, I_W1, I_W2, N_IN };

constexpr size_t O_YP = 0;
constexpr size_t O_YS = O_YP + (size_t)MP * D;
constexpr size_t O_PSSM = O_YS + (size_t)SB * D;
constexpr size_t O_PCONV = O_PSSM + (size_t)BATCH * NH * HP * SN;
constexpr size_t O_PKV128 = O_PCONV + (size_t)BATCH * 3 * CONVD;
constexpr size_t O_PKV512 = O_PKV128 + (size_t)BATCH * 128 * 2048;
constexpr size_t O_PKV2048 = O_PKV512 + (size_t)BATCH * 512 * 2048;
constexpr size_t O_PPOOL = O_PKV2048 + (size_t)BATCH * 2048 * 2048;
constexpr size_t O_SSSM = O_PPOOL + (size_t)BATCH * 15 * D;
constexpr size_t O_SCONV = O_SSSM + (size_t)SB * NH * HP * SN;
constexpr size_t O_SKV128 = O_SCONV + (size_t)SB * 3 * CONVD;
constexpr size_t O_SKV512 = O_SKV128 + (size_t)SB * 128 * 2048;
constexpr size_t O_SKV2048 = O_SKV512 + (size_t)SB * 512 * 2048;
constexpr size_t O_SPOOL = O_SKV2048 + (size_t)SB * 2048 * 2048;
constexpr size_t O_END = O_SPOOL + (size_t)SB * 15 * D;

constexpr size_t MiB = 1u << 20;
constexpr size_t WS_CTL = 0;
constexpr size_t WS_MOD = 1 * MiB;
constexpr size_t WS_WIN = 4 * MiB;
constexpr size_t WS_WOUT = 66 * MiB;
constexpr size_t WS_W1 = 78 * MiB;
constexpr size_t WS_W2 = 142 * MiB;
constexpr size_t WS_WPOOL = 206 * MiB;
constexpr size_t WS_A0 = 208 * MiB;
constexpr size_t WS_SMP = 240 * MiB;
constexpr size_t WS_PROJ = 244 * MiB;
constexpr size_t WS_HDN = WS_PROJ;
constexpr size_t WS_U = WS_PROJ + 128 * MiB;
constexpr size_t WS_XC = 488 * MiB;
constexpr size_t WS_Y = 552 * MiB;
constexpr size_t WS_ATT = 616 * MiB;
constexpr size_t WS_LSE = 664 * MiB;
constexpr size_t WS_DT = 665 * MiB;
constexpr size_t WS_A1 = 668 * MiB;
constexpr size_t WS_END = 716 * MiB;
constexpr size_t SM_USBF = 0;
constexpr size_t SM_PROJ = 64 * 1024;
constexpr size_t SM_XC = 576 * 1024;
constexpr size_t SM_DT = 704 * 1024;
constexpr size_t SM_QK = 708 * 1024;
constexpr size_t SM_Y = 900 * 1024;
constexpr size_t SM_ATT = 964 * 1024;
constexpr size_t SM_LSE = 1060 * 1024;
constexpr size_t SM_A1BF = 1064 * 1024;
constexpr size_t SM_X1 = 1112 * 1024;
constexpr size_t SM_HBF = 1176 * 1024;
constexpr size_t SM_X2 = 1304 * 1024;
constexpr size_t SM_PGBF = 1368 * 1024;
constexpr size_t SM_X3 = 1400 * 1024;
constexpr size_t SM_H0 = 1500 * 1024;
constexpr size_t SM_H1 = 1756 * 1024;
constexpr size_t WS_RS = 667 * MiB;

constexpr int LDS_BYTES = 147456;

struct P { const float* in[N_IN]; float* out; unsigned char* ws; int ph_lo, ph_hi; };
static_assert(sizeof(P) == 8 * (N_IN + 2) + 8, "no padding in P");
typedef const __attribute__((address_space(4))) P CP;

__device__ __forceinline__ float bf2f(unsigned b) { return __uint_as_float(b << 16); }
__device__ __forceinline__ unsigned f2bf(float f) { unsigned u = __float_as_uint(f); return (u + 0x7fffu + ((u >> 16) & 1u)) >> 16; }
typedef float f32x2v_ __attribute__((ext_vector_type(2)));
typedef __bf16 bf16x2v_ __attribute__((ext_vector_type(2)));
__device__ __forceinline__ unsigned pk2(float lo, float hi) { const f32x2v_ v = {lo, hi}; return __builtin_bit_cast(unsigned, __builtin_convertvector(v, bf16x2v_)); }
__device__ __forceinline__ float wave_sum(float v) {
#pragma unroll
    for (int o = 1; o < 64; o <<= 1) v += __shfl_xor(v, o);
    return v;
}
__device__ __forceinline__ float wave_max(float v) {
#pragma unroll
    for (int o = 1; o < 64; o <<= 1) v = fmaxf(v, __shfl_xor(v, o));
    return v;
}
__device__ __forceinline__ float siluf(float x) { return x * __builtin_amdgcn_rcpf(1.f + __expf(-x)); }
__device__ __forceinline__ float softplusf(float x) { return log1pf(__expf(-fabsf(x))) + fmaxf(x, 0.f); }
#define LDS_WAIT() asm volatile("s_waitcnt lgkmcnt(0)" ::: "memory")

namespace pg8 {
constexpr int BM = 256, BK = 64, HALF = 128, HTB = HALF * BK * 2, STAGE_BYTES = 8 * HTB, NXCD = 8, WGM = 4;
__host__ __device__ __forceinline__ int lds_byte(int r, int c) { const int st = (r >> 4) * 2 + (c >> 5), rr = r & 15, cc = c & 31, ob = rr * 64 + cc * 2; return st * 1024 + (ob ^ (((ob >> 9) & 1) << 5)); }
__host__ __device__ __forceinline__ void stage_rc(int b, int& R, int& C) { const int st = b / 1024, sb = b % 1024, swz = sb ^ (((sb >> 9) & 1) << 5); R = (st >> 1) * 16 + swz / 64; C = (st & 1) * 32 + (swz % 64) / 2; }
__host__ __device__ __forceinline__ int perm32(int rho) { const int n = rho >> 4, i = rho & 15; return 8 * (i >> 2) + 4 * n + (i & 3); }
struct Unit { int pm, pn; };
struct Gemm { const bf16* A; const bf16* Bt; int M, N, K, lda, ldb, agrp; int akt = 0, bkt = 0; };
struct StaticOrder {
    int nM, nN, nwg, G, c;
    __device__ void init(int M, int N, int G_, int c_) { nM = M / BM; nN = N / BM; nwg = nM * nN; G = G_; c = c_; }
    __device__ bool next(int i, Unit& u) const {
        const long L = (long)i * G + c; if (L >= nwg) return false;
        int wgid = (int)L; { const int q = nwg / NXCD, r = nwg % NXCD, xcd = wgid % NXCD, off = wgid / NXCD; wgid = (xcd < r ? xcd * (q + 1) : r * (q + 1) + (xcd - r) * q) + off; }
        const int nig = WGM * nN, gid = wgid / nig, fm = gid * WGM, gsz = (nM - fm) < WGM ? (nM - fm) : WGM;
        u.pm = fm + ((wgid % nig) % gsz); u.pn = (wgid % nig) / gsz;
        { const int rot = gid * (nN / NXCD); u.pn = (u.pn + rot) % nN; }
        return true;
    }
};
__device__ __forceinline__ unsigned cvt_pk_bf16(float lo, float hi) { unsigned r; asm volatile("v_cvt_pk_bf16_f32 %0, %1, %2" : "=v"(r) : "v"(lo), "v"(hi)); return r; }

template <int ACT  > struct EpiBf16 {
    static constexpr bool PERM = true;
    bf16* O; int ldc; int okt;
    __device__ __forceinline__ void operator()(const f32x4 (&acc)[2][2][4][2], const Unit& u, int wr, int wc, int fr, int fq) const {
        const int row0 = u.pm * BM + wr * 64 + fr; const int col0 = u.pn * BM + wc * 32 + 8 * fq;
#pragma unroll
        for (int ai = 0; ai < 2; ++ai)
#pragma unroll
            for (int m = 0; m < 4; ++m) { const int rrow = row0 + ai * HALF + m * 16; bf16* rowp = okt ? O + ((size_t)(rrow >> 8) * okt + (col0 >> 6)) * 16384 + (rrow & 255) * 64 + (col0 & 63) : O + (size_t)rrow * ldc + col0;
#pragma unroll
                for (int bj = 0; bj < 2; ++bj) { f32x4 v0 = acc[ai][bj][m][0], v1 = acc[ai][bj][m][1];
                    if (ACT == 1) {
#pragma unroll
                        for (int j = 0; j < 4; ++j) { const float a = fmaxf(v0[j], 0.f), b = fmaxf(v1[j], 0.f); v0[j] = a * a; v1[j] = b * b; } }
                    u32x4 w; w.x = cvt_pk_bf16(v0[0], v0[1]); w.y = cvt_pk_bf16(v0[2], v0[3]); w.z = cvt_pk_bf16(v1[0], v1[1]); w.w = cvt_pk_bf16(v1[2], v1[3]);
                    *(u32x4*)(rowp + (okt ? bj * 2 * 16384 : bj * HALF)) = w; } }
    }
};
template <bool BIN  , bool BOUT  > struct EpiResid {
    static constexpr bool PERM = true;
    const void* base; void* out; int ldc; const float* gate; int gate_bstride; const float* cscale; float* rowss;
    __device__ __forceinline__ void operator()(const f32x4 (&acc)[2][2][4][2], const Unit& u, int wr, int wc, int fr, int fq) const {
        const int row0 = u.pm * BM + wr * 64 + fr, col0 = u.pn * BM + wc * 32 + 8 * fq;
        const float* gp = gate + (size_t)(u.pm / 8) * gate_bstride;
        f32x4 gv[2][2];
#pragma unroll
        for (int bj = 0; bj < 2; ++bj)
#pragma unroll
            for (int n = 0; n < 2; ++n) { gv[bj][n] = *(const f32x4*)(gp + col0 + bj * HALF + 4 * n); if (cscale) gv[bj][n] = gv[bj][n] * *(const f32x4*)(cscale + col0 + bj * HALF + 4 * n); }
#pragma unroll
        for (int ai = 0; ai < 2; ++ai)
#pragma unroll
            for (int m = 0; m < 4; ++m) { const size_t off = (size_t)(row0 + ai * HALF + m * 16) * ldc + col0; float ssq = 0.f;
#pragma unroll
                for (int bj = 0; bj < 2; ++bj) { f32x4 b0, b1;
                    if (BIN) { const u32x4 x = *(const u32x4*)((const bf16*)base + off + bj * HALF);
                        b0 = (f32x4){__uint_as_float(x.x << 16), __uint_as_float(x.x & 0xffff0000u), __uint_as_float(x.y << 16), __uint_as_float(x.y & 0xffff0000u)};
                        b1 = (f32x4){__uint_as_float(x.z << 16), __uint_as_float(x.z & 0xffff0000u), __uint_as_float(x.w << 16), __uint_as_float(x.w & 0xffff0000u)}; }
                    else { b0 = *(const f32x4*)((const float*)base + off + bj * HALF); b1 = *(const f32x4*)((const float*)base + off + bj * HALF + 4); }
                    const f32x4 o0 = b0 + gv[bj][0] * acc[ai][bj][m][0], o1 = b1 + gv[bj][1] * acc[ai][bj][m][1];
                    if (BOUT) { u32x4 w; w.x = cvt_pk_bf16(o0[0], o0[1]); w.y = cvt_pk_bf16(o0[2], o0[3]); w.z = cvt_pk_bf16(o1[0], o1[1]); w.w = cvt_pk_bf16(o1[2], o1[3]); *(u32x4*)((bf16*)out + off + bj * HALF) = w; }
                    else { *(f32x4*)((float*)out + off + bj * HALF) = o0; *(f32x4*)((float*)out + off + bj * HALF + 4) = o1; }
                    ssq += (o0.x * o0.x + o0.y * o0.y) + (o0.z * o0.z + o0.w * o0.w) + (o1.x * o1.x + o1.y * o1.y) + (o1.z * o1.z + o1.w * o1.w); }
                if (rowss) { ssq += __shfl_xor(ssq, 16); ssq += __shfl_xor(ssq, 32); if (fq == 0) atomicAdd(rowss + row0 + ai * HALF + m * 16, ssq); } }
    }
};


struct EpiProj {
    static constexpr bool PERM = true;
    bf16* O; float* dtout; float* out; const float* qg; const float* kg; const float* dtb; LAS float* xch;
    __device__ __forceinline__ void operator()(const f32x4 (&acc)[2][2][4][2], const Unit& u, int wr, int wc, int fr, int fq) const {
        const int rt0 = wr * 64 + fr;
        const int row0 = u.pm * BM + rt0, colt = u.pn * BM, cw8 = wc * 32 + 8 * fq;
        const int b = u.pm >> 3, tb = (u.pm & 7) * BM;
        if (u.pn == 60) {
            if (wc == 0) { const f32x4 b0 = *(const f32x4*)(dtb + 8 * fq), b1 = *(const f32x4*)(dtb + 8 * fq + 4);
#pragma unroll
                for (int ai = 0; ai < 2; ++ai)
#pragma unroll
                    for (int m = 0; m < 4; ++m) { float* d = dtout + (size_t)(row0 + ai * HALF + m * 16) * 32 + 8 * fq; const f32x4 v0 = acc[ai][0][m][0] + b0, v1 = acc[ai][0][m][1] + b1;
                        *(f32x4*)d = (f32x4){softplusf(v0.x), softplusf(v0.y), softplusf(v0.z), softplusf(v0.w)}; *(f32x4*)(d + 4) = (f32x4){softplusf(v1.x), softplusf(v1.y), softplusf(v1.z), softplusf(v1.w)}; } }
            return;
        }
        const bool isq = u.pn >= 24 && u.pn < 36, isk = u.pn >= 36 && u.pn < 48, isv = u.pn >= 48, isx = u.pn >= 8 && u.pn < 24;
        float scl[2][4][2];
        f32x4 g0 = (f32x4){1.f, 1.f, 1.f, 1.f}, g1 = g0;
        if (isq || isk) {
#pragma unroll
            for (int ai = 0; ai < 2; ++ai)
#pragma unroll
                for (int m = 0; m < 4; ++m)
#pragma unroll
                    for (int bj = 0; bj < 2; ++bj) { const f32x4 a = acc[ai][bj][m][0], c2 = acc[ai][bj][m][1];
                        float ssq = (a.x * a.x + a.y * a.y) + (a.z * a.z + a.w * a.w) + (c2.x * c2.x + c2.y * c2.y) + (c2.z * c2.z + c2.w * c2.w);
                        ssq += __shfl_xor(ssq, 16); ssq += __shfl_xor(ssq, 32);
                        if (fq == 0) xch[((ai * HALF + rt0 + m * 16) * 2 + bj) * 4 + wc] = ssq; }
            asm volatile("s_waitcnt lgkmcnt(0)" ::: "memory"); __builtin_amdgcn_s_barrier(); asm volatile("" ::: "memory");
#pragma unroll
            for (int ai = 0; ai < 2; ++ai)
#pragma unroll
                for (int m = 0; m < 4; ++m)
#pragma unroll
                    for (int bj = 0; bj < 2; ++bj) { const f32x4 pz = *(const LAS f32x4*)(xch + ((ai * HALF + rt0 + m * 16) * 2 + bj) * 4);
                        scl[ai][m][bj] = rsqrtf(((pz.x + pz.y) + (pz.z + pz.w)) * (1.f / 128.f) + 1e-6f); }
            const float* gp = (isq ? qg : kg) + cw8; g0 = *(const f32x4*)gp; g1 = *(const f32x4*)(gp + 4);
        } else {
#pragma unroll
            for (int ai = 0; ai < 2; ++ai)
#pragma unroll
                for (int m = 0; m < 4; ++m) { scl[ai][m][0] = 1.f; scl[ai][m][1] = 1.f; }
        }
#pragma unroll
        for (int ai = 0; ai < 2; ++ai)
#pragma unroll
            for (int m = 0; m < 4; ++m) { const int rr = ai * HALF + m * 16; bf16* rowp = O + (size_t)(row0 + rr) * ldo() + colt + cw8; const int t = tb + rt0 + rr;
#pragma unroll
                for (int bj = 0; bj < 2; ++bj) { const f32x4 v0 = acc[ai][bj][m][0] * scl[ai][m][bj] * g0, v1 = acc[ai][bj][m][1] * scl[ai][m][bj] * g1;
                    u32x4 w; w.x = cvt_pk_bf16(v0[0], v0[1]); w.y = cvt_pk_bf16(v0[2], v0[3]); w.z = cvt_pk_bf16(v1[0], v1[1]); w.w = cvt_pk_bf16(v1[2], v1[3]);
                    *(u32x4*)(rowp + bj * HALF) = w;
                    if (isk || isv) { const int hd = (u.pn - (isk ? 36 : 48)) * 2 + bj, gi = hd >> 3, slot = hd & 7, W = gi == 0 ? 128 : (gi == 1 ? 512 : 2048);
                        if (t >= 2048 - W) { float* o = out + (gi == 0 ? O_PKV128 : (gi == 1 ? O_PKV512 : O_PKV2048)) + (((size_t)b * W + (t - (2048 - W))) * 2 + (isv ? 1 : 0)) * 1024 + slot * 128 + cw8;
                            *(f32x4*)o = v0; *(f32x4*)(o + 4) = v1; } }
                    if (isx && t >= 2045) { float* o = out + O_PCONV + ((size_t)b * 3 + (t - 2045)) * 4096 + (colt - 2048) + bj * HALF + cw8; *(f32x4*)o = v0; *(f32x4*)(o + 4) = v1; } } }
    }
    __device__ __forceinline__ static constexpr int ldo() { return 15616; }
};

struct NoHook { static constexpr int T = -1; __device__ __forceinline__ void operator()(f32x4 (&)[2][2][4][2], const Unit&, int, int) const {} };
struct RowScaleHook { static constexpr int T = 32; const float* ss;
    __device__ __forceinline__ void operator()(f32x4 (&acc)[2][2][4][2], const Unit& u, int wr, int fr) const {
#pragma unroll
        for (int ai = 0; ai < 2; ++ai)
#pragma unroll
            for (int m = 0; m < 4; ++m) { const float rs = rsqrtf(ss[u.pm * BM + ai * HALF + wr * 64 + m * 16 + fr] * (1.f / 2048.f) + 1e-6f);
#pragma unroll
                for (int bj = 0; bj < 2; ++bj)
#pragma unroll
                    for (int n = 0; n < 2; ++n) acc[ai][bj][m][n] = acc[ai][bj][m][n] * rs; } } };
template <class Epi, bool ALIGN_EPI = true, class Hook = NoHook>
__device__ __forceinline__ void gemm_phase(LAS unsigned char* lds, const Gemm g, const StaticOrder& S, const Epi& E, const Hook& H = Hook(), unsigned long long* clkq = nullptr) {
#ifdef CLKSEL
    volatile LAS unsigned* clk_w = (volatile LAS unsigned*)(lds + 147456 - 8);
#define CLK_SET() do { if (clkq && tid == 0) clk_w[0] = (unsigned)__builtin_readcyclecounter(); } while (0)
#define CLK_ACC() do { if (clkq && tid == 0) clk_w[1] = clk_w[1] + ((unsigned)__builtin_readcyclecounter() - clk_w[0]); } while (0)
#endif
    const int tid = threadIdx.x, wid = __builtin_amdgcn_readfirstlane(tid >> 6), lane = tid & 63, wr = wid >> 2, wc = wid & 3, fr = lane & 15, fq = lane >> 4;
    const int K = g.K, nt = K / BK;
    unsigned voffA[2], voffB[2];
#pragma unroll
    for (int i = 0; i < 2; ++i) { int R, C; stage_rc(tid * 16 + i * 8192, R, C); const int Rb = Epi::PERM ? ((R & ~31) + perm32(R & 31)) : R;
        voffA[i] = (unsigned)(R * (g.akt ? 64 : g.lda) + C) * 2u; voffB[i] = (unsigned)(Rb * (g.bkt ? 64 : g.ldb) + C) * 2u; }
    const size_t kstepA = g.akt ? (size_t)32768 : (size_t)(BK * 2), kstepB = g.bkt ? (size_t)32768 : (size_t)(BK * 2);
    const size_t hstepA = (size_t)HALF * (g.akt ? 64 : g.lda) * 2, hstepB = (size_t)HALF * (g.bkt ? 64 : g.ldb) * 2;
    const size_t tstepA = g.akt ? (size_t)g.akt * 32768 : 2 * hstepA, tstepB = g.bkt ? (size_t)g.bkt * 32768 : 2 * hstepB;
    const unsigned ldsw = (unsigned)wid * 1024u;
    const int aoff = lds_byte(wr * 64 + fr, fq * 8), boff = lds_byte(wc * 32 + fr, fq * 8);
#define PG8_SA(b, h) (((b) * 2 + (h)) * HTB)
#define PG8_SB(b, h) ((4 + (b) * 2 + (h)) * HTB)
#define PG8_STAGE(bufoff, gbase, voff) do { _Pragma("unroll") for (int _i = 0; _i < 2; ++_i) \
        __builtin_amdgcn_global_load_lds((const unsigned*)((const char*)(gbase) + (voff)[_i]), (LAS unsigned*)(lds + (bufoff) + ldsw + _i * 8192), 16, 0, 0); } while (0)
#define PG8_LDA(dst, b, h) do { _Pragma("unroll") for (int m = 0; m < 4; ++m) _Pragma("unroll") for (int k = 0; k < 2; ++k) dst[m][k] = *(const LAS bf16x8*)(lds + PG8_SA(b, h) + aoff + m * 2048 + k * 1024); } while (0)
#define PG8_LDB(dst, b, h) do { _Pragma("unroll") for (int n = 0; n < 2; ++n) _Pragma("unroll") for (int k = 0; k < 2; ++k) dst[n][k] = *(const LAS bf16x8*)(lds + PG8_SB(b, h) + boff + n * 2048 + k * 1024); } while (0)
#define PG8_MMA(ai, bj, At, Bt) do { __builtin_amdgcn_s_setprio(1); _Pragma("unroll") for (int m = 0; m < 4; ++m) _Pragma("unroll") for (int n = 0; n < 2; ++n) _Pragma("unroll") for (int k = 0; k < 2; ++k) \
        acc[ai][bj][m][n] = __builtin_amdgcn_mfma_f32_16x16x32_bf16(Bt[n][k], At[m][k], acc[ai][bj][m][n], 0, 0, 0); __builtin_amdgcn_s_setprio(0); } while (0)
#define PG8_WAIT_V(n) asm volatile("s_waitcnt vmcnt(" #n ")" ::: "memory")
#define PG8_WAIT_L(n) asm volatile("s_waitcnt lgkmcnt(" #n ")" ::: "memory")
#define PG8_BAR __builtin_amdgcn_s_barrier()
#define PG8_SCHED __builtin_amdgcn_sched_barrier(0)
    Unit cur, nxt; int ui = 0;
    if (!S.next(0, cur)) return;
    f32x4 acc[2][2][4][2];
#pragma unroll
    for (int a = 0; a < 2; ++a)
#pragma unroll
        for (int b = 0; b < 2; ++b)
#pragma unroll
            for (int m = 0; m < 4; ++m)
#pragma unroll
                for (int n = 0; n < 2; ++n) acc[a][b][m][n] = (f32x4){0.f, 0.f, 0.f, 0.f};
    bf16x8 At[4][2], B0[2][2], B1[2][2];
    const char* cA = (const char*)g.A + (size_t)cur.pm * tstepA + (size_t)(cur.pn / g.agrp) * (K / BK) * kstepA; const char* cB = (const char*)g.Bt + (size_t)cur.pn * tstepB;
    PG8_STAGE(PG8_SB(0, 0), cB, voffB); PG8_STAGE(PG8_SB(0, 1), cB + hstepB, voffB); PG8_STAGE(PG8_SA(0, 0), cA, voffA); PG8_STAGE(PG8_SA(0, 1), cA + hstepA, voffA);
    if (wr == 1) PG8_BAR;
    PG8_WAIT_V(2); PG8_BAR;
    PG8_STAGE(PG8_SB(1, 0), cB + kstepB, voffB); PG8_STAGE(PG8_SA(1, 0), cA + kstepA, voffA); PG8_STAGE(PG8_SB(1, 1), cB + hstepB + kstepB, voffB);
    PG8_WAIT_V(6); PG8_BAR;
    for (;;) {
#ifdef CLKSEL
        if (CLKSEL == 1) CLK_SET();
#endif
        const bool has_next = S.next(ui + 1, nxt);
        const char* nA = has_next ? (const char*)g.A + (size_t)nxt.pm * tstepA + (size_t)(nxt.pn / g.agrp) * (K / BK) * kstepA : cA; const char* nB = has_next ? (const char*)g.Bt + (size_t)nxt.pn * tstepB : cB;
        for (int t = 0; t < nt; t += 2) {
            const bool last = (t == nt - 2);
            if constexpr (Hook::T >= 0) { if (t == Hook::T) H(acc, cur, wr, fr); }
            const char* a1 = cA + (size_t)(t + 1) * kstepA;
            const char* a2 = last ? nA : cA + (size_t)(t + 2) * kstepA; const char* b2 = last ? nB : cB + (size_t)(t + 2) * kstepB;
            const char* a3 = a2 + kstepA; const char* b3 = b2 + kstepB;
            PG8_LDB(B0, 0, 0); PG8_LDB(B1, 0, 1); PG8_SCHED; PG8_LDA(At, 0, 0); PG8_STAGE(PG8_SA(1, 1), a1 + hstepA, voffA);
            PG8_WAIT_V(8); PG8_WAIT_L(0); PG8_BAR; PG8_MMA(0, 0, At, B0); PG8_MMA(0, 1, At, B1); PG8_BAR; PG8_SCHED;
            PG8_LDA(At, 0, 1); PG8_STAGE(PG8_SB(0, 0), b2, voffB); PG8_STAGE(PG8_SB(0, 1), b2 + hstepB, voffB); PG8_STAGE(PG8_SA(0, 0), a2, voffA);
            PG8_WAIT_V(8); PG8_WAIT_L(0); PG8_BAR; PG8_MMA(1, 0, At, B0); PG8_MMA(1, 1, At, B1); PG8_BAR; PG8_SCHED;
            PG8_LDB(B0, 1, 0); PG8_LDB(B1, 1, 1); PG8_SCHED; PG8_LDA(At, 1, 0); PG8_STAGE(PG8_SA(0, 1), a2 + hstepA, voffA);
            PG8_WAIT_V(8); PG8_WAIT_L(0); PG8_BAR; PG8_MMA(0, 0, At, B0); PG8_MMA(0, 1, At, B1); PG8_BAR; PG8_SCHED;
            PG8_LDA(At, 1, 1); PG8_STAGE(PG8_SB(1, 0), b3, voffB); PG8_STAGE(PG8_SB(1, 1), b3 + hstepB, voffB); PG8_STAGE(PG8_SA(1, 0), a3, voffA);
            PG8_WAIT_V(8); PG8_WAIT_L(0); PG8_BAR; PG8_MMA(1, 0, At, B0); PG8_MMA(1, 1, At, B1); PG8_BAR; PG8_SCHED;
#ifdef CLKSEL
            if (t == 0) { if (CLKSEL == 1) CLK_ACC(); if (CLKSEL == 0) CLK_SET(); }
#endif
        }
#ifdef CLKSEL
        if (CLKSEL == 0) CLK_ACC(); if (CLKSEL == 2) CLK_SET();
#endif
        if constexpr (ALIGN_EPI) { if (wr == 0) PG8_BAR; }
        E(acc, cur, wr, wc, fr, fq);
#ifdef CLKSEL
        if (CLKSEL == 2) CLK_ACC();
#endif
        if (!has_next) break;
#pragma unroll
        for (int a = 0; a < 2; ++a)
#pragma unroll
            for (int b = 0; b < 2; ++b)
#pragma unroll
                for (int m = 0; m < 4; ++m)
#pragma unroll
                    for (int n = 0; n < 2; ++n) acc[a][b][m][n] = (f32x4){0.f, 0.f, 0.f, 0.f};
        cur = nxt; cA = nA; cB = nB; ++ui;
        if constexpr (ALIGN_EPI) { if (wr == 1) PG8_BAR; }
    }
    PG8_WAIT_V(0);
    if constexpr (!ALIGN_EPI) { if (wr == 0) PG8_BAR; }
    PG8_BAR;
#ifdef CLKSEL
    if (clkq && blockIdx.x == 0 && tid == 0) { clkq[0] = clk_w[1]; }
#endif
#undef PG8_SA
#undef PG8_SB
#undef PG8_STAGE
#undef PG8_LDA
#undef PG8_LDB
#undef PG8_MMA
#undef PG8_WAIT_V
#undef PG8_WAIT_L
#undef PG8_BAR
#undef PG8_SCHED
}
}


#define XB_TMO      128
#define XB_XCNT(j)  (256  + 64 * (j))
#define XB_XSUB(j)  (1280 + 64 * (j))
#define XB_XGEN(j)  (2304 + 64 * (j))
#define XB_TOP      3328
#define XB_TOPGEN   3392
#define XCD_BAR_WORDS 3456
#define XB_SPIN_CAP (1u << 18)
__device__ __forceinline__ unsigned xb_ld(unsigned* p)              { return __hip_atomic_load(p, __ATOMIC_RELAXED, __HIP_MEMORY_SCOPE_AGENT); }
__device__ __forceinline__ unsigned xb_add(unsigned* p, unsigned v) { return __hip_atomic_fetch_add(p, v, __ATOMIC_RELAXED, __HIP_MEMORY_SCOPE_AGENT); }
__device__ __forceinline__ unsigned xb_xcc_id() { return (unsigned)__builtin_amdgcn_s_getreg((3 << 11) | 20) & 0xFu; }
#define XB_SPIN(cond, bar) do { unsigned _sp = 0; while (cond) { __builtin_amdgcn_s_sleep(1); \
    if ((++_sp & 255u) == 0u) { if (xb_ld(&(bar)[XB_TMO])) break; if (_sp > XB_SPIN_CAP) { atomicAdd(&(bar)[XB_TMO], 1u); break; } } } } while (0)
struct XcdBarrier { unsigned* bar; unsigned x; volatile LAS unsigned* st; };
__device__ __forceinline__ XcdBarrier xcd_barrier_post(unsigned* bar, volatile LAS unsigned* st) {
    XcdBarrier b; b.bar = bar; b.x = xb_xcc_id(); b.st = st;
    if (threadIdx.x == 0) (void)xb_add(&bar[XB_XCNT(b.x)], 1u);
    return b;
}
__device__ __forceinline__ void xcd_barrier_complete(unsigned* bar, unsigned x, unsigned& nloc, unsigned& nx) {
    const unsigned G = gridDim.x * gridDim.y * gridDim.z;
    unsigned sum, cnt, mine, sp = 0u;
    for (;;) {
        sum = 0u; cnt = 0u; mine = 0u;
#pragma unroll
        for (unsigned j = 0; j < 16; ++j) { const unsigned c = xb_ld(&bar[XB_XCNT(j)]); sum += c; cnt += (c > 0u) ? 1u : 0u; mine = (j == x) ? c : mine; }
        if (sum == G) break;
        __builtin_amdgcn_s_sleep(1);
        if ((++sp & 255u) == 0u) { if (xb_ld(&bar[XB_TMO])) break; if (sp > XB_SPIN_CAP) { atomicAdd(&bar[XB_TMO], 1u); break; } }
    }
    nloc = mine > 0u ? mine : 1u; nx = cnt > 0u ? cnt : 1u;
}
__device__ __forceinline__ void xcd_barrier(const XcdBarrier& b) {
    asm volatile("s_waitcnt vmcnt(0)" ::: "memory");
    __syncthreads();
    if (threadIdx.x == 0) {
        unsigned* bar = b.bar;
        __builtin_amdgcn_s_waitcnt(0);
        unsigned nloc = b.st[0], nx = b.st[1];
        if (nloc == 0u) { xcd_barrier_complete(bar, b.x, nloc, nx); b.st[0] = nloc; b.st[1] = nx; }
        const unsigned old = xb_add(&bar[XB_XSUB(b.x)], 1u);
        const unsigned gen = old / nloc;
        if (old + 1u == (gen + 1u) * nloc) {
            __builtin_amdgcn_fence(__ATOMIC_RELEASE, "agent");
            asm volatile("s_waitcnt vmcnt(0)" ::: "memory");
            const unsigned og = xb_add(&bar[XB_TOP], 1u);
            const unsigned tg = og / nx;
            if (og + 1u == (tg + 1u) * nx) xb_add(&bar[XB_TOPGEN], 1u);
            else XB_SPIN(xb_ld(&bar[XB_TOPGEN]) == tg, bar);
            __builtin_amdgcn_fence(__ATOMIC_ACQUIRE, "agent");
            xb_add(&bar[XB_XGEN(b.x)], 1u);
            asm volatile("s_waitcnt vmcnt(0)" ::: "memory");
        } else {
            XB_SPIN(xb_ld(&bar[XB_XGEN(b.x)]) == gen, bar);
            __builtin_amdgcn_fence(__ATOMIC_ACQUIRE, "agent");
            asm volatile("s_waitcnt vmcnt(0)" ::: "memory");
        }
    }
    __syncthreads();
}

struct Ctx { int tid, lane, wave, gw, ngw; LAS unsigned char* lds; unsigned char* ws; };

template <class LA, class F> __device__ __forceinline__ void skinny(const Ctx& c, LA&& aload, const bf16* WT, int ldb, int K, int N, int KS, F&& epi, int bkt = 0) {
    const int lane = c.lane, ncg = N / 16, kl = K / KS;
    for (int it = c.gw; it < ncg * KS; it += c.ngw) {
        const int cg = it % ncg, kb = (it / ncg) * kl;
        f32x4 acc = (f32x4){0.f, 0.f, 0.f, 0.f};
        const int nn = cg * 16 + (lane & 15);
        const bf16* bp = bkt ? WT + ((size_t)(nn >> 8) * bkt + (kb >> 6)) * 16384 + (nn & 255) * 64 + 8 * (lane >> 4) : WT + (size_t)nn * ldb + kb + 8 * (lane >> 4);
#pragma unroll 8
        for (int k0 = 0; k0 < kl; k0 += 32) { const bf16x8 av = aload(lane & 7, kb + k0 + 8 * (lane >> 4)), bv = *(const bf16x8*)(bp + (bkt ? (k0 >> 6) * 16384 + (k0 & 63) : k0)); acc = __builtin_amdgcn_mfma_f32_16x16x32_bf16(av, bv, acc, 0, 0, 0); }
        if ((lane >> 4) < 2) {
#pragma unroll
            for (int j = 0; j < 4; ++j) epi((lane >> 4) * 4 + j, cg * 16 + (lane & 15), acc[j]);
        }
    }
}
__device__ __forceinline__ bf16x8 relu2_bf16x8(const float* q) { const f32x4 a = *(const f32x4*)q, b = *(const f32x4*)(q + 4);
    u32x4 w; float t0, t1;
    t0 = fmaxf(a.x, 0.f); t1 = fmaxf(a.y, 0.f); w.x = pk2(t0 * t0, t1 * t1); t0 = fmaxf(a.z, 0.f); t1 = fmaxf(a.w, 0.f); w.y = pk2(t0 * t0, t1 * t1);
    t0 = fmaxf(b.x, 0.f); t1 = fmaxf(b.y, 0.f); w.z = pk2(t0 * t0, t1 * t1); t0 = fmaxf(b.z, 0.f); t1 = fmaxf(b.w, 0.f); w.w = pk2(t0 * t0, t1 * t1);
    return __builtin_bit_cast(bf16x8, w); }

__device__ __forceinline__ void load_row(const float* row, f32x4 (&v)[8], int lane) {
#pragma unroll
    for (int j = 0; j < 8; ++j) v[j] = ((const f32x4*)row)[lane + 64 * j];
}
__device__ __forceinline__ void load_row_bf16(const bf16* row, f32x4 (&v)[8], int lane) {
#pragma unroll
    for (int j = 0; j < 8; ++j) { const u32x2 x = ((const u32x2*)row)[lane + 64 * j]; v[j] = (f32x4){__uint_as_float(x.x << 16), __uint_as_float(x.x & 0xffff0000u), __uint_as_float(x.y << 16), __uint_as_float(x.y & 0xffff0000u)}; }
}
__device__ __forceinline__ float row_rs(const f32x4 (&v)[8]) {
    float s = 0.f;
#pragma unroll
    for (int j = 0; j < 8; ++j) s += (v[j].x * v[j].x + v[j].y * v[j].y) + (v[j].z * v[j].z + v[j].w * v[j].w);
    return rsqrtf(wave_sum(s) * (1.f / D) + EPS);
}
__device__ __forceinline__ void normmod(f32x4 (&v)[8], const float* g, const float* sc, const float* sh, int lane) {
    const float rs = row_rs(v);
#pragma unroll
    for (int j = 0; j < 8; ++j) { const int c = 4 * (lane + 64 * j); const f32x4 gg = *(const f32x4*)(g + c), s1 = *(const f32x4*)(sc + c), s0 = *(const f32x4*)(sh + c);
        v[j] = v[j] * rs * gg * (s1 + 1.f) + s0; }
}
__device__ __forceinline__ void store_row_bf16(bf16* row, const f32x4 (&v)[8], int lane) {
#pragma unroll
    for (int j = 0; j < 8; ++j) { u32x2 w; w.x = pk2(v[j].x, v[j].y); w.y = pk2(v[j].z, v[j].w); ((u32x2*)row)[lane + 64 * j] = w; }
}
__device__ __forceinline__ void store_row_bf16_tiled(bf16* base, int m, const f32x4 (&v)[8], int lane) {
#pragma unroll
    for (int j = 0; j < 8; ++j) { const int col = 4 * (lane + 64 * j); u32x2 w; w.x = pk2(v[j].x, v[j].y); w.y = pk2(v[j].z, v[j].w);
        *(u32x2*)(base + ((size_t)(m >> 8) * 32 + (col >> 6)) * 16384 + (m & 255) * 64 + (col & 63)) = w; }
}
__device__ __forceinline__ void store_row_f32(float* row, const f32x4 (&v)[8], int lane) {
#pragma unroll
    for (int j = 0; j < 8; ++j) ((f32x4*)row)[lane + 64 * j] = v[j];
}

__device__ __forceinline__ const float* modp(const unsigned char* ws, int layer, int r, int chunk) { return (const float*)(ws + WS_MOD) + ((size_t)(layer * 12 + r) * 6 + chunk) * D; }

struct TDesc { const float* W; bf16* WT; const float* ks; int N, ldt, row0, k0, n0, tkt; };
__device__ __forceinline__ TDesc tdecode(CP& p, const Ctx& c, int it) {
    constexpr int I_IN = (D / 64) * (INC / 32), I_OUT = (MIXK / 64) * (D / 32), I_1 = (D / 64) * (DFF / 32), I_2 = (DFF / 64) * (D / 32), I_P = (512 / 64) * (512 / 32);
    TDesc d; d.ks = nullptr; d.tkt = 0; d.row0 = 0; int r = it;
    if (r < I_IN) { const int nb = INC / 32, n0 = (r % nb) * 32; const int nd = n0 < 6144 ? n0 : (n0 < 6176 ? CDT + (n0 - 6144) : n0 - 32);
        d.W = p.in[I_INW]; d.N = INC; d.WT = (bf16*)(c.ws + WS_WIN); d.ldt = D; d.row0 = nd - n0; d.k0 = (r / nb) * 64; d.n0 = n0; d.tkt = D / 64; return d; } r -= I_IN;
    if (r < I_OUT) { const int nb = D / 32; d.W = p.in[I_OUTW]; d.N = D; d.WT = (bf16*)(c.ws + WS_WOUT); d.ldt = MIXK; d.k0 = (r / nb) * 64; d.n0 = (r % nb) * 32; if (d.k0 < INNER) d.ks = p.in[I_SSDG]; return d; } r -= I_OUT;
    if (r < 2 * I_1) { const int l = r / I_1, q = r % I_1, nb = DFF / 32; d.W = p.in[I_W1] + (size_t)l * D * DFF; d.N = DFF; d.WT = (bf16*)(c.ws + WS_W1) + (size_t)l * DFF * D; d.ldt = D; d.k0 = (q / nb) * 64; d.n0 = (q % nb) * 32; d.tkt = D / 64; return d; } r -= 2 * I_1;
    if (r < 2 * I_2) { const int l = r / I_2, q = r % I_2, nb = D / 32; d.W = p.in[I_W2] + (size_t)l * DFF * D; d.N = D; d.WT = (bf16*)(c.ws + WS_W2) + (size_t)l * D * DFF; d.ldt = DFF; d.k0 = (q / nb) * 64; d.n0 = (q % nb) * 32; d.tkt = DFF / 64; return d; } r -= 2 * I_2;
    { const int gq = r / I_P, q = r % I_P, nb = 512 / 32; d.W = p.in[I_POOLW] + (size_t)gq * 512 * 512; d.N = 512; d.WT = (bf16*)(c.ws + WS_WPOOL) + (size_t)gq * 512 * 512; d.ldt = 512; d.k0 = (q / nb) * 64; d.n0 = (q % nb) * 32; return d; }
}
__device__ __forceinline__ void tload(const TDesc& d, int lane, float (&v)[32]) {
    const float* wp = d.W + (size_t)(d.k0 + (lane >> 5)) * d.N + d.n0 + (lane & 31);
#pragma unroll
    for (int i = 0; i < 32; ++i) v[i] = __builtin_nontemporal_load(wp + (size_t)(2 * i) * d.N);
}
__device__ __forceinline__ void tstore(const TDesc& d, LAS float* scr, int lane, const float (&v)[32]) {
#pragma unroll
    for (int i = 0; i < 32; ++i) { const int kk = 2 * i + (lane >> 5); float wv = v[i]; if (d.ks) wv *= d.ks[d.k0 + kk]; scr[kk * 33 + (lane & 31)] = wv; }
    LDS_WAIT();
    const int cc = lane & 7;
#pragma unroll
    for (int j = 0; j < 4; ++j) { const int n = (lane >> 3) + 8 * j; const LAS float* s = scr + (8 * cc) * 33 + n;
        u32x4 o; o.x = pk2(s[0 * 33], s[1 * 33]); o.y = pk2(s[2 * 33], s[3 * 33]); o.z = pk2(s[4 * 33], s[5 * 33]); o.w = pk2(s[6 * 33], s[7 * 33]);
        const int nn = d.row0 + d.n0 + n;
        *(u32x4*)(d.tkt ? d.WT + ((size_t)(nn >> 8) * d.tkt + (d.k0 >> 6)) * 16384 + (nn & 255) * 64 + 8 * cc : d.WT + (size_t)nn * d.ldt + d.k0 + 8 * cc) = o; }
    LDS_WAIT();
}

__device__ __forceinline__ void ph_prologue(CP& p, const Ctx& c) {
    const int lane = c.lane, wave = c.wave, tid = c.tid;
    const float* const cpp_ = p.in[I_CP]; const float* const csp_ = p.in[I_CS];
    __syncthreads();
    for (int it = blockIdx.x; it < 768; it += gridDim.x) {
        const int kq = it & 7, cgp = (it >> 3) % 48, layer = it / 384, n0 = cgp * 256, kb = kq * 256 + wave * 32;
        LAS float* cs = (LAS float*)c.lds + wave * (12 * 32);
        for (int i = lane; i < 12 * 32; i += 64) { const int r = i >> 5, k = kb + (i & 31); const float cv = r < 4 ? cpp_[r * D + k] : csp_[(r - 4) * D + k]; cs[i] = siluf(cv); }
        LDS_WAIT();
        f32x4 acc[12];
#pragma unroll
        for (int r = 0; r < 12; ++r) acc[r] = (f32x4){0.f, 0.f, 0.f, 0.f};
        const float* W = p.in[I_ADAW] + (size_t)layer * D * MODW + (size_t)kb * MODW + n0 + lane * 4;
#pragma unroll
        for (int h = 0; h < 2; ++h) { f32x4 w[16];
#pragma unroll
            for (int kk = 0; kk < 16; ++kk) w[kk] = __builtin_nontemporal_load((const f32x4*)(W + (size_t)(16 * h + kk) * MODW));
#pragma unroll
            for (int kk = 0; kk < 16; ++kk)
#pragma unroll
                for (int r = 0; r < 12; ++r) acc[r] += w[kk] * cs[r * 32 + 16 * h + kk]; }
        __syncthreads();
        LAS f32x4* red = (LAS f32x4*)(c.lds + 16384);
#pragma unroll
        for (int r = 0; r < 12; ++r) red[(wave * 12 + r) * 64 + lane] = acc[r];
        __syncthreads();
        for (int o = tid; o < 12 * 256; o += NT) { const int r = o >> 8, cc = o & 255; float sacc = kq == 0 ? p.in[I_ADAB][layer * MODW + n0 + cc] : 0.f;
#pragma unroll
            for (int w = 0; w < 8; ++w) sacc += ((LAS float*)(c.lds + 16384))[(w * 12 + r) * 256 + cc];
            atomicAdd((float*)(c.ws + WS_MOD) + (size_t)(layer * 12 + r) * MODW + n0 + cc, sacc); }
        __syncthreads();
    }
    {
        LAS float* scr = (LAS float*)(c.lds + wave * 16384);
        constexpr int NITEMS = (D / 64) * (INC / 32) + (MIXK / 64) * (D / 32) + 2 * (D / 64) * (DFF / 32) + 2 * (DFF / 64) * (D / 32) + 4 * (512 / 64) * (512 / 32);
        int it = c.gw;
        if (it < NITEMS) {
            TDesc d = tdecode(p, c, it); float v[32]; tload(d, lane, v);
#pragma clang loop unroll(disable)
            for (;;) { const int itn = it + c.ngw; TDesc dn = d; float vn[32];
                if (itn < NITEMS) { dn = tdecode(p, c, itn); tload(dn, lane, vn); }
                tstore(d, scr, lane, v);
                if (itn >= NITEMS) break;
                d = dn; it = itn;
#pragma unroll
                for (int i = 0; i < 32; ++i) v[i] = vn[i]; }
        }
    }
    { const int gt = blockIdx.x * NT + tid, gn = gridDim.x * NT;
      f32x4* z0 = (f32x4*)(c.ws + WS_SMP + SM_PROJ); for (int i = gt; i < SB * INP / 4; i += gn) z0[i] = (f32x4){0.f, 0.f, 0.f, 0.f};
      f32x4* z1 = (f32x4*)(c.ws + WS_SMP + SM_H0); for (int i = gt; i < 2 * SB * DFF / 4; i += gn) z1[i] = (f32x4){0.f, 0.f, 0.f, 0.f};
      f32x4* z2 = (f32x4*)(c.ws + WS_RS); for (int i = gt; i < 4 * MP / 4; i += gn) z2[i] = (f32x4){0.f, 0.f, 0.f, 0.f}; }
    { bf16* wt = (bf16*)(c.ws + WS_WIN) + (size_t)60 * 32 * 16384;
      for (int i = blockIdx.x * NT + tid; i < 32 * 224 * 8; i += gridDim.x * NT) { const int kt = i / (224 * 8), rem = i % (224 * 8), row = 32 + rem / 8, cc = rem % 8; *(u32x4*)(wt + (size_t)kt * 16384 + row * 64 + cc * 8) = (u32x4){0u, 0u, 0u, 0u}; } }
}

template <bool XBF> __device__ __forceinline__ void ph_normmod(CP& p, const Ctx& c, const void* xp, const float* xs, const float* g, int layer, int csh, int csc, float* xs_copy) {
    for (int m = c.gw; m < MP + SB; m += c.ngw) {
        f32x4 v[8];
        if (m < MP) { if (XBF) load_row_bf16((const bf16*)xp + (size_t)m * D, v, c.lane); else load_row((const float*)xp + (size_t)m * D, v, c.lane); normmod(v, g, modp(c.ws, layer, m >> 11, csc), modp(c.ws, layer, m >> 11, csh), c.lane); store_row_bf16_tiled((bf16*)(c.ws + WS_A0), m, v, c.lane); }
        else { const int r = m - MP; load_row(xs + (size_t)r * D, v, c.lane); store_row_f32(xs_copy + (size_t)r * D, v, c.lane); normmod(v, g, modp(c.ws, layer, 4 + r, csc), modp(c.ws, layer, 4 + r, csh), c.lane); store_row_bf16((bf16*)(c.ws + WS_SMP + SM_USBF) + (size_t)r * D, v, c.lane); }
    }
}

__device__ __forceinline__ int kvlen(int gi) { return gi == 0 ? 128 : (gi == 1 ? 512 : 2048); }
__device__ __forceinline__ size_t pkv_off(int gi) { return gi == 0 ? O_PKV128 : (gi == 1 ? O_PKV512 : O_PKV2048); }
__device__ __forceinline__ size_t skv_off(int gi) { return gi == 0 ? O_SKV128 : (gi == 1 ? O_SKV512 : O_SKV2048); }

__device__ __forceinline__ void ph_sample_postproj(CP& p, const Ctx& c) {
    const int lane = c.lane;
    const float* cw = p.in[I_CONVW]; const float* cb = p.in[I_CONVB]; const float* const qgp = p.in[I_QG]; const float* const kgp = p.in[I_KG];
    const float* sproj = (const float*)(c.ws + WS_SMP + SM_PROJ);
    for (int it = c.gw; it < 64 + 384 + 192; it += c.ngw) {
        if (it < 64) { const int b = it >> 3, ch = (it & 7) * 512 + lane * 8; const float* prow = sproj + (size_t)b * INP;
            const float* st = p.in[I_CONV] + (size_t)b * 3 * CONVD + ch;
            f32x4 o0 = *(const f32x4*)(cb + ch), o1 = *(const f32x4*)(cb + ch + 4);
            const f32x4 s00 = *(const f32x4*)(st), s01 = *(const f32x4*)(st + 4), s10 = *(const f32x4*)(st + CONVD), s11 = *(const f32x4*)(st + CONVD + 4), s20 = *(const f32x4*)(st + 2 * CONVD), s21 = *(const f32x4*)(st + 2 * CONVD + 4);
            const f32x4 x0 = *(const f32x4*)(prow + CX + ch), x1 = *(const f32x4*)(prow + CX + ch + 4);
            o0 += *(const f32x4*)(cw + ch) * s00 + *(const f32x4*)(cw + CONVD + ch) * s10 + *(const f32x4*)(cw + 2 * CONVD + ch) * s20 + *(const f32x4*)(cw + 3 * CONVD + ch) * x0;
            o1 += *(const f32x4*)(cw + ch + 4) * s01 + *(const f32x4*)(cw + CONVD + ch + 4) * s11 + *(const f32x4*)(cw + 2 * CONVD + ch + 4) * s21 + *(const f32x4*)(cw + 3 * CONVD + ch + 4) * x1;
            float* xo = (float*)(c.ws + WS_SMP + SM_XC) + (size_t)b * CONVD + ch;
            *(f32x4*)xo = (f32x4){siluf(o0.x), siluf(o0.y), siluf(o0.z), siluf(o0.w)}; *(f32x4*)(xo + 4) = (f32x4){siluf(o1.x), siluf(o1.y), siluf(o1.z), siluf(o1.w)};
            float* sc = p.out + O_SCONV + (size_t)b * 3 * CONVD + ch;
            *(f32x4*)sc = s10; *(f32x4*)(sc + 4) = s11; *(f32x4*)(sc + CONVD) = s20; *(f32x4*)(sc + CONVD + 4) = s21; *(f32x4*)(sc + 2 * CONVD) = x0; *(f32x4*)(sc + 2 * CONVD + 4) = x1;
            if ((it & 7) == 0 && lane < NH) ((float*)(c.ws + WS_SMP + SM_DT))[b * NH + lane] = softplusf(prow[CDT + lane] + p.in[I_DTB][lane]);
        } else if (it < 64 + 384) { const int q = it - 64, b = q / 48, hh = q % 48; const float* prow = sproj + (size_t)b * INP;
            float* qk = (float*)(c.ws + WS_SMP + SM_QK) + (size_t)b * 6144;
            const float x0 = prow[CQ + hh * HD + lane], x1 = prow[CQ + hh * HD + 64 + lane];
            const float rs = rsqrtf(wave_sum(x0 * x0 + x1 * x1) * (1.f / HD) + EPS); const float* gg = hh < AH ? qgp : kgp;
            const float y0 = x0 * rs * gg[lane], y1 = x1 * rs * gg[64 + lane];
            qk[hh * HD + lane] = y0; qk[hh * HD + 64 + lane] = y1;
            if (hh >= AH) { const int kh = hh - AH, gi = kh >> 3, slot = kh & 7, W = kvlen(gi);
                float* o = p.out + skv_off(gi) + (((size_t)b * W + (W - 1)) * 2 + 0) * 1024 + slot * HD; o[lane] = y0; o[64 + lane] = y1; }
        } else { const int q = it - 448, b = q / AH, vh = q % AH, gi = vh >> 3, slot = vh & 7, W = kvlen(gi); const float* prow = sproj + (size_t)b * INP;
            float* o = p.out + skv_off(gi) + (((size_t)b * W + (W - 1)) * 2 + 1) * 1024 + slot * HD; o[lane] = prow[CV + vh * HD + lane]; o[64 + lane] = prow[CV + vh * HD + 64 + lane]; }
    }
}
__device__ __forceinline__ void ph_kvcopy(CP& p, const Ctx& c, int rp0, int rp1, int w0, int nw) {
    constexpr int R0 = 8 * 127, R1 = 8 * 511, R2 = 8 * 2047, TOTR = R0 + R1 + R2;
    const int lane = c.lane;
    const float* const kc0 = p.in[I_KV128]; const float* const kc1 = p.in[I_KV512]; const float* const kc2 = p.in[I_KV2048];
#pragma clang loop unroll(disable)
    for (int rp = rp0 + w0; rp < rp1; rp += nw) {
        const u32x4* src[2]; u32x4* dst[2];
#pragma unroll
        for (int h = 0; h < 2; ++h) { int q = 2 * rp + h; const float* cb; size_t ob; int W;
            if (q < R0) { cb = kc0; ob = O_SKV128; W = 128; } else if (q < R0 + R1) { q -= R0; cb = kc1; ob = O_SKV512; W = 512; } else { q -= R0 + R1; cb = kc2; ob = O_SKV2048; W = 2048; }
            const int b = q / (W - 1), r = q - b * (W - 1); const size_t base = ((size_t)b * W + r) * 512;
            src[h] = (const u32x4*)cb + base + 512 + lane; dst[h] = (u32x4*)(p.out + ob) + base + lane; }
        u32x4 v[2][8];
#pragma unroll
        for (int h = 0; h < 2; ++h)
#pragma unroll
            for (int j = 0; j < 8; ++j) v[h][j] = __builtin_nontemporal_load(src[h] + 64 * j);
#pragma unroll
        for (int h = 0; h < 2; ++h)
#pragma unroll
            for (int j = 0; j < 8; ++j) __builtin_nontemporal_store(v[h][j], dst[h] + 64 * j);
    }
}

__device__ __forceinline__ int rel_bucket(int dist) {
    if (dist < 16) return dist;
    int l = 16 + (int)(logf((float)dist * (1.f / 16.f)) / 4.852030263919617f * 16.f);
    return l < 31 ? l : 31;
}

typedef short s16x4 __attribute__((ext_vector_type(4)));
__device__ __forceinline__ s16x4 tr_read(const LAS unsigned char* p) { return __builtin_bit_cast(s16x4, __builtin_amdgcn_ds_read_tr16_b64_v4i16((LAS s16x4*)p)); }
__device__ __forceinline__ bf16x8 cat4(s16x4 a, s16x4 b) { return (bf16x8){a[0], a[1], a[2], a[3], b[0], b[1], b[2], b[3]}; }
__device__ __forceinline__ bf16x8 pack8(f32x4 a, f32x4 b) { u32x4 w; w.x = pk2(a[0], a[1]); w.y = pk2(a[2], a[3]); w.z = pk2(b[0], b[1]); w.w = pk2(b[2], b[3]); return __builtin_bit_cast(bf16x8, w); }
#define MFMA16(a, b, c) __builtin_amdgcn_mfma_f32_16x16x32_bf16((a), (b), (c), 0, 0, 0)


struct ConvW { f32x4 w[4][2]; f32x4 b[2]; };
__device__ __forceinline__ void conv_load_w(ConvW& cwv, const float* cw, const float* cb, int ch) {
#pragma unroll
    for (int k = 0; k < 4; ++k) { cwv.w[k][0] = *(const f32x4*)(cw + k * CONVD + ch); cwv.w[k][1] = *(const f32x4*)(cw + k * CONVD + ch + 4); }
    cwv.b[0] = *(const f32x4*)(cb + ch); cwv.b[1] = *(const f32x4*)(cb + ch + 4);
}
__device__ __forceinline__ void conv8(const bf16* prow, int t, int ch, const ConvW& cwv, f32x4& o0, f32x4& o1) {
    o0 = cwv.b[0]; o1 = cwv.b[1];
#pragma unroll
    for (int k = 0; k < 4; ++k) { if (t + k - 3 >= 0) { const u32x4 xv = *(const u32x4*)(prow + (ptrdiff_t)(k - 3) * INP + CX + ch);
            o0 += cwv.w[k][0] * (f32x4){bf2f(xv.x & 0xffffu), bf2f(xv.x >> 16), bf2f(xv.y & 0xffffu), bf2f(xv.y >> 16)};
            o1 += cwv.w[k][1] * (f32x4){bf2f(xv.z & 0xffffu), bf2f(xv.z >> 16), bf2f(xv.w & 0xffffu), bf2f(xv.w >> 16)}; } }
    o0 = (f32x4){siluf(o0.x), siluf(o0.y), siluf(o0.z), siluf(o0.w)}; o1 = (f32x4){siluf(o1.x), siluf(o1.y), siluf(o1.z), siluf(o1.w)};
}

template <int R> __device__ __forceinline__ void conv_rows(const bf16* prow0, int t0, int ch, const ConvW& cwv, f32x4 (&o0)[R], f32x4 (&o1)[R]) {
    u32x4 raw[R + 3];
#pragma unroll
    for (int i = 0; i < R + 3; ++i) raw[i] = (t0 - 3 + i >= 0) ? *(const u32x4*)(prow0 + (ptrdiff_t)(i - 3) * INP + CX + ch) : (u32x4){0u, 0u, 0u, 0u};
#pragma unroll
    for (int r = 0; r < R; ++r) { f32x4 a0 = cwv.b[0], a1 = cwv.b[1];
#pragma unroll
        for (int k = 0; k < 4; ++k) { const u32x4 xv = raw[r + k];
            a0 += cwv.w[k][0] * (f32x4){bf2f(xv.x & 0xffffu), bf2f(xv.x >> 16), bf2f(xv.y & 0xffffu), bf2f(xv.y >> 16)};
            a1 += cwv.w[k][1] * (f32x4){bf2f(xv.z & 0xffffu), bf2f(xv.z >> 16), bf2f(xv.w & 0xffffu), bf2f(xv.w >> 16)}; }
        o0[r] = (f32x4){siluf(a0.x), siluf(a0.y), siluf(a0.z), siluf(a0.w)}; o1[r] = (f32x4){siluf(a1.x), siluf(a1.y), siluf(a1.z), siluf(a1.w)}; }
}

constexpr size_t WS_ACUM = 666 * MiB;
constexpr size_t WS_STATES = WS_Y;
constexpr size_t WS_HPREV = WS_XC;
__device__ __forceinline__ void ssd_states_item(CP& p, const Ctx& c, int b, int ch, int g) {
    LAS unsigned char* Bm = c.lds;
    LAS unsigned char* Xw = c.lds + 36864;
    LAS float* wts = (LAS float*)(c.lds + 118784);
    const int lane = c.lane, wave = c.wave, tid = c.tid, fq = lane >> 4, fr = lane & 15;
    const int m0 = b * SEQ + ch * 128;
    const bf16* pr0 = (const bf16*)(c.ws + WS_PROJ) + (size_t)m0 * INP; const int tch = ch * 128;
    if (wave < 4) {
        const int h = 4 * g + wave; const float A = -__expf(p.in[I_ALOG][h]);
        const float* dtp = (const float*)(c.ws + WS_DT) + (size_t)m0 * NH + h;
        const float d0 = dtp[(size_t)(2 * lane) * NH], d1 = dtp[(size_t)(2 * lane + 1) * NH];
        const float a0 = d0 * A, a1 = d1 * A; float sc = a0 + a1;
#pragma unroll
        for (int o = 1; o < 64; o <<= 1) { const float t = __shfl_up(sc, o); if (lane >= o) sc += t; }
        const float aend = __shfl(sc, 63); const float ac1 = sc, ac0 = sc - a1;
        float* ag = (float*)(c.ws + WS_ACUM) + (size_t)m0 * NH + h; ag[(size_t)(2 * lane) * NH] = ac0; ag[(size_t)(2 * lane + 1) * NH] = ac1;
        wts[wave * 128 + 2 * lane] = d0 * __expf(aend - ac0); wts[wave * 128 + 2 * lane + 1] = d1 * __expf(aend - ac1);
    }
    f32x4 xo0[8], xo1[8];
    { const int cc = tid & 7, e = (tid >> 3) & 3, chn = (4 * g + e) * HP + cc * 8, r0 = 8 * (tid >> 5); ConvW cwv; conv_load_w(cwv, p.in[I_CONVW], p.in[I_CONVB], chn);
      conv_rows<8>(pr0 + (size_t)r0 * INP, tch + r0, chn, cwv, xo0, xo1); }
    { const int cc = tid & 15, chn = INNER + g * SN + cc * 8, r0 = 4 * (tid >> 4); ConvW cwv; conv_load_w(cwv, p.in[I_CONVW], p.in[I_CONVB], chn);
      f32x4 o0[4], o1[4]; conv_rows<4>(pr0 + (size_t)r0 * INP, tch + r0, chn, cwv, o0, o1);
#pragma unroll
      for (int r = 0; r < 4; ++r) *(LAS bf16x8*)(Bm + (r0 + r) * 288 + cc * 16) = pack8(o0[r], o1[r]); }
    __syncthreads();
    { const int cc = tid & 7, e = (tid >> 3) & 3, r0 = 8 * (tid >> 5);
#pragma unroll
      for (int r = 0; r < 8; ++r) { const float w = wts[e * 128 + r0 + r]; *(LAS bf16x8*)(Xw + e * 20480 + (r0 + r) * 160 + cc * 16) = pack8(xo0[r] * w, xo1[r] * w); } }
    __syncthreads();
    const int troff = (4 * fq + (fr >> 2));
    bf16x8 bfr[4];
#pragma unroll
    for (int ks = 0; ks < 4; ++ks) { const LAS unsigned char* a = Bm + (32 * ks + troff) * 288 + (16 * wave + 4 * (fr & 3)) * 2; bfr[ks] = cat4(tr_read(a), tr_read(a + 16 * 288)); }
    float* st = (float*)(c.ws + WS_STATES) + (((size_t)(b * 16 + ch) * NH + 4 * g) * HP) * SN;
#pragma unroll 1
    for (int e = 0; e < 4; ++e) {
#pragma unroll
        for (int pt = 0; pt < 4; ++pt) { f32x4 acc = (f32x4){0.f, 0.f, 0.f, 0.f};
#pragma unroll
            for (int ks = 0; ks < 4; ++ks) { const LAS unsigned char* a = Xw + e * 20480 + (32 * ks + troff) * 160 + (16 * pt + 4 * (fr & 3)) * 2; acc = MFMA16(cat4(tr_read(a), tr_read(a + 16 * 160)), bfr[ks], acc); }
#pragma unroll
            for (int r = 0; r < 4; ++r) st[((size_t)e * HP + 16 * pt + 4 * fq + r) * SN + 16 * wave + fr] = acc[r]; }
    }
    __syncthreads();
}

__device__ __forceinline__ void ph_ssd_scan(CP& p, const Ctx& c, int blk0) {
    if ((int)blockIdx.x < blk0) return;
    const size_t gt = (size_t)(blockIdx.x - blk0) * NT + c.tid, gn = (size_t)(gridDim.x - blk0) * NT;
    const float* st = (const float*)(c.ws + WS_STATES); bf16* hp = (bf16*)(c.ws + WS_HPREV); const float* ac = (const float*)(c.ws + WS_ACUM);
    for (size_t i = gt; i < (size_t)BATCH * NH * HP * (SN / 4); i += gn) { const int n4 = (int)(i & 31), pp = (int)(i >> 5) & 63, h = (int)(i >> 11) & 31, b = (int)(i >> 16);
        f32x4 hr = (f32x4){0.f, 0.f, 0.f, 0.f};
        f32x4 stv[16]; float dcv[16];
#pragma unroll
        for (int ch = 0; ch < 16; ++ch) { stv[ch] = __builtin_nontemporal_load((const f32x4*)(st + ((((size_t)(b * 16 + ch) * NH + h) * HP + pp) * SN) + 4 * n4)); dcv[ch] = ac[(size_t)(b * SEQ + ch * 128 + 127) * NH + h]; }
#pragma unroll
        for (int ch = 0; ch < 16; ++ch) { const size_t off = ((((size_t)(b * 16 + ch) * NH + h) * HP + pp) * SN) + 4 * n4;
            u32x2 w; w.x = pk2(hr.x, hr.y); w.y = pk2(hr.z, hr.w); *(u32x2*)(hp + off) = w;
            hr = hr * __expf(dcv[ch]) + stv[ch]; }
        *(f32x4*)(p.out + O_PSSM + (((size_t)b * NH + h) * HP + pp) * SN + 4 * n4) = hr; }
}

__device__ __forceinline__ void ssd_out_item(CP& p, const Ctx& c, int b, int ch, int g, bool do_atomic = true) {
    LAS unsigned char* Bm = c.lds;
    LAS unsigned char* Xs = c.lds + 34816;
    LAS float* acs = (LAS float*)(c.lds + 116736);
    LAS float* dts = (LAS float*)(c.lds + 118784);
    const int lane = c.lane, wave = c.wave, tid = c.tid, fq = lane >> 4, fr = lane & 15;
    const int m0 = b * SEQ + ch * 128;
    const bf16* pr0 = (const bf16*)(c.ws + WS_PROJ) + (size_t)m0 * INP; const int tch = ch * 128;
    { const int cc = tid & 7, e = (tid >> 3) & 3, chn = (4 * g + e) * HP + cc * 8, r0 = 8 * (tid >> 5); ConvW cwv; conv_load_w(cwv, p.in[I_CONVW], p.in[I_CONVB], chn);
      f32x4 o0[8], o1[8]; conv_rows<8>(pr0 + (size_t)r0 * INP, tch + r0, chn, cwv, o0, o1);
#pragma unroll
      for (int r = 0; r < 8; ++r) *(LAS bf16x8*)(Xs + e * 20480 + (r0 + r) * 160 + cc * 16) = pack8(o0[r], o1[r]); }
    { const int cc = tid & 15, chn = INNER + g * SN + cc * 8, r0 = 4 * (tid >> 4); ConvW cwv; conv_load_w(cwv, p.in[I_CONVW], p.in[I_CONVB], chn);
      f32x4 o0[4], o1[4]; conv_rows<4>(pr0 + (size_t)r0 * INP, tch + r0, chn, cwv, o0, o1);
#pragma unroll
      for (int r = 0; r < 4; ++r) *(LAS bf16x8*)(Bm + (r0 + r) * 272 + cc * 16) = pack8(o0[r], o1[r]); }
    { const int e = tid >> 7, j = tid & 127; acs[tid] = ((const float*)(c.ws + WS_ACUM))[(size_t)(m0 + j) * NH + 4 * g + e]; dts[tid] = ((const float*)(c.ws + WS_DT))[(size_t)(m0 + j) * NH + 4 * g + e]; }
    __syncthreads();
    const int i_tok = 16 * wave + fr;
    bf16x8 cf[4];
#pragma unroll
    for (int ks = 0; ks < 4; ++ks) { const int chn = INNER + SG * SN + g * SN + 32 * ks + 8 * fq; ConvW cwv; conv_load_w(cwv, p.in[I_CONVW], p.in[I_CONVB], chn);
        f32x4 o0, o1; conv8(pr0 + (size_t)i_tok * INP, tch + i_tok, chn, cwv, o0, o1); cf[ks] = pack8(o0, o1); }
    f32x4 cb[8];
#pragma unroll
    for (int jt = 0; jt < 8; ++jt) { cb[jt] = (f32x4){0.f, 0.f, 0.f, 0.f};
        if (jt <= wave) {
#pragma unroll
            for (int ks = 0; ks < 4; ++ks) cb[jt] = MFMA16(*(const LAS bf16x8*)(Bm + (16 * jt + fr) * 272 + (32 * ks + 8 * fq) * 2), cf[ks], cb[jt]); } }
    const int troff = 4 * fq + (fr >> 2);
    const bf16* hpv = (const bf16*)(c.ws + WS_HPREV) + (((size_t)(b * 16 + ch) * NH + 4 * g) * HP) * SN;
    bf16* a1row = (bf16*)(c.ws + WS_A1) + (size_t)(m0 + i_tok) * MIXK + 4 * g * HP; const bf16* zrow = pr0 + (size_t)i_tok * INP + CZ + 4 * g * HP; float ssq = 0.f;
    bf16x8 hp[16];
#pragma unroll
    for (int q = 0; q < 16; ++q) hp[q] = *(const bf16x8*)(hpv + ((size_t)(16 * (q >> 2) + fr)) * SN + 32 * (q & 3) + 8 * fq);
#pragma unroll 1
    for (int e = 0; e < 4; ++e) {
        const float ai = acs[e * 128 + i_tok];
        u32x2 zv4[4];
#pragma unroll
        for (int pt = 0; pt < 4; ++pt) zv4[pt] = *(const u32x2*)(zrow + e * HP + 16 * pt + 4 * fq);
        f32x4 acc[4];
#pragma unroll
        for (int pt = 0; pt < 4; ++pt) { acc[pt] = (f32x4){0.f, 0.f, 0.f, 0.f};
#pragma unroll
            for (int ks = 0; ks < 4; ++ks) acc[pt] = MFMA16(hp[pt * 4 + ks], cf[ks], acc[pt]); }
        if (e < 3) {
#pragma unroll
            for (int q = 0; q < 16; ++q) hp[q] = *(const bf16x8*)(hpv + ((size_t)(e + 1) * HP + 16 * (q >> 2) + fr) * SN + 32 * (q & 3) + 8 * fq); }
        const float ei = __expf(ai);
#pragma unroll
        for (int pt = 0; pt < 4; ++pt) acc[pt] = acc[pt] * ei;
#pragma unroll
        for (int s2 = 0; s2 < 4; ++s2) {
            if (2 * s2 <= wave) {
                f32x4 mv[2];
#pragma unroll
                for (int hf = 0; hf < 2; ++hf) { const int jt = 2 * s2 + hf; const int j0 = 16 * jt + 4 * fq;
                    const f32x4 aj = *(const LAS f32x4*)(acs + e * 128 + j0), dj = *(const LAS f32x4*)(dts + e * 128 + j0);
#pragma unroll
                    for (int r = 0; r < 4; ++r) mv[hf][r] = (j0 + r <= i_tok) ? cb[jt][r] * __expf(ai - aj[r]) * dj[r] : 0.f; }
                const bf16x8 mf = pack8(mv[0], mv[1]);
#pragma unroll
                for (int pt = 0; pt < 4; ++pt) { const LAS unsigned char* a = Xs + e * 20480 + (32 * s2 + troff) * 160 + (16 * pt + 4 * (fr & 3)) * 2; acc[pt] = MFMA16(cat4(tr_read(a), tr_read(a + 16 * 160)), mf, acc[pt]); }
            }
        }
        const float dsk = p.in[I_DSKIP][4 * g + e];
#pragma unroll
        for (int pt = 0; pt < 4; ++pt) { const int pc = e * HP + 16 * pt + 4 * fq;
            const u32x2 xv = *(const LAS u32x2*)(Xs + e * 20480 + i_tok * 160 + (16 * pt + 4 * fq) * 2), zv = zv4[pt];
            const float y0 = (acc[pt][0] + dsk * bf2f(xv.x & 0xffffu)) * siluf(bf2f(zv.x & 0xffffu)), y1 = (acc[pt][1] + dsk * bf2f(xv.x >> 16)) * siluf(bf2f(zv.x >> 16));
            const float y2 = (acc[pt][2] + dsk * bf2f(xv.y & 0xffffu)) * siluf(bf2f(zv.y & 0xffffu)), y3 = (acc[pt][3] + dsk * bf2f(xv.y >> 16)) * siluf(bf2f(zv.y >> 16));
            ssq += (y0 * y0 + y1 * y1) + (y2 * y2 + y3 * y3);
            u32x2 w; w.x = pk2(y0, y1); w.y = pk2(y2, y3); *(u32x2*)(a1row + pc) = w; }
    }
    ssq += __shfl_xor(ssq, 16); ssq += __shfl_xor(ssq, 32);
    if (fq == 0 && do_atomic) atomicAdd((float*)(c.ws + WS_RS) + m0 + i_tok, ssq);
    __syncthreads();
}

struct AttnPre { u32x4 k[8], v[8]; bf16x8 q[4]; float bias; };
struct AttnIt { int b, hd, r, n; };
__device__ __forceinline__ AttnIt attn_decode(int a) { const int gi = a / 512, q = a % 512; AttnIt t; t.b = q >> 7; const int slot = (q >> 4) & 7; t.hd = gi * 8 + slot;
    if (gi == 0) { t.r = 0; t.n = q & 15; } else if (gi == 1) { t.r = (q >> 2) & 3; t.n = q & 3; } else { t.r = q & 15; t.n = 0; } return t; }
__device__ __forceinline__ void attn_prefetch(CP& p, const Ctx& c, const AttnIt it, AttnPre& pre) {
    const int gi = it.hd >> 3, dil = gi == 0 ? 1 : (gi == 1 ? 4 : 16), Ls = SEQ / dil, tid = c.tid, lane = c.lane, wave = c.wave;
    const bf16* proj = (const bf16*)(c.ws + WS_PROJ);
    const int cc = tid & 15;
#pragma unroll
    for (int j = 0; j < 8; ++j) { const int row = (tid >> 4) + 32 * j; int sp = 128 * (it.n - 1) + row; sp = sp < 0 ? 0 : (sp > Ls - 1 ? Ls - 1 : sp);
        const bf16* pr = proj + (size_t)(it.b * SEQ + sp * dil + it.r) * INP + it.hd * HD + cc * 8; pre.k[j] = *(const u32x4*)(pr + CK); pre.v[j] = *(const u32x4*)(pr + CV); }
    const int tokq = it.b * SEQ + (128 * it.n + 16 * wave + (lane & 15)) * dil + it.r;
#pragma unroll
    for (int ks = 0; ks < 4; ++ks) pre.q[ks] = *(const bf16x8*)(proj + (size_t)tokq * INP + CQ + it.hd * HD + 32 * ks + 8 * (lane >> 4));
    { const int t = tid - 16; pre.bias = (tid < 176 && t >= 0 && t <= 128) ? p.in[I_RELB][rel_bucket((128 - t) * dil) * AH + it.hd] : -1e30f; }
}
__device__ __forceinline__ void attn_store_lds(const Ctx& c, const AttnPre& pre) {
    LAS unsigned char* Ks = c.lds; LAS unsigned char* Vs = c.lds + 69632; LAS float* rb = (LAS float*)(c.lds + 143360);
    const int tid = c.tid, cc = tid & 15;
#pragma unroll
    for (int j = 0; j < 8; ++j) { const int row = (tid >> 4) + 32 * j; *(LAS u32x4*)(Ks + row * 272 + cc * 16) = pre.k[j]; *(LAS u32x4*)(Vs + row * 288 + cc * 16) = pre.v[j]; }
    if (tid < 176) rb[tid] = pre.bias;
}
__device__ __forceinline__ void attn_compute(CP& p, const Ctx& c, const AttnIt it, const bf16x8 (&qf)[4]) {
    const int gi = it.hd >> 3, slot = it.hd & 7, dil = gi == 0 ? 1 : (gi == 1 ? 4 : 16), n = it.n;
    const LAS unsigned char* Ks = c.lds; const LAS unsigned char* Vs = c.lds + 69632; const LAS float* rb = (const LAS float*)(c.lds + 143360);
    const int lane = c.lane, wave = c.wave, fq = lane >> 4, fr = lane & 15;
    const int q0 = 16 * wave, qi = q0 + fr;
    const int tokq = it.b * SEQ + (128 * n + qi) * dil + it.r;
    f32x4 sa[10];
#pragma unroll
    for (int kt = 0; kt < 10; ++kt) { int kr = q0 + 16 * kt + fr; kr = kr > 255 ? 255 : kr;
        sa[kt] = (f32x4){0.f, 0.f, 0.f, 0.f};
#pragma unroll
        for (int ks = 0; ks < 4; ++ks) sa[kt] = MFMA16(*(const LAS bf16x8*)(Ks + kr * 272 + (32 * ks + 8 * fq) * 2), qf[ks], sa[kt]);
        if (kt & 1) __builtin_amdgcn_sched_barrier(0); }
    float mx = -1e30f;
#pragma unroll
    for (int kt = 0; kt < 10; ++kt)
#pragma unroll
        for (int rg = 0; rg < 4; ++rg) { const int t = 16 * kt + 4 * fq + rg - fr; float lg = sa[kt][rg] * 0.08838834764831845f + rb[t + 16];
            if (n == 0 && (q0 + 16 * kt + 4 * fq + rg) < 128) lg = -1e30f;
            sa[kt][rg] = lg; mx = fmaxf(mx, lg); }
    mx = fmaxf(mx, __shfl_xor(mx, 16)); mx = fmaxf(mx, __shfl_xor(mx, 32));
    float sum = 0.f;
#pragma unroll
    for (int kt = 0; kt < 10; ++kt)
#pragma unroll
        for (int rg = 0; rg < 4; ++rg) { const float e = __expf(sa[kt][rg] - mx); sa[kt][rg] = e; sum += e; }
    sum += __shfl_xor(sum, 16); sum += __shfl_xor(sum, 32);
    bf16x8 pf[5];
#pragma unroll
    for (int s2 = 0; s2 < 5; ++s2) pf[s2] = pack8(sa[2 * s2], sa[2 * s2 + 1]);
    const float inv = 1.f / sum;
    bf16* orow = (bf16*)(c.ws + WS_ATT) + ((size_t)gi * MP + tokq) * AOUT + slot * HD;
#pragma unroll
    for (int dt = 0; dt < 8; ++dt) { f32x4 o = (f32x4){0.f, 0.f, 0.f, 0.f};
#pragma unroll
        for (int s2 = 0; s2 < 5; ++s2) { int r0 = q0 + 32 * s2 + 4 * fq + (fr >> 2), r1 = r0 + 16; r0 = r0 > 255 ? 255 : r0; r1 = r1 > 255 ? 255 : r1;
            const int cb2 = (16 * dt + 4 * (fr & 3)) * 2; o = MFMA16(cat4(tr_read(Vs + r0 * 288 + cb2), tr_read(Vs + r1 * 288 + cb2)), pf[s2], o); }
        u32x2 w; w.x = pk2(o[0] * inv, o[1] * inv); w.y = pk2(o[2] * inv, o[3] * inv); *(u32x2*)(orow + 16 * dt + 4 * fq) = w;
        if (dt & 1) __builtin_amdgcn_sched_barrier(0); }
    if (fq == 0) ((float*)(c.ws + WS_LSE))[((size_t)gi * MP + tokq) * HPP + slot] = mx + __logf(sum);
}

__device__ __forceinline__ void ph_mixers(CP& p, const Ctx& c) {
    const int G = gridDim.x;
    int it = blockIdx.x;
    for (; it < 512; it += G) ssd_states_item(p, c, it >> 7, (it >> 3) & 15, it & 7);
    int a = it - 512;
    if (a < 1536) {
        AttnPre pre; attn_prefetch(p, c, attn_decode(a), pre);
#pragma clang loop unroll(disable)
        for (; a < 1536; a += G) {
            const AttnIt cur = attn_decode(a);
            attn_store_lds(c, pre);
            bf16x8 qf[4];
#pragma unroll
            for (int ks = 0; ks < 4; ++ks) qf[ks] = pre.q[ks];
            __syncthreads();
            if (a + G < 1536) attn_prefetch(p, c, attn_decode(a + G), pre);
            attn_compute(p, c, cur, qf);
            __syncthreads();
        }
    }
}
__device__ __forceinline__ void ph_sample_mix(CP& p, const Ctx& c) {
    const int lane = c.lane;
    for (int grp = c.gw; grp < SB * NH * (HP / 8); grp += c.ngw) {
        const int b = grp >> 8, h = (grp >> 3) & 31, pp0 = (grp & 7) * 8, g = h >> 2;
        const float* xcs = (const float*)(c.ws + WS_SMP + SM_XC) + (size_t)b * CONVD;
        const float* h0 = p.in[I_SSM] + (((size_t)b * NH + h) * HP + pp0) * SN; float* ho = p.out + O_SSSM + (((size_t)b * NH + h) * HP + pp0) * SN;
        f32x2 hv[8];
#pragma unroll
        for (int k = 0; k < 8; ++k) hv[k] = *(const f32x2*)(h0 + (size_t)k * SN + 2 * lane);
        const float dtv = ((const float*)(c.ws + WS_SMP + SM_DT))[b * NH + h], a = __expf(-__expf(p.in[I_ALOG][h]) * dtv);
        const f32x2 bv = *(const f32x2*)(xcs + INNER + g * SN + 2 * lane), cv = *(const f32x2*)(xcs + INNER + SG * SN + g * SN + 2 * lane);
        const float xl = xcs[h * HP + pp0 + (lane & 7)];
        float yk = 0.f;
#pragma unroll
        for (int k = 0; k < 8; ++k) { const float xdt = dtv * __shfl(xl, k);
            const f32x2 hn = (f32x2){a * hv[k].x + xdt * bv.x, a * hv[k].y + xdt * bv.y};
            *(f32x2*)(ho + (size_t)k * SN + 2 * lane) = hn;
            const float y = wave_sum(hn.x * cv.x + hn.y * cv.y); if (lane == k) yk = y; }
        if (lane < 8) ((float*)(c.ws + WS_SMP + SM_Y))[b * INNER + h * HP + pp0 + lane] = yk;
    }
}
__device__ __forceinline__ void ph_sample_attn(CP& p, const Ctx& c) {
    const int lane = c.lane, wq = c.wave & 3, half = c.wave >> 2;
    LAS float* part = (LAS float*)c.lds;
    LAS float* ps = (LAS float*)c.lds + 8 * 132 + c.wave * 48;
    for (int pair = blockIdx.x; pair < SB * AH / 2; pair += gridDim.x) {
        const int it = pair * 2 + half;
        const int b = it / AH, hd = it % AH, gi = hd >> 3, slot = hd & 7, dil = gi == 0 ? 1 : (gi == 1 ? 4 : 16), W = kvlen(gi), kb = wq * 33;
        const float* qk = (const float*)(c.ws + WS_SMP + SM_QK) + (size_t)b * 6144; const float* q = qk + hd * HD; const float* knew = qk + (AH + hd) * HD;
        const float* vnew = (const float*)(c.ws + WS_SMP + SM_PROJ) + (size_t)b * INP + CV + hd * HD;
        const float* const kc0 = p.in[I_KV128]; const float* const kc1 = p.in[I_KV512]; const float* const kc2 = p.in[I_KV2048];
        const float* cache = (gi == 0 ? kc0 : (gi == 1 ? kc1 : kc2)) + (size_t)b * W * 2048;
        const int sub = lane & 3, kg = lane >> 2;
        f32x4 qv[8];
#pragma unroll
        for (int e = 0; e < 8; ++e) qv[e] = *(const f32x4*)(q + sub * 32 + 4 * e);
        f32x4 kv[3][8];
#pragma unroll
        for (int ps3 = 0; ps3 < 3; ++ps3) { const int jj = kb + ps3 * 16 + kg; const int jc = jj > 128 ? 128 : jj;
            const float* kr = (jc == 0 ? knew : cache + ((size_t)(W - dil * jc) * 2 + 0) * 1024 + slot * HD) + sub * 32;
#pragma unroll
            for (int e = 0; e < 8; ++e) kv[ps3][e] = *(const f32x4*)(kr + 4 * e); }
        const int ksl = lane >> 3, dc = lane & 7;
        f32x4 vv[5][4];
#pragma unroll
        for (int st = 0; st < 5; ++st) { const int loc = 8 * st + ksl, jj = kb + loc; const int jc = jj > 128 ? 128 : jj;
            const float* vr = (jc == 0 ? vnew : cache + ((size_t)(W - dil * jc) * 2 + 1) * 1024 + slot * HD) + 16 * dc;
#pragma unroll
            for (int q4 = 0; q4 < 4; ++q4) vv[st][q4] = *(const f32x4*)(vr + 4 * q4); }
        float lg[3]; float mx = -1e30f;
#pragma unroll
        for (int ps3 = 0; ps3 < 3; ++ps3) { const int loc = ps3 * 16 + kg, jj = kb + loc; const int jc = jj > 128 ? 128 : jj; float sdot = 0.f;
#pragma unroll
            for (int e = 0; e < 8; ++e) sdot += (kv[ps3][e].x * qv[e].x + kv[ps3][e].y * qv[e].y) + (kv[ps3][e].z * qv[e].z + kv[ps3][e].w * qv[e].w);
            sdot += __shfl_xor(sdot, 1); sdot += __shfl_xor(sdot, 2);
            lg[ps3] = (loc < 33 && jj <= 128) ? sdot * 0.08838834764831845f + p.in[I_RELB][rel_bucket(jc * dil) * AH + hd] : -1e30f; mx = fmaxf(mx, lg[ps3]); }
        mx = wave_max(mx); float sum = 0.f;
#pragma unroll
        for (int ps3 = 0; ps3 < 3; ++ps3) { const int loc = ps3 * 16 + kg, jj = kb + loc; const float e = (loc < 33 && jj <= 128) ? __expf(lg[ps3] - mx) : 0.f; if (sub == 0) { ps[loc] = e; sum += e; } }
        sum = wave_sum(sum);
        LDS_WAIT();
        float pj[5];
#pragma unroll
        for (int st = 0; st < 5; ++st) pj[st] = ps[8 * st + ksl];
        f32x4 oa[4];
#pragma unroll
        for (int q4 = 0; q4 < 4; ++q4) oa[q4] = (f32x4){0.f, 0.f, 0.f, 0.f};
#pragma unroll
        for (int st = 0; st < 5; ++st)
#pragma unroll
            for (int q4 = 0; q4 < 4; ++q4) oa[q4] += vv[st][q4] * pj[st];
#pragma unroll
        for (int q4 = 0; q4 < 4; ++q4)
#pragma unroll
            for (int e = 0; e < 4; ++e) { float t = oa[q4][e]; t += __shfl_xor(t, 8); t += __shfl_xor(t, 16); t += __shfl_xor(t, 32); oa[q4][e] = t; }
        if (ksl == 0) {
#pragma unroll
            for (int q4 = 0; q4 < 4; ++q4) *(LAS f32x4*)(part + c.wave * 132 + 16 * dc + 4 * q4) = oa[q4]; }
        if (lane == 0) { part[c.wave * 132 + 128] = mx; part[c.wave * 132 + 129] = sum; }
        __syncthreads();
        if (wq == 0 && lane < 32) { const LAS float* pw = part + (half * 4) * 132;
            const float m0 = pw[128], m1 = pw[132 + 128], m2 = pw[264 + 128], m3 = pw[396 + 128], M = fmaxf(fmaxf(m0, m1), fmaxf(m2, m3));
            const float w0 = __expf(m0 - M), w1 = __expf(m1 - M), w2 = __expf(m2 - M), w3 = __expf(m3 - M);
            const float S = pw[129] * w0 + pw[132 + 129] * w1 + pw[264 + 129] * w2 + pw[396 + 129] * w3;
            const f32x4 o = *(const LAS f32x4*)(pw + 4 * lane) * w0 + *(const LAS f32x4*)(pw + 132 + 4 * lane) * w1 + *(const LAS f32x4*)(pw + 264 + 4 * lane) * w2 + *(const LAS f32x4*)(pw + 396 + 4 * lane) * w3;
            float* ao = (float*)(c.ws + WS_SMP + SM_ATT) + ((size_t)gi * SB + b) * AOUT + slot * HD + 4 * lane;
            *(f32x4*)ao = o * (1.f / S);
            if (lane == 0) ((float*)(c.ws + WS_SMP + SM_LSE))[(gi * SB + b) * HPP + slot] = M + __logf(S); }
        __syncthreads();
    }
}

__device__ __forceinline__ void ph_combine(CP& p, const Ctx& c, int blk0) {
    if ((int)blockIdx.x < blk0) return;
    const int lane = c.lane; const float* lse = (const float*)(c.ws + WS_LSE);
    for (int m = c.gw - blk0 * NWAVES; m < MP; m += c.ngw - blk0 * NWAVES) {
        bf16* arow = (bf16*)(c.ws + WS_A1) + (size_t)m * MIXK;
#pragma unroll
        for (int j = 0; j < 4; ++j) { const int ch = 4 * (lane + 64 * j), slot = ch >> 7;
            const float l0 = lse[((size_t)0 * MP + m) * HPP + slot], l1 = lse[((size_t)1 * MP + m) * HPP + slot], l2 = lse[((size_t)2 * MP + m) * HPP + slot];
            const float mx = fmaxf(l0, fmaxf(l1, l2)); float w0 = __expf(l0 - mx), w1 = __expf(l1 - mx), w2 = __expf(l2 - mx); const float inv = 1.f / (w0 + w1 + w2); w0 *= inv; w1 *= inv; w2 *= inv;
            const bf16* ab = (const bf16*)(c.ws + WS_ATT) + (size_t)m * AOUT + ch;
            const u32x2 a0 = *(const u32x2*)ab, a1 = *(const u32x2*)(ab + (size_t)MP * AOUT), a2 = *(const u32x2*)(ab + (size_t)2 * MP * AOUT);
            const float o0 = w0 * bf2f(a0.x & 0xffffu) + w1 * bf2f(a1.x & 0xffffu) + w2 * bf2f(a2.x & 0xffffu), o1 = w0 * bf2f(a0.x >> 16) + w1 * bf2f(a1.x >> 16) + w2 * bf2f(a2.x >> 16);
            const float o2 = w0 * bf2f(a0.y & 0xffffu) + w1 * bf2f(a1.y & 0xffffu) + w2 * bf2f(a2.y & 0xffffu), o3 = w0 * bf2f(a0.y >> 16) + w1 * bf2f(a1.y >> 16) + w2 * bf2f(a2.y >> 16);
            u32x2 w; w.x = pk2(o0, o1); w.y = pk2(o2, o3); *(u32x2*)(arow + INNER + ch) = w; }
    }
}
__device__ __forceinline__ void ph_sample_a1(CP& p, const Ctx& c) {
    const int lane = c.lane;
    for (int b = c.gw; b < SB; b += c.ngw) {
        f32x4 v[8]; load_row((const float*)(c.ws + WS_SMP + SM_Y) + (size_t)b * INNER, v, lane);
        const float* xcs = (const float*)(c.ws + WS_SMP + SM_XC) + (size_t)b * CONVD; const float* zs = (const float*)(c.ws + WS_SMP + SM_PROJ) + (size_t)b * INP + CZ;
        float ss = 0.f;
#pragma unroll
        for (int j = 0; j < 8; ++j) { const int ch = 4 * (lane + 64 * j); const float dsk = p.in[I_DSKIP][ch >> 6]; const f32x4 xv = *(const f32x4*)(xcs + ch), zv = *(const f32x4*)(zs + ch);
            v[j].x = (v[j].x + dsk * xv.x) * siluf(zv.x); v[j].y = (v[j].y + dsk * xv.y) * siluf(zv.y); v[j].z = (v[j].z + dsk * xv.z) * siluf(zv.z); v[j].w = (v[j].w + dsk * xv.w) * siluf(zv.w);
            ss += (v[j].x * v[j].x + v[j].y * v[j].y) + (v[j].z * v[j].z + v[j].w * v[j].w); }
        const float rs = rsqrtf(wave_sum(ss) * (1.f / INNER) + EPS);
        bf16* arow = (bf16*)(c.ws + WS_SMP + SM_A1BF) + (size_t)b * MIXK;
#pragma unroll
        for (int j = 0; j < 8; ++j) { const int ch = 4 * (lane + 64 * j); const f32x4 o = v[j] * rs; u32x2 w; w.x = pk2(o.x, o.y); w.y = pk2(o.z, o.w); *(u32x2*)(arow + ch) = w; }
        const float* lse = (const float*)(c.ws + WS_SMP + SM_LSE); const float* att = (const float*)(c.ws + WS_SMP + SM_ATT);
#pragma unroll
        for (int j = 0; j < 4; ++j) { const int ch = 4 * (lane + 64 * j), slot = ch >> 7;
            const float l0 = lse[(0 * SB + b) * HPP + slot], l1 = lse[(1 * SB + b) * HPP + slot], l2 = lse[(2 * SB + b) * HPP + slot];
            const float mx = fmaxf(l0, fmaxf(l1, l2)); float w0 = __expf(l0 - mx), w1 = __expf(l1 - mx), w2 = __expf(l2 - mx); const float inv = 1.f / (w0 + w1 + w2); w0 *= inv; w1 *= inv; w2 *= inv;
            const f32x4 a0 = *(const f32x4*)(att + ((size_t)0 * SB + b) * AOUT + ch), a1 = *(const f32x4*)(att + ((size_t)1 * SB + b) * AOUT + ch), a2 = *(const f32x4*)(att + ((size_t)2 * SB + b) * AOUT + ch);
            const f32x4 o = a0 * w0 + a1 * w1 + a2 * w2;
            u32x2 w; w.x = pk2(o.x, o.y); w.y = pk2(o.z, o.w); *(u32x2*)(arow + INNER + ch) = w; }
    }
}

__device__ __forceinline__ void ph_pool(CP& p, const Ctx& c) {
    const int lane = c.lane;
    const bf16* x2 = (const bf16*)(c.ws + WS_Y); const float* rss = (const float*)(c.ws + WS_RS) + MP;
    bf16* pg = (bf16*)(c.ws + WS_A1);
    const int gt = blockIdx.x * NT + c.tid, gn = gridDim.x * NT;
    for (int task = gt; task < BATCH * 128 * 512; task += gn) {
        const int cq = task & 511, seg = (task >> 9) & 127, b = task >> 16, ch = 4 * cq, gi = cq >> 7, t0 = seg * 16;
        const f32x4 gg = *(const f32x4*)(p.in[I_NMIX] + D + ch), s1 = *(const f32x4*)(modp(c.ws, 1, b, 1) + ch), sh = *(const f32x4*)(modp(c.ws, 1, b, 0) + ch);
        const f32x4 gm = gg * (s1 + 1.f);
        const bf16* xb = x2 + (size_t)b * SEQ * D + ch; const float* rb = rss + b * SEQ;
        f32x4 xh[31];
#pragma unroll
        for (int i = 0; i < 31; ++i) { const int t = t0 - 15 + i; if (t >= 0 && i >= 16 - (2 << gi)) { const u32x2 x = *(const u32x2*)(xb + (size_t)t * D); xh[i] = (f32x4){__uint_as_float(x.x << 16), __uint_as_float(x.x & 0xffff0000u), __uint_as_float(x.y << 16), __uint_as_float(x.y & 0xffff0000u)} * rsqrtf(rb[t] * (1.f / D) + EPS); } else xh[i] = (f32x4){0.f, 0.f, 0.f, 0.f}; }
        auto emit = [&](int i, const f32x4& S, int w) { const int t = t0 + i; const int cnt = t + 1 < w ? t + 1 : w; const f32x4 xn = xh[15 + i]; const f32x4 o = gm * (S * __builtin_amdgcn_rcpf((float)cnt) - xn);
            u32x2 wv; wv.x = pk2(o.x, o.y); wv.y = pk2(o.z, o.w); *(u32x2*)(pg + (size_t)(b * SEQ + t) * D + ch) = wv;
            if (t >= SEQ - 15) *(f32x4*)(p.out + O_PPOOL + ((size_t)b * 15 + (t - (SEQ - 15))) * D + ch) = xn * gm + sh; };
#define POOL_W(W_) { f32x4 S = (f32x4){0.f, 0.f, 0.f, 0.f}; _Pragma("unroll") for (int k = 0; k < W_; ++k) S += xh[15 - k]; \
            _Pragma("unroll") for (int i = 0; i < 16; ++i) { emit(i, S, W_); if (i < 15) S += xh[16 + i] - xh[16 + i - W_]; } }
        if (gi == 0) POOL_W(2) else if (gi == 1) POOL_W(4) else if (gi == 2) POOL_W(8) else POOL_W(16)
#undef POOL_W
    }
    for (int it = c.gw; it < 112 + 64; it += c.ngw) {
        if (it < 112) { const int b = it / 14, k = it % 14; f32x4 t4[8]; load_row(p.in[I_POOL] + ((size_t)b * 15 + k + 1) * D, t4, lane); store_row_f32(p.out + O_SPOOL + ((size_t)b * 15 + k) * D, t4, lane); continue; }
        const int b = (it - 112) >> 3, j = (it - 112) & 7;
        f32x4 v[8]; load_row((const float*)(c.ws + WS_SMP + SM_X2) + (size_t)b * D, v, lane);
        const float rs = row_rs(v);
        const int ch = 4 * (lane + 64 * j), gi = ch >> 9, w = 2 << gi;
        const f32x4 xr = v[0];
        (void)xr;
        f32x4 xo;
#pragma unroll
        for (int jj = 0; jj < 8; ++jj) if (jj == j) xo = v[jj];
        ((f32x4*)((float*)(c.ws + WS_SMP + SM_X3) + (size_t)b * D))[lane + 64 * j] = xo;
        const f32x4 gg = *(const f32x4*)(p.in[I_NMIX] + D + ch), s1 = *(const f32x4*)(modp(c.ws, 1, 4 + b, 1) + ch), s0 = *(const f32x4*)(modp(c.ws, 1, 4 + b, 0) + ch);
        const f32x4 u = xo * rs * gg * (s1 + 1.f) + s0;
        const float* sp = p.in[I_POOL] + (size_t)b * 15 * D;
        *(f32x4*)(p.out + O_SPOOL + ((size_t)b * 15 + 14) * D + ch) = u;
        f32x4 pr[15];
#pragma unroll
        for (int k = 1; k < 16; ++k) pr[k - 1] = *(const f32x4*)(sp + (size_t)(15 - k) * D + ch);
        f32x4 sacc = u;
#pragma unroll
        for (int k = 1; k < 16; ++k) if (k < w) sacc += pr[k - 1];
        const f32x4 o = sacc * (1.f / (float)w) - u; u32x2 wv; wv.x = pk2(o.x, o.y); wv.y = pk2(o.z, o.w); *(u32x2*)((bf16*)(c.ws + WS_SMP + SM_PGBF) + (size_t)b * D + ch) = wv;
    }
}

constexpr int NPHASE = 15;
constexpr int KV_SPLIT = 7000;
__device__ __forceinline__ unsigned char* launder(unsigned char* q) { const unsigned long long v = (unsigned long long)q; unsigned lo = (unsigned)__builtin_amdgcn_readfirstlane((int)(unsigned)v), hi = (unsigned)__builtin_amdgcn_readfirstlane((int)(unsigned)(v >> 32)); asm volatile("" : "+s"(lo), "+s"(hi)); return (unsigned char*)(((unsigned long long)hi << 32) | (unsigned long long)lo); }
__device__ __forceinline__ CP* kernarg_p() { unsigned long long v = (unsigned long long)__builtin_amdgcn_kernarg_segment_ptr(); unsigned lo = (unsigned)v, hi = (unsigned)(v >> 32); asm volatile("" : "+s"(lo), "+s"(hi)); return (CP*)(((unsigned long long)hi << 32) | (unsigned long long)lo); }
__global__ void __launch_bounds__(NT, 2) mk_fwd(P p_unused) {
    (void)p_unused;
    CP& p0 = *kernarg_p();
    extern __shared__ __attribute__((aligned(16))) unsigned char lds_raw[];
    Ctx c0; c0.lds = (LAS unsigned char*)lds_raw; c0.tid = threadIdx.x; c0.lane = c0.tid & 63; c0.wave = __builtin_amdgcn_readfirstlane(c0.tid >> 6);
    c0.gw = blockIdx.x * NWAVES + c0.wave; c0.ngw = gridDim.x * NWAVES; c0.ws = nullptr;
    volatile LAS unsigned* bst = (volatile LAS unsigned*)(c0.lds + LDS_BYTES - 16);
    if (c0.tid < 4) bst[c0.tid] = 0u;
    __syncthreads();
#if defined(CLKSEL) && CLKSEL == 6
    if (c0.tid == 0) bst[2] = (unsigned)__builtin_amdgcn_s_memrealtime();
#endif
#define WS_UNIFORM() ((unsigned char*)((((unsigned long long)(unsigned)__builtin_amdgcn_readfirstlane((int)((unsigned long long)p0.ws >> 32))) << 32) | (unsigned long long)(unsigned)__builtin_amdgcn_readfirstlane((int)(unsigned)(unsigned long long)p0.ws)))
    (void)xcd_barrier_post((unsigned*)(WS_UNIFORM() + WS_CTL) + 1024, bst);
    const int lo = p0.ph_lo, hi = p0.ph_hi;
    const int G = gridDim.x;
#ifndef PHMASK
#define PHMASK 0xFFFFF
#endif
#ifndef CLKPROBE
#define CLKPROBE -1
#endif
#define CLK_A(k) do { if (CLKPROBE == (k) && blockIdx.x == 0 && threadIdx.x == 0) { volatile unsigned long long* q_ = (volatile unsigned long long*)(ws + WS_CTL + 65536); q_[0] = __builtin_readcyclecounter(); q_[1] = __builtin_amdgcn_s_memrealtime(); } } while (0)
#define CLK_B(k) do { if (CLKPROBE == (k) && blockIdx.x == 0 && threadIdx.x == 0) { volatile unsigned long long* q_ = (volatile unsigned long long*)(ws + WS_CTL + 65536); const unsigned long long c1_ = __builtin_readcyclecounter(), r1_ = __builtin_amdgcn_s_memrealtime(); \
    const float dc_ = (float)(c1_ - q_[0]), dr_ = (float)(r1_ - q_[1]); const unsigned long long tgt_ = (unsigned long long)(dc_ * 5000.f / dr_); while (__builtin_amdgcn_s_memrealtime() - r1_ < tgt_) __builtin_amdgcn_s_sleep(8); } } while (0)
#ifdef CLKSEL
#ifndef CLKMUL
#define CLKMUL 8
#define CLKBLK 100
#endif
#undef CLK_B
#define CLK_B(k) do { if (CLKPROBE == (k) && blockIdx.x == 0 && threadIdx.x == 0) { volatile unsigned long long* q_ = (volatile unsigned long long*)(ws + WS_CTL + 65536); const unsigned long long r1_ = __builtin_amdgcn_s_memrealtime(); \
    const unsigned long long tgt_ = (CLKSEL == 3 ? (unsigned long long)__builtin_readcyclecounter() - q_[0] : q_[2]) * CLKMUL / 4; while (__builtin_amdgcn_s_memrealtime() - r1_ < tgt_) __builtin_amdgcn_s_sleep(8); } } while (0)
#endif
#if defined(CLKSEL) && CLKSEL >= 4
#undef CLK_A
#undef CLK_B
#define CLK_A(k) do { if (CLKPROBE == (k) && threadIdx.x == 0) bst[2] = (unsigned)__builtin_amdgcn_s_memrealtime(); } while (0)
#define CLK_B(k) do { if (CLKPROBE == (k) && threadIdx.x == 0) { unsigned* q_ = (unsigned*)(ws + WS_CTL + 131072); const unsigned d_ = (unsigned)__builtin_amdgcn_s_memrealtime() - bst[2]; atomicMax(q_, d_); atomicMax(q_ + 1, 0xFFFFFFFFu - d_); if (blockIdx.x == CLKBLK) q_[2] = d_; } } while (0)
#define CLK_C(k) do { if (blockIdx.x == 0 && threadIdx.x == 0) { volatile unsigned* q_ = (volatile unsigned*)(WS_UNIFORM() + WS_CTL + 131072); \
    const unsigned long long r1_ = __builtin_amdgcn_s_memrealtime(); const unsigned long long tgt_ = (unsigned long long)(CLKSEL == 4 ? q_[0] : (CLKSEL == 5 ? 0xFFFFFFFFu - q_[1] : q_[2])) * CLKMUL; while (__builtin_amdgcn_s_memrealtime() - r1_ < tgt_) __builtin_amdgcn_s_sleep(8); } } while (0)
#else
#define CLK_C(k) do { } while (0)
#endif
#if defined(CLKSEL) && CLKSEL == 6
#define CLK_T(k) do { if (CLKPROBE == (k) && blockIdx.x == 0 && threadIdx.x == 0) { const unsigned r1_ = (unsigned)__builtin_amdgcn_s_memrealtime(); const unsigned tgt_ = (r1_ - bst[2]) * CLKMUL; while ((unsigned)__builtin_amdgcn_s_memrealtime() - r1_ < tgt_) __builtin_amdgcn_s_sleep(8); } } while (0)
#else
#define CLK_T(k) do { } while (0)
#endif
#define IN(k) (((PHMASK >> (k)) & 1) && lo <= (k) && (k) < hi)
#ifndef REPMASK
#define REPMASK 0
#endif
#define REPLOOP(k) _Pragma("clang loop unroll(disable)") for (int rep_ = 0; rep_ < 1 + ((REPMASK >> (k)) & 1); ++rep_)
#define SEAM(k) do { if (IN(k) && IN((k) + 1)) { XcdBarrier bb_; bb_.bar = (unsigned*)(WS_UNIFORM() + WS_CTL) + 1024; bb_.x = xb_xcc_id(); bb_.st = (volatile LAS unsigned*)(c0.lds + LDS_BYTES - 16); xcd_barrier(bb_); CLK_T(k); } } while (0)
    if (IN(0)) REPLOOP(0) { CP& p = *kernarg_p(); Ctx c = c0; c.ws = launder(p.ws); unsigned char* ws = c.ws; (void)ws; ph_prologue(p, c); }
    SEAM(0);
    if (IN(1)) REPLOOP(1) { CP& p = *kernarg_p(); Ctx c = c0; c.ws = launder(p.ws); unsigned char* ws = c.ws; (void)ws; ph_normmod<false>(p, c, p.in[I_XP], p.in[I_XS], p.in[I_NMIX], 0, 0, 1, (float*)(ws + WS_SMP + SM_X1)); }
    SEAM(1);
    if (IN(2)) REPLOOP(2) { CP& p = *kernarg_p(); Ctx c = c0; c.ws = launder(p.ws); unsigned char* ws = c.ws; (void)ws;
        pg8::Gemm g{(const bf16*)(ws + WS_A0), (const bf16*)(ws + WS_WIN), MP, INP, D, D, D, 1 << 20, D / 64, D / 64}; pg8::StaticOrder S; S.init(MP, INP, G, blockIdx.x);
        if (G == 256 && blockIdx.x >= 160) { ph_kvcopy(p, c, 0, KV_SPLIT, (blockIdx.x - 160) * NWAVES + c.wave, 96 * NWAVES); __syncthreads(); }
        pg8::EpiProj E{(bf16*)(ws + WS_PROJ), (float*)(ws + WS_DT), p.out, p.in[I_QG], p.in[I_KG], p.in[I_DTB], (LAS float*)(c.lds + 131072)};
        pg8::gemm_phase<pg8::EpiProj>(c.lds, g, S, E);
        float* sp = (float*)(ws + WS_SMP + SM_PROJ); const bf16* ua = (const bf16*)(ws + WS_SMP + SM_USBF);
        if (rep_ == 0) skinny(c, [&](int r, int k) { return *(const bf16x8*)(ua + (size_t)r * D + k); }, (const bf16*)(ws + WS_WIN), D, D, INP, 2, [&](int r, int n, float v) { atomicAdd(sp + (size_t)r * INP + n, v); }, D / 64);
    }
    SEAM(2);
    if (IN(3)) REPLOOP(3) { CP& p = *kernarg_p(); Ctx c = c0; c.ws = launder(p.ws); unsigned char* ws = c.ws; (void)ws; ph_mixers(p, c); ph_sample_postproj(p, c); ph_kvcopy(p, c, (G == 256 ? KV_SPLIT : 0), 10740, c.gw, c.ngw); }
    SEAM(3);
    if (IN(4)) REPLOOP(4) { CP& p = *kernarg_p(); Ctx c = c0; c.ws = launder(p.ws); unsigned char* ws = c.ws; (void)ws; const int sb0 = G >= 192 ? SB * AH / 2 : 0; CLK_A(4); ph_sample_attn(p, c); ph_ssd_scan(p, c, 0); ph_combine(p, c, sb0); ph_sample_mix(p, c); CLK_B(4); }
    SEAM(4);
    if (IN(5)) REPLOOP(5) { CP& p = *kernarg_p(); Ctx c = c0; c.ws = launder(p.ws); unsigned char* ws = c.ws; (void)ws;
        for (int it = blockIdx.x; it < 512; it += gridDim.x) ssd_out_item(p, c, it >> 7, (it >> 3) & 15, it & 7, rep_ == 0);
        ph_sample_a1(p, c); }
    SEAM(5);
    if (IN(6)) REPLOOP(6) { CP& p = *kernarg_p(); Ctx c = c0; c.ws = launder(p.ws); unsigned char* ws = c.ws; (void)ws;
        pg8::Gemm g{(const bf16*)(ws + WS_A1), (const bf16*)(ws + WS_WOUT), MP, D, MIXK, MIXK, MIXK, 1 << 20}; pg8::StaticOrder S; S.init(MP, D, G, blockIdx.x);
        pg8::EpiResid<false, true> E{p.in[I_XP], (void*)(ws + WS_XC), D, modp(c.ws, 0, 0, 2), MODW, nullptr, nullptr};
        pg8::RowScaleHook H{(const float*)(ws + WS_RS)};
        pg8::gemm_phase<pg8::EpiResid<false, true>, true, pg8::RowScaleHook>(c.lds, g, S, E, H);
        float* x1s = (float*)(ws + WS_SMP + SM_X1); const bf16* aa = (const bf16*)(ws + WS_SMP + SM_A1BF);
        if (rep_ == 0) skinny(c, [&](int r, int k) { return *(const bf16x8*)(aa + (size_t)r * MIXK + k); }, (const bf16*)(ws + WS_WOUT), MIXK, MIXK, D, 12, [&](int r, int n, float v) { atomicAdd(x1s + r * D + n, modp(c.ws, 0, 4 + r, 2)[n] * v); });
    }
    SEAM(6);
    if (IN(7)) REPLOOP(7) { CP& p = *kernarg_p(); Ctx c = c0; c.ws = launder(p.ws); unsigned char* ws = c.ws; (void)ws; ph_normmod<true>(p, c, (const void*)(ws + WS_XC), (const float*)(ws + WS_SMP + SM_X1), p.in[I_NMLP], 0, 3, 4, (float*)(ws + WS_SMP + SM_X2)); }
    SEAM(7);
    if (IN(8)) REPLOOP(8) { CP& p = *kernarg_p(); Ctx c = c0; c.ws = launder(p.ws); unsigned char* ws = c.ws; (void)ws;
        pg8::Gemm g{(const bf16*)(ws + WS_A0), (const bf16*)(ws + WS_W1), MP, DFF, D, D, D, 1 << 20, D / 64, D / 64}; pg8::StaticOrder S; S.init(MP, DFF, G, blockIdx.x);
        pg8::EpiBf16<1> E{(bf16*)(ws + WS_HDN), DFF, DFF / 64};
        CLK_A(8);
        pg8::gemm_phase<pg8::EpiBf16<1>>(c.lds, g, S, E, pg8::NoHook(), (unsigned long long*)(ws + WS_CTL + 65536) + 2);
        CLK_B(8);
        float* hacc = (float*)(ws + WS_SMP + SM_H0); const bf16* ua = (const bf16*)(ws + WS_SMP + SM_USBF);
        if (rep_ == 0) skinny(c, [&](int r, int k) { return *(const bf16x8*)(ua + (size_t)r * D + k); }, (const bf16*)(ws + WS_W1), D, D, DFF, 4, [&](int r, int n, float v) { atomicAdd(hacc + (size_t)r * DFF + n, v); }, D / 64);
    }
    SEAM(8);
    if (IN(9)) REPLOOP(9) { CP& p = *kernarg_p(); Ctx c = c0; c.ws = launder(p.ws); unsigned char* ws = c.ws; (void)ws;
        pg8::Gemm g{(const bf16*)(ws + WS_HDN), (const bf16*)(ws + WS_W2), MP, D, DFF, DFF, DFF, 1 << 20, DFF / 64, DFF / 64}; pg8::StaticOrder S; S.init(MP, D, G, blockIdx.x);
        pg8::EpiResid<true, true> E{(const void*)(ws + WS_XC), (void*)(ws + WS_Y), D, modp(c.ws, 0, 0, 5), MODW, nullptr, rep_ == 0 ? (float*)(ws + WS_RS) + MP : nullptr};
        pg8::gemm_phase<pg8::EpiResid<true, true>>(c.lds, g, S, E);
        float* x2s = (float*)(ws + WS_SMP + SM_X2); const float* hacc = (const float*)(ws + WS_SMP + SM_H0);
        if (rep_ == 0) skinny(c, [&](int r, int k) { return relu2_bf16x8(hacc + (size_t)r * DFF + k); }, (const bf16*)(ws + WS_W2), DFF, DFF, D, 16, [&](int r, int n, float v) { atomicAdd(x2s + r * D + n, modp(c.ws, 0, 4 + r, 5)[n] * v); }, DFF / 64);
    }
    SEAM(9);
    if (IN(10)) REPLOOP(10) { CP& p = *kernarg_p(); Ctx c = c0; c.ws = launder(p.ws); unsigned char* ws = c.ws; (void)ws; CLK_A(10); ph_pool(p, c); CLK_B(10); }
    SEAM(10);
    if (IN(11)) REPLOOP(11) { CP& p = *kernarg_p(); Ctx c = c0; c.ws = launder(p.ws); unsigned char* ws = c.ws; (void)ws;
        pg8::Gemm g{(const bf16*)(ws + WS_A1), (const bf16*)(ws + WS_WPOOL), MP, D, 512, D, 512, 2}; pg8::StaticOrder S; S.init(MP, D, G, blockIdx.x);
        pg8::EpiResid<true, true> E{(const void*)(ws + WS_Y), (void*)(ws + WS_XC), D, modp(c.ws, 1, 0, 2), MODW, p.in[I_POOLS], nullptr};
        pg8::gemm_phase<pg8::EpiResid<true, true>>(c.lds, g, S, E);
        float* x3s = (float*)(ws + WS_SMP + SM_X3); const float* psc = p.in[I_POOLS]; const bf16* pa = (const bf16*)(ws + WS_SMP + SM_PGBF);
#pragma unroll 1
        for (int gq = 0; gq < 4; ++gq)
            if (rep_ == 0) skinny(c, [&](int r, int k) { return *(const bf16x8*)(pa + (size_t)r * D + gq * 512 + k); }, (const bf16*)(ws + WS_WPOOL) + (size_t)gq * 512 * 512, 512, 512, 512, 4,
                   [&](int r, int n, float v) { const int col = gq * 512 + n; atomicAdd(x3s + r * D + col, modp(c.ws, 1, 4 + r, 2)[col] * psc[col] * v); });
    }
    SEAM(11);
    if (IN(12)) REPLOOP(12) { CP& p = *kernarg_p(); Ctx c = c0; c.ws = launder(p.ws); unsigned char* ws = c.ws; (void)ws; ph_normmod<true>(p, c, (const void*)(ws + WS_XC), (const float*)(ws + WS_SMP + SM_X3), p.in[I_NMLP] + D, 1, 3, 4, p.out + O_YS); }
    SEAM(12);
    if (IN(13)) REPLOOP(13) { CP& p = *kernarg_p(); Ctx c = c0; c.ws = launder(p.ws); unsigned char* ws = c.ws; (void)ws;
        pg8::Gemm g{(const bf16*)(ws + WS_A0), (const bf16*)(ws + WS_W1) + (size_t)DFF * D, MP, DFF, D, D, D, 1 << 20, D / 64, D / 64}; pg8::StaticOrder S; S.init(MP, DFF, G, blockIdx.x);
        pg8::EpiBf16<1> E{(bf16*)(ws + WS_HDN), DFF, DFF / 64};
        pg8::gemm_phase<pg8::EpiBf16<1>>(c.lds, g, S, E);
        float* hacc = (float*)(ws + WS_SMP + SM_H1); const bf16* ua = (const bf16*)(ws + WS_SMP + SM_USBF);
        if (rep_ == 0) skinny(c, [&](int r, int k) { return *(const bf16x8*)(ua + (size_t)r * D + k); }, (const bf16*)(ws + WS_W1) + (size_t)DFF * D, D, D, DFF, 4, [&](int r, int n, float v) { atomicAdd(hacc + (size_t)r * DFF + n, v); }, D / 64);
    }
    SEAM(13);
    if (IN(14)) REPLOOP(14) { CP& p = *kernarg_p(); Ctx c = c0; c.ws = launder(p.ws); unsigned char* ws = c.ws; (void)ws;
        pg8::Gemm g{(const bf16*)(ws + WS_HDN), (const bf16*)(ws + WS_W2) + (size_t)D * DFF, MP, D, DFF, DFF, DFF, 1 << 20, DFF / 64, DFF / 64}; pg8::StaticOrder S; S.init(MP, D, G, blockIdx.x);
        pg8::EpiResid<true, false> E{(const void*)(ws + WS_XC), (void*)(p.out + O_YP), D, modp(c.ws, 1, 0, 5), MODW, nullptr, nullptr};
        pg8::gemm_phase<pg8::EpiResid<true, false>>(c.lds, g, S, E);
        float* ys = p.out + O_YS; const float* hacc = (const float*)(ws + WS_SMP + SM_H1);
        if (rep_ == 0) skinny(c, [&](int r, int k) { return relu2_bf16x8(hacc + (size_t)r * DFF + k); }, (const bf16*)(ws + WS_W2) + (size_t)D * DFF, DFF, DFF, D, 16, [&](int r, int n, float v) { atomicAdd(ys + r * D + n, modp(c.ws, 1, 4 + r, 5)[n] * v); }, DFF / 64);
    }
#if defined(CLKSEL) && CLKSEL >= 4 && CLKSEL != 6
    { XcdBarrier bb_; bb_.bar = (unsigned*)(WS_UNIFORM() + WS_CTL) + 1024; bb_.x = xb_xcc_id(); bb_.st = (volatile LAS unsigned*)(c0.lds + LDS_BYTES - 16); xcd_barrier(bb_); }
    CLK_C(0);
#endif
#undef IN
#undef SEAM
}

extern "C" void kernel_launch(void* const* d_in, const int* in_sizes, int n_in, void* d_out, int out_size, void* d_ws, size_t ws_size, hipStream_t stream) {
    static int grid = 0;
    if (grid == 0) {
        if (n_in != N_IN || (size_t)out_size != O_END || ws_size < WS_END) { fprintf(stderr, "kernel_launch: shape mismatch: n_in %d (want %d), out %d (want %zu), ws %zu (want >= %zu)\n", n_in, (int)N_IN, out_size, (size_t)O_END, ws_size, (size_t)WS_END); grid = -1; return; }
        int dev = 0, cus = 0, per_cu = 0;
        if (hipGetDevice(&dev) != hipSuccess || hipDeviceGetAttribute(&cus, hipDeviceAttributeMultiprocessorCount, dev) != hipSuccess) { grid = -1; return; }
        if (hipFuncSetAttribute((const void*)mk_fwd, hipFuncAttributeMaxDynamicSharedMemorySize, LDS_BYTES) != hipSuccess) { fprintf(stderr, "kernel_launch: hipFuncSetAttribute failed\n"); grid = -1; return; }
        if (hipOccupancyMaxActiveBlocksPerMultiprocessor(&per_cu, (const void*)mk_fwd, NT, LDS_BYTES) != hipSuccess || per_cu < 1) { fprintf(stderr, "kernel_launch: occupancy query says %d blocks per CU\n", per_cu); (void)hipGetLastError(); per_cu = 1; }
        grid = cus;
        fprintf(stderr, "kernel_launch: %d CUs, occupancy query %d per CU, grid %d\n", cus, per_cu, grid);
    }
    if (grid < 0) return;
    if (hipMemsetAsync((char*)d_ws + WS_CTL, 0, WS_MOD + (size_t)2 * 12 * MODW * 4, stream) != hipSuccess) { fprintf(stderr, "kernel_launch: memset failed\n"); return; }
    P a{};
    for (int i = 0; i < N_IN; ++i) a.in[i] = (const float*)d_in[i];
    a.out = (float*)d_out; a.ws = (unsigned char*)d_ws;
#if MK_ONE_LAUNCH
    a.ph_lo = 0; a.ph_hi = NPHASE;
    { void* args[] = {&a}; hipError_t e = hipLaunchCooperativeKernel((const void*)mk_fwd, dim3(grid), dim3(NT), args, LDS_BYTES, stream);
      if (e != hipSuccess) fprintf(stderr, "kernel_launch: cooperative launch failed: %s\n", hipGetErrorString(e)); }
#else
    for (int ph = 0; ph < NPHASE; ++ph) { a.ph_lo = ph; a.ph_hi = ph + 1; void* args[] = {&a};
        hipError_t e = hipLaunchCooperativeKernel((const void*)mk_fwd, dim3(grid), dim3(NT), args, LDS_BYTES, stream);
        if (e != hipSuccess) { fprintf(stderr, "kernel_launch: launch %d failed: %s\n", ph, hipGetErrorString(e)); break; } }
#endif
}
```
